# Optimizing an MI355X kernel written in HIP

```python
import jax, jax.numpy as jnp
from jax import lax
import numpy as np

D_MODEL = 1024
BATCH = 4
SEQ = 4096
DEPTH = 1
DEC_BATCH = 8
DEC_SEQ = 32
PAST_LEN = 2048

CHUNK = 64
N_META = 16
Q_BLOCK = 128
SB_HEADS = 8
SB_HEAD_DIM = 64
SB_WIDTH = SB_HEADS * SB_HEAD_DIM
HG_HEADS = 4
HG_HEAD_DIM = 128
HG_WIDTH = HG_HEADS * HG_HEAD_DIM
D_FF = 2816
EPS = 1e-6
IN_SPLITS = [SB_WIDTH, SB_WIDTH, SB_WIDTH, HG_WIDTH, HG_WIDTH, HG_WIDTH, HG_WIDTH, D_MODEL, D_MODEL]
N_IN = sum(IN_SPLITS)

kernel_name = 'streaming_stickbreak_hgrn2_macaron'


def rmsnorm(x, g):
    xf = x.astype(jnp.float32)
    y = xf * lax.rsqrt(jnp.mean(xf * xf, axis=-1, keepdims=True) + EPS)
    return (y * g.astype(jnp.float32)).astype(x.dtype)


def half_ffn(x, g, w_gate, w_up, w_down):
    h = rmsnorm(x, g)
    return x + 0.5 * ((jax.nn.silu(h @ w_gate) * (h @ w_up)) @ w_down)


def sb_block(q, k, v, q_idx, k_idx):
    z = jnp.einsum('bqhd,bkhd->bhqk', q.astype(jnp.float32), k.astype(jnp.float32)) * (SB_HEAD_DIM ** -0.5)
    strict = k_idx[None, :] < q_idx[:, None]
    log_stay = jnp.where(strict, jax.nn.log_sigmoid(-z), 0.0)
    after = lax.cumsum(log_stay, axis=3, reverse=True) - log_stay
    a = jnp.where(strict, jnp.exp(jax.nn.log_sigmoid(z) + after), 0.0)
    return jnp.einsum('bhqk,bkhd->bqhd', a, v.astype(jnp.float32))


def sb_prompt(q, k, v):
    B, L, H, D = q.shape
    Lp = -(-L // Q_BLOCK) * Q_BLOCK
    pad = ((0, 0), (0, Lp - L), (0, 0), (0, 0))
    qp, kp, vp = jnp.pad(q, pad), jnp.pad(k, pad), jnp.pad(v, pad)
    n = Lp // Q_BLOCK
    qb = jnp.moveaxis(qp.reshape(B, n, Q_BLOCK, H, D), 1, 0)
    starts = jnp.arange(n, dtype=jnp.int32) * Q_BLOCK
    k_idx = jnp.arange(Lp, dtype=jnp.int32)
    out = lax.map(lambda a: sb_block(a[0], kp, vp, a[1] + jnp.arange(Q_BLOCK, dtype=jnp.int32), k_idx), (qb, starts))
    return jnp.moveaxis(out, 0, 1).reshape(B, Lp, H, D)[:, :L]


def hgrn_chunk(S, q, k, iv, logf):
    T = q.shape[1]
    b = jnp.cumsum(logf, axis=1)
    causal = jnp.arange(T)[:, None] >= jnp.arange(T)[None, :]
    diff = b[:, :, None] - b[:, None, :]
    decay = jnp.exp(jnp.where(causal[None, :, :, None, None], diff, -jnp.inf))
    scores = jnp.einsum('bthk,bshk,btshk->bhts', q, k, decay)
    o = jnp.einsum('bhts,bshv->bthv', scores, iv) + jnp.einsum('bthk,bhkv->bthv', q * jnp.exp(b), S)
    b_last = b[:, -1]
    S_new = jnp.exp(b_last)[..., None] * S + jnp.einsum('bshk,bshv->bhkv', k * jnp.exp(b_last[:, None] - b), iv)
    return o, S_new


def hgrn_prompt(q, k, iv, logf):
    B, L, H, K = q.shape
    V = iv.shape[-1]
    S0 = jnp.zeros((B, H, K, V), jnp.float32)
    o_meta, S = hgrn_chunk(S0, q[:, :N_META], k[:, :N_META], iv[:, :N_META], logf[:, :N_META])
    n = (L - N_META) // CHUNK
    blk = lambda a: jnp.moveaxis(a[:, N_META:].reshape(B, n, CHUNK, H, a.shape[-1]), 1, 0)

    def step(S, xs):
        o, S2 = hgrn_chunk(S, *xs)
        return S2, o

    S, outs = lax.scan(step, S, (blk(q), blk(k), blk(iv), blk(logf)))
    o_rest = jnp.moveaxis(outs, 0, 1).reshape(B, n * CHUNK, H, V)
    return jnp.concatenate([o_meta, o_rest], axis=1), S


def hgrn_lower_bounds(logits):
    p = jax.nn.softmax(logits.astype(jnp.float32), axis=0)
    return jnp.cumsum(p, axis=0) - p[0]


def setup_inputs(seed: int = 0) -> dict:
    key = jax.random.key(seed)
    ks = jax.random.split(key, 32)
    nrm = lambda k, s, sc: jax.random.normal(k, s, jnp.float32) * sc
    gain = lambda k, s: 1.0 + 0.02 * jax.random.normal(k, s, jnp.float32)
    L_cache = N_META + PAST_LEN
    return {
        'x_prompt': nrm(ks[0], (BATCH, SEQ, D_MODEL), 1.0),
        'x_sample': nrm(ks[1], (DEC_BATCH, DEC_SEQ, D_MODEL), 1.0),
        'cache_sb_k': nrm(ks[2], (DEPTH, DEC_BATCH, L_cache, SB_HEADS, SB_HEAD_DIM), 1.0),
        'cache_sb_v': nrm(ks[3], (DEPTH, DEC_BATCH, L_cache, SB_HEADS, SB_HEAD_DIM), 1.0),
        'state_hgrn': nrm(ks[4], (DEPTH, DEC_BATCH, HG_HEADS, HG_HEAD_DIM, HG_HEAD_DIM), 0.5),
        'meta_tokens': nrm(ks[5], (N_META, D_MODEL), 1.0),
        'ffn1_norm': gain(ks[6], (DEPTH, D_MODEL)),
        'ffn1_w_gate': nrm(ks[7], (DEPTH, D_MODEL, D_FF), D_MODEL ** -0.5),
        'ffn1_w_up': nrm(ks[8], (DEPTH, D_MODEL, D_FF), D_MODEL ** -0.5),
        'ffn1_w_down': nrm(ks[9], (DEPTH, D_FF, D_MODEL), D_FF ** -0.5),
        'mix_norm': gain(ks[10], (DEPTH, D_MODEL)),
        'w_in': nrm(ks[11], (DEPTH, D_MODEL, N_IN), D_MODEL ** -0.5),
        'b_gate': nrm(ks[12], (DEPTH, 2 * D_MODEL), 0.02),
        'hg_lb_logits': nrm(ks[13], (DEPTH + 1, HG_WIDTH), 0.1),
        'hg_out_norm': gain(ks[14], (DEPTH, HG_WIDTH)),
        'w_branch_a': nrm(ks[15], (DEPTH, SB_WIDTH, D_MODEL), SB_WIDTH ** -0.5),
        'w_branch_b': nrm(ks[16], (DEPTH, HG_WIDTH, D_MODEL), HG_WIDTH ** -0.5),
        'w_out': nrm(ks[17], (DEPTH, D_MODEL, D_MODEL), D_MODEL ** -0.5),
        'ffn2_norm': gain(ks[18], (DEPTH, D_MODEL)),
        'ffn2_w_gate': nrm(ks[19], (DEPTH, D_MODEL, D_FF), D_MODEL ** -0.5),
        'ffn2_w_up': nrm(ks[20], (DEPTH, D_MODEL, D_FF), D_MODEL ** -0.5),
        'ffn2_w_down': nrm(ks[21], (DEPTH, D_FF, D_MODEL), D_FF ** -0.5),
        'final_norm': gain(ks[22], (D_MODEL,)),
    }


def reference(x_prompt, x_sample, cache_sb_k, cache_sb_v, state_hgrn, meta_tokens,
              ffn1_norm, ffn1_w_gate, ffn1_w_up, ffn1_w_down, mix_norm, w_in, b_gate,
              hg_lb_logits, hg_out_norm, w_branch_a, w_branch_b, w_out,
              ffn2_norm, ffn2_w_gate, ffn2_w_up, ffn2_w_down, final_norm):
    lower = hgrn_lower_bounds(hg_lb_logits)
    split_at = np.cumsum(IN_SPLITS)[:-1].tolist()

    def pre_mix(x, l):
        x = half_ffn(x, ffn1_norm[l], ffn1_w_gate[l], ffn1_w_up[l], ffn1_w_down[l])
        h = rmsnorm(x, mix_norm[l])
        B, L, _ = h.shape
        qa, ka, va, zf, ih, qh, g, ga, gb = jnp.split(h @ w_in[l], split_at, axis=-1)
        heads_a = lambda a: a.reshape(B, L, SB_HEADS, SB_HEAD_DIM)
        heads_b = lambda a: a.astype(jnp.float32).reshape(B, L, HG_HEADS, HG_HEAD_DIM)
        lb = lower[l + 1]
        f = lb + (1.0 - lb) * jax.nn.sigmoid(zf.astype(jnp.float32))
        hg = (heads_b(qh), heads_b(1.0 - f), heads_b(ih), heads_b(jnp.log(f)))
        gates = jax.nn.sigmoid((jnp.concatenate([ga, gb], -1) + b_gate[l]).astype(jnp.float32))
        return x, (heads_a(qa), heads_a(ka), heads_a(va)), hg, g, gates

    def post_mix(x, l, oa, ob, g, gates):
        B, L, _ = x.shape
        on = ob * lax.rsqrt(jnp.mean(ob * ob, axis=-1, keepdims=True) + EPS) * hg_out_norm[l].astype(jnp.float32).reshape(HG_HEADS, HG_HEAD_DIM)
        ob = (on * jax.nn.silu(g.astype(jnp.float32).reshape(B, L, HG_HEADS, HG_HEAD_DIM))).reshape(B, L, HG_WIDTH).astype(x.dtype)
        oa = oa.reshape(B, L, SB_WIDTH).astype(x.dtype)
        gates = gates.astype(x.dtype)
        merged = gates[..., :D_MODEL] * (oa @ w_branch_a[l]) + gates[..., D_MODEL:] * (ob @ w_branch_b[l])
        x = x + merged @ w_out[l]
        return half_ffn(x, ffn2_norm[l], ffn2_w_gate[l], ffn2_w_up[l], ffn2_w_down[l])

    Bp = x_prompt.shape[0]
    xp = jnp.concatenate([jnp.broadcast_to(meta_tokens.astype(x_prompt.dtype)[None], (Bp, N_META, D_MODEL)), x_prompt], axis=1)
    pk, pv, ps = [], [], []
    for l in range(DEPTH):
        xp, (qa, ka, va), hg, g, gates = pre_mix(xp, l)
        oa = sb_prompt(qa, ka, va)
        ob, S = hgrn_prompt(*hg)
        xp = post_mix(xp, l, oa, ob, g, gates)
        pk.append(ka)
        pv.append(va)
        ps.append(S)
    y_prompt = rmsnorm(xp, final_norm)[:, N_META:]

    xs = x_sample
    T = xs.shape[1]
    Lc = cache_sb_k.shape[2]
    q_idx = Lc + jnp.arange(T, dtype=jnp.int32)
    k_idx = jnp.arange(Lc + T, dtype=jnp.int32)
    sk, sv, ss = [], [], []
    for l in range(DEPTH):
        xs, (qa, ka, va), hg, g, gates = pre_mix(xs, l)
        kk = jnp.concatenate([cache_sb_k[l], ka.astype(cache_sb_k.dtype)], axis=1)
        vv = jnp.concatenate([cache_sb_v[l], va.astype(cache_sb_v.dtype)], axis=1)
        oa = sb_block(qa, kk, vv, q_idx, k_idx)
        ob, S = hgrn_chunk(state_hgrn[l].astype(jnp.float32), *hg)
        xs = post_mix(xs, l, oa, ob, g, gates)
        sk.append(ka)
        sv.append(va)
        ss.append(S)
    y_sample = rmsnorm(xs, final_norm)

    return (y_prompt, y_sample, jnp.stack(pk), jnp.stack(pv), jnp.stack(ps), jnp.stack(sk), jnp.stack(sv), jnp.stack(ss))
```

```cpp
#include <hip/hip_runtime.h>
#include <hip/hip_cooperative_groups.h>
#include <cstdio>
#include <cstdint>
namespace cg = cooperative_groups;
namespace pg8 {
#define PG8_LAS __attribute__((address_space(3)))
typedef unsigned short bf16_t;
typedef short bf16x8 __attribute__((ext_vector_type(8)));
typedef float f32x4 __attribute__((ext_vector_type(4)));
typedef unsigned u32x4 __attribute__((ext_vector_type(4)));
constexpr int BM = 256, BK = 64, HALF = 128, HTB = HALF * BK * 2  , STAGE_BYTES = 8 * HTB, NXCD = 8, WGM = 8;

__host__ __device__ __forceinline__ int lds_byte(int r, int c) { const int st = (r >> 4) * 2 + (c >> 5), rr = r & 15, cc = c & 31, ob = rr * 64 + cc * 2; return st * 1024 + (ob ^ (((ob >> 9) & 1) << 5)); }
__host__ __device__ __forceinline__ void stage_rc(int b, int& R, int& C) { const int st = b / 1024, sb = b % 1024, swz = sb ^ (((sb >> 9) & 1) << 5); R = (st >> 1) * 16 + swz / 64; C = (st & 1) * 32 + (swz % 64) / 2; }
__host__ __device__ __forceinline__ int perm32(int rho) { const int n = rho >> 4, i = rho & 15; return 8 * (i >> 2) + 4 * n + (i & 3); }

struct Unit { int pm, pn; };
struct Gemm { const bf16_t* A; const bf16_t* Bt; int M, N, K; };

struct StaticOrder {
    int nM, nN, nwg, G, c;
    __host__ __device__ void init(int M, int N, int G_, int c_) { nM = M / BM; nN = N / BM; nwg = nM * nN; G = G_; c = c_; }
    __host__ __device__ bool next(int i, Unit& u) const {
        const long L = (long)i * G + c; if (L >= nwg) return false;
        int wgid = (int)L; { const int q = nwg / NXCD, r = nwg % NXCD, xcd = wgid % NXCD, off = wgid / NXCD; wgid = (xcd < r ? xcd * (q + 1) : r * (q + 1) + (xcd - r) * q) + off; }
        const int nig = WGM * nN, gid = wgid / nig, fm = gid * WGM, gsz = (nM - fm) < WGM ? (nM - fm) : WGM;
        u.pm = fm + ((wgid % nig) % gsz); u.pn = (wgid % nig) / gsz; return true;
    }
    __device__ __forceinline__ void a_ready(const Unit&) const {}
    __device__ __forceinline__ void done(const Unit&) const {}
};

__device__ __forceinline__ unsigned cvt_pk_bf16(float lo, float hi) { unsigned r; asm volatile("v_cvt_pk_bf16_f32 %0, %1, %2" : "=v"(r) : "v"(lo), "v"(hi)); return r; }
template <class Epi, class Sched, bool ALIGN_EPI = false, bool SP2 = false>
__device__ __forceinline__ void gemm_phase(PG8_LAS unsigned char* lds, const Gemm g, const Sched S, const Epi E) {
    int tid_l = threadIdx.x; asm volatile("" : "+v"(tid_l)); const int tid = tid_l, wid = __builtin_amdgcn_readfirstlane(tid >> 6), lane = tid & 63, wr = wid >> 2, wc = wid & 3, fr = lane & 15, fq = lane >> 4;
    const int K = g.K, nt = K / BK;
    unsigned voffA[2], voffB[2];
#pragma unroll
    for (int i = 0; i < 2; ++i) { int R, C; stage_rc(tid * 16 + i * 8192, R, C); const int Rb = Epi::PERM ? ((R & ~31) + perm32(R & 31)) : R;
        voffA[i] = (unsigned)(R * K + C) * 2u; voffB[i] = (unsigned)(Rb * K + C) * 2u; }
    const size_t kstep = (size_t)(BK * 2);
    const size_t hstep = (size_t)HALF * K * 2;
    const size_t tstep = 2 * hstep;
    const unsigned ldsw = (unsigned)wid * 1024u;
    const int aoff = lds_byte(wr * 64 + fr, fq * 8), boff = lds_byte(wc * 32 + fr, fq * 8);
#define PG8_SA(b, h) (((b) * 2 + (h)) * HTB)
#define PG8_SB(b, h) ((4 + (b) * 2 + (h)) * HTB)
#define PG8_STAGE(bufoff, gbase, voff) do { _Pragma("unroll") for (int _i = 0; _i < 2; ++_i) \
        __builtin_amdgcn_global_load_lds((const unsigned*)((const char*)(gbase) + (voff)[_i]), (PG8_LAS unsigned*)(lds + (bufoff) + ldsw + _i * 8192), 16, 0, 0); } while (0)
#define PG8_LDA(dst, b, h) do { _Pragma("unroll") for (int m = 0; m < 4; ++m) _Pragma("unroll") for (int k = 0; k < 2; ++k) dst[m][k] = *(const PG8_LAS bf16x8*)(lds + PG8_SA(b, h) + aoff + m * 2048 + k * 1024); } while (0)
#define PG8_LDB(dst, b, h) do { _Pragma("unroll") for (int n = 0; n < 2; ++n) _Pragma("unroll") for (int k = 0; k < 2; ++k) dst[n][k] = *(const PG8_LAS bf16x8*)(lds + PG8_SB(b, h) + boff + n * 2048 + k * 1024); } while (0)
#define PG8_MMA(ai, bj, At, Bt) do { __builtin_amdgcn_s_setprio(1); _Pragma("unroll") for (int m = 0; m < 4; ++m) _Pragma("unroll") for (int n = 0; n < 2; ++n) _Pragma("unroll") for (int k = 0; k < 2; ++k) \
        acc[ai][bj][m][n] = __builtin_amdgcn_mfma_f32_16x16x32_bf16(Bt[n][k], At[m][k], acc[ai][bj][m][n], 0, 0, 0); __builtin_amdgcn_s_setprio(0); } while (0)
#define PG8_WAIT_V(n) asm volatile("s_waitcnt vmcnt(" #n ")" ::: "memory")
#define PG8_WAIT_L(n) asm volatile("s_waitcnt lgkmcnt(" #n ")" ::: "memory")
#define PG8_BAR __builtin_amdgcn_s_barrier()
#define PG8_SCHED __builtin_amdgcn_sched_barrier(0)
    Unit cur, nxt; int ui = 0;
    if (!S.next(0, cur)) return;
    f32x4 acc[2][2][4][2];
#pragma unroll
    for (int a = 0; a < 2; ++a)
#pragma unroll
        for (int b = 0; b < 2; ++b)
#pragma unroll
            for (int m = 0; m < 4; ++m)
#pragma unroll
                for (int n = 0; n < 2; ++n) acc[a][b][m][n] = (f32x4){0.f, 0.f, 0.f, 0.f};
    bf16x8 At[4][2], B0[2][2], B1[2][2];
    const char* cA = (const char*)g.A + (size_t)cur.pm * tstep; const char* cB = (const char*)g.Bt + (size_t)cur.pn * tstep;
    S.a_ready(cur);
    if constexpr (SP2) {
        PG8_STAGE(PG8_SB(0, 0), cB, voffB); PG8_STAGE(PG8_SB(0, 1), cB + hstep, voffB); PG8_STAGE(PG8_SA(0, 0), cA, voffA); PG8_STAGE(PG8_SA(0, 1), cA + hstep, voffA);
        if (wr == 1) PG8_BAR;
        PG8_WAIT_V(2); PG8_BAR;
        PG8_STAGE(PG8_SB(1, 0), cB + kstep, voffB); PG8_STAGE(PG8_SA(1, 0), cA + kstep, voffA); PG8_STAGE(PG8_SB(1, 1), cB + hstep + kstep, voffB);
        PG8_WAIT_V(6); PG8_BAR;
    } else {
        PG8_STAGE(PG8_SB(0, 0), cB, voffB); PG8_STAGE(PG8_SA(0, 0), cA, voffA); PG8_STAGE(PG8_SB(0, 1), cB + hstep, voffB); PG8_STAGE(PG8_SA(0, 1), cA + hstep, voffA);
        if (wr == 1) PG8_BAR;
        PG8_WAIT_V(4); PG8_BAR;
        PG8_STAGE(PG8_SB(1, 0), cB + kstep, voffB); PG8_STAGE(PG8_SA(1, 0), cA + kstep, voffA); PG8_STAGE(PG8_SB(1, 1), cB + hstep + kstep, voffB);
        PG8_WAIT_V(6); PG8_BAR;
    }
    for (;;) {
        const bool has_next = S.next(ui + 1, nxt);
        const char* nA = has_next ? (const char*)g.A + (size_t)nxt.pm * tstep : cA; const char* nB = has_next ? (const char*)g.Bt + (size_t)nxt.pn * tstep : cB;
        for (int t = 0; t < nt; t += 2) {
            const bool last = (t == nt - 2);
            const char* a1 = cA + (size_t)(t + 1) * kstep;
            const char* a2 = last ? nA : cA + (size_t)(t + 2) * kstep; const char* b2 = last ? nB : cB + (size_t)(t + 2) * kstep;
            const char* a3 = a2 + kstep; const char* b3 = b2 + kstep;
            if (last && has_next) S.a_ready(nxt);
            if constexpr (SP2) {
            PG8_LDB(B0, 0, 0); PG8_LDB(B1, 0, 1); PG8_SCHED; PG8_LDA(At, 0, 0); PG8_STAGE(PG8_SA(1, 1), a1 + hstep, voffA);
            PG8_WAIT_V(8); PG8_WAIT_L(0); PG8_BAR; PG8_MMA(0, 0, At, B0); PG8_MMA(0, 1, At, B1); PG8_BAR; PG8_SCHED;
            PG8_LDA(At, 0, 1); PG8_STAGE(PG8_SB(0, 0), b2, voffB); PG8_STAGE(PG8_SB(0, 1), b2 + hstep, voffB); PG8_STAGE(PG8_SA(0, 0), a2, voffA);
            PG8_WAIT_V(8); PG8_WAIT_L(0); PG8_BAR; PG8_MMA(1, 0, At, B0); PG8_MMA(1, 1, At, B1); PG8_BAR; PG8_SCHED;
            PG8_LDB(B0, 1, 0); PG8_LDB(B1, 1, 1); PG8_SCHED; PG8_LDA(At, 1, 0); PG8_STAGE(PG8_SA(0, 1), a2 + hstep, voffA);
            PG8_WAIT_V(8); PG8_WAIT_L(0); PG8_BAR; PG8_MMA(0, 0, At, B0); PG8_MMA(0, 1, At, B1); PG8_BAR; PG8_SCHED;
            PG8_LDA(At, 1, 1); PG8_STAGE(PG8_SB(1, 0), b3, voffB); PG8_STAGE(PG8_SB(1, 1), b3 + hstep, voffB); PG8_STAGE(PG8_SA(1, 0), a3, voffA);
            PG8_WAIT_V(8); PG8_WAIT_L(0); PG8_BAR; PG8_MMA(1, 0, At, B0); PG8_MMA(1, 1, At, B1); PG8_BAR; PG8_SCHED;
            } else {
            PG8_LDB(B0, 0, 0); PG8_SCHED; PG8_LDA(At, 0, 0); PG8_STAGE(PG8_SA(1, 1), a1 + hstep, voffA);
            PG8_WAIT_L(8); PG8_BAR; PG8_WAIT_L(0); PG8_MMA(0, 0, At, B0); PG8_BAR; PG8_SCHED;
            PG8_LDB(B1, 0, 1); PG8_STAGE(PG8_SB(0, 0), b2, voffB);
            PG8_BAR; PG8_WAIT_L(0); PG8_MMA(0, 1, At, B1); PG8_BAR;
            PG8_LDA(At, 0, 1); PG8_STAGE(PG8_SA(0, 0), a2, voffA);
            PG8_BAR; PG8_WAIT_L(0); PG8_MMA(1, 0, At, B0); PG8_BAR; PG8_SCHED;
            PG8_STAGE(PG8_SB(0, 1), b2 + hstep, voffB);
            PG8_WAIT_V(6); PG8_BAR; PG8_MMA(1, 1, At, B1); PG8_BAR;
            PG8_LDB(B0, 1, 0); PG8_SCHED; PG8_LDA(At, 1, 0); PG8_STAGE(PG8_SA(0, 1), a2 + hstep, voffA);
            PG8_WAIT_L(8); PG8_BAR; PG8_WAIT_L(0); PG8_MMA(0, 0, At, B0); PG8_BAR; PG8_SCHED;
            PG8_LDB(B1, 1, 1); PG8_STAGE(PG8_SB(1, 0), b3, voffB);
            PG8_BAR; PG8_WAIT_L(0); PG8_MMA(0, 1, At, B1); PG8_BAR;
            PG8_LDA(At, 1, 1); PG8_STAGE(PG8_SA(1, 0), a3, voffA);
            PG8_BAR; PG8_WAIT_L(0); PG8_MMA(1, 0, At, B0); PG8_BAR; PG8_SCHED;
            PG8_STAGE(PG8_SB(1, 1), b3 + hstep, voffB);
            PG8_WAIT_V(6); PG8_BAR; PG8_MMA(1, 1, At, B1); PG8_BAR;
            }
        }
        if constexpr (ALIGN_EPI) { if (wr == 0) PG8_BAR; }
        if constexpr (!Epi::AFTER_DRAIN) { E(acc, cur, wr, wc, fr, fq); S.done(cur); }
        if (!has_next) break;
#pragma unroll
        for (int a = 0; a < 2; ++a)
#pragma unroll
            for (int b = 0; b < 2; ++b)
#pragma unroll
                for (int m = 0; m < 4; ++m)
#pragma unroll
                    for (int n = 0; n < 2; ++n) acc[a][b][m][n] = (f32x4){0.f, 0.f, 0.f, 0.f};
        cur = nxt; cA = nA; cB = nB; ++ui;
        if constexpr (ALIGN_EPI) { if (wr == 1) PG8_BAR; }
    }
    PG8_WAIT_V(0);
    if constexpr (!ALIGN_EPI) { if (wr == 0) PG8_BAR; }
    PG8_BAR;
    if constexpr (Epi::AFTER_DRAIN) { E.fused(acc, cur, wr, wc, fr, fq, lds, wid, lane); S.done(cur); }
#undef PG8_SA
#undef PG8_SB
#undef PG8_STAGE
#undef PG8_LDA
#undef PG8_LDB
#undef PG8_MMA
#undef PG8_WAIT_V
#undef PG8_WAIT_L
#undef PG8_BAR
#undef PG8_SCHED
}
}

#define LAS __attribute__((address_space(3)))
typedef unsigned short bf16;
typedef float f32x4 __attribute__((ext_vector_type(4)));
typedef float f32x16 __attribute__((ext_vector_type(16)));
typedef short bf16x8 __attribute__((ext_vector_type(8)));
typedef unsigned u32x4 __attribute__((ext_vector_type(4)));
typedef unsigned u32x2 __attribute__((ext_vector_type(2)));
using pg8::cvt_pk_bf16;

constexpr int NWAVES = 8, NTHREADS = 512;
constexpr int D = 1024, FF = 2816, NIN = 5632;
constexpr int MP = 16384;
constexpr int MS = 256;
constexpr int MO = MP + MS;
constexpr int MX = MO + 16;
constexpr int MPAD = 16896;
constexpr int LP = 4112;
constexpr int LC = 2064;
constexpr float EPS = 1e-6f;
constexpr float LOG2E = 1.4426950408889634f;
constexpr float QSCALE = 0.125f * LOG2E;
constexpr float SB_EXIT = 152.0f;

constexpr size_t O_YP = 0, O_YS = 16777216, O_PK = 17039360, O_PV = 25460736, O_PH = 33882112, O_SK = 34144256, O_SV = 34275328, O_SH = 34406400;
constexpr size_t WS_WGU1 = 0, WS_WD1 = 11534336, WS_WIN = 17301504, WS_WA = 28835840, WS_WB = 29884416, WS_WOUT = 30932992, WS_WGU2 = 33030144, WS_WD2 = 44564480;
constexpr size_t WS_SS = 50331648, SS_BYTES = (size_t)MPAD * 16 * 4;
constexpr size_t WS_XN = 54657024, WS_ACT = 89260032;
constexpr size_t WS_KKH = 184418304, WS_QB = 201719808, WS_QH = 219021312, WS_IVTP = 236322816, WS_IVTS = 253165568, WS_END = 253689856;
constexpr size_t WS_GA = WS_ACT, WS_GB = WS_ACT + 34603008, WS_SG = WS_ACT + 69206016;
constexpr int LDS_BYTES = 147456;

struct Args { const float* in[23]; float* out; unsigned char* ws; };
typedef const Args __attribute__((address_space(4)))* ArgsP;
__device__ __forceinline__ ArgsP argsp() { ArgsP p = (ArgsP)__builtin_amdgcn_kernarg_segment_ptr(); asm volatile("" : "+s"(p)); return p; }
enum { I_XP = 0, I_XS, I_CK, I_CV, I_ST, I_META, I_N1, I_WG1, I_WU1, I_WD1, I_NMIX, I_WIN, I_BG, I_LB, I_HGN, I_WA, I_WB, I_WOUT, I_N2, I_WG2, I_WU2, I_WD2, I_NF };

__device__ __forceinline__ float wave_sum(float v) {
#pragma unroll
    for (int o = 1; o < 64; o <<= 1) v += __shfl_xor(v, o);
    return v;
}
__device__ __forceinline__ float ex2(float x) { return __builtin_amdgcn_exp2f(x); }
__device__ __forceinline__ float lg2(float x) { return __builtin_amdgcn_logf(x); }
__device__ __forceinline__ float sigmoidf_(float x) { return 1.0f / (1.0f + ex2(-x * LOG2E)); }
__device__ __forceinline__ float rstd_from_ss(const float* ss, int r) {
    const f32x4* p = (const f32x4*)(ss + (size_t)r * 16);
    f32x4 a = p[0], b = p[1], c = p[2], d = p[3];
    float s = ((a.x + a.y) + (a.z + a.w)) + ((b.x + b.y) + (b.z + b.w)) + ((c.x + c.y) + (c.z + c.w)) + ((d.x + d.y) + (d.z + d.w));
    return rsqrtf(s * (1.0f / 1024.0f) + EPS);
}
__device__ __forceinline__ const float* xin_row(ArgsP A, int r) {
    if (r < MP) return A->in[I_XP] + (size_t)r * D;
    if (r < MO) return A->in[I_XS] + (size_t)(r - MP) * D;
    if (r < MX) return A->in[I_META] + (size_t)(r - MO) * D;
    return nullptr;
}

__device__ __forceinline__ void p0_transpose_item(const float* W, int K, int N, bf16* WT, int il, LAS float* scr, int item, int lane) {
    const int nblk = N / 32, kb = item / nblk, nb = item % nblk, k0 = 64 * kb, n0 = 32 * nb;
#pragma unroll 8
    for (int i = 0; i < 32; ++i) { const int kk = 2 * i + (lane >> 5); scr[kk * 33 + (lane & 31)] = W[(size_t)(k0 + kk) * N + n0 + (lane & 31)]; }
    asm volatile("s_waitcnt lgkmcnt(0)" ::: "memory");
    const int rbase = il == 0 ? n0 : ((n0 >> 7) * 256 + (n0 & 127) + (il == 2 ? 128 : 0));
    const int c = lane & 7;
#pragma unroll
    for (int j = 0; j < 4; ++j) { const int n = (lane >> 3) + 8 * j; const LAS float* s = scr + (8 * c) * 33 + n;
        u32x4 o; o.x = cvt_pk_bf16(s[0 * 33], s[1 * 33]); o.y = cvt_pk_bf16(s[2 * 33], s[3 * 33]); o.z = cvt_pk_bf16(s[4 * 33], s[5 * 33]); o.w = cvt_pk_bf16(s[6 * 33], s[7 * 33]);
        *(u32x4*)(WT + (size_t)(rbase + n) * K + k0 + 8 * c) = o; }
    asm volatile("s_waitcnt lgkmcnt(0)" ::: "memory");
}
__device__ __forceinline__ void p0_phase(ArgsP A, LAS unsigned char* lds, int wave, int lane) {
    LAS float* scr = (LAS float*)(lds + wave * 16384);
    const int G = gridDim.x, gw = blockIdx.x * NWAVES + wave, NGW = G * NWAVES;
    unsigned char* ws = A->ws;
    constexpr int I_GU = (D / 64) * (FF / 32), I_DN = (FF / 64) * (D / 32), I_IN = (D / 64) * (NIN / 32), I_BR = (512 / 64) * (D / 32), I_OU = (D / 64) * (D / 32);
    constexpr int NITEMS = 4 * I_GU + 2 * I_DN + I_IN + 2 * I_BR + I_OU;
    for (int it = gw; it < NITEMS; it += NGW) {
        int r = it;
        if (r < I_GU) { p0_transpose_item(A->in[I_WG1], D, FF, (bf16*)(ws + WS_WGU1), 1, scr, r, lane); continue; } r -= I_GU;
        if (r < I_GU) { p0_transpose_item(A->in[I_WU1], D, FF, (bf16*)(ws + WS_WGU1), 2, scr, r, lane); continue; } r -= I_GU;
        if (r < I_DN) { p0_transpose_item(A->in[I_WD1], FF, D, (bf16*)(ws + WS_WD1), 0, scr, r, lane); continue; } r -= I_DN;
        if (r < I_IN) { p0_transpose_item(A->in[I_WIN], D, NIN, (bf16*)(ws + WS_WIN), 0, scr, r, lane); continue; } r -= I_IN;
        if (r < I_BR) { p0_transpose_item(A->in[I_WA], 512, D, (bf16*)(ws + WS_WA), 0, scr, r, lane); continue; } r -= I_BR;
        if (r < I_BR) { p0_transpose_item(A->in[I_WB], 512, D, (bf16*)(ws + WS_WB), 0, scr, r, lane); continue; } r -= I_BR;
        if (r < I_OU) { p0_transpose_item(A->in[I_WOUT], D, D, (bf16*)(ws + WS_WOUT), 0, scr, r, lane); continue; } r -= I_OU;
        if (r < I_GU) { p0_transpose_item(A->in[I_WG2], D, FF, (bf16*)(ws + WS_WGU2), 1, scr, r, lane); continue; } r -= I_GU;
        if (r < I_GU) { p0_transpose_item(A->in[I_WU2], D, FF, (bf16*)(ws + WS_WGU2), 2, scr, r, lane); continue; } r -= I_GU;
        p0_transpose_item(A->in[I_WD2], FF, D, (bf16*)(ws + WS_WD2), 0, scr, r, lane);
    }
    bf16* XN = (bf16*)(ws + WS_XN); float* SS0 = (float*)(ws + WS_SS);
    const f32x4* g1 = (const f32x4*)A->in[I_N1] + lane;
    for (int m = gw; m < MPAD; m += NGW) {
        const float* xr = xin_row(A, m);
        unsigned long long* o8 = (unsigned long long*)(XN + (size_t)m * D) + lane;
        float s = 0.f;
        if (xr) {
            const f32x4* x4 = (const f32x4*)xr + lane;
#pragma unroll
            for (int j = 0; j < 4; ++j) { f32x4 v = x4[64 * j]; const f32x4 g = g1[64 * j]; s += (v.x * v.x + v.y * v.y) + (v.z * v.z + v.w * v.w);
                o8[64 * j] = (unsigned long long)cvt_pk_bf16(v.x * g.x, v.y * g.y) | ((unsigned long long)cvt_pk_bf16(v.z * g.z, v.w * g.w) << 32); }
        } else {
#pragma unroll
            for (int j = 0; j < 4; ++j) o8[64 * j] = 0ull;
        }
        s = wave_sum(s);
        if (lane < 16) SS0[(size_t)m * 16 + lane] = lane == 0 ? s : 0.f;
    }
}

struct EpiSwiGLU {
    static constexpr bool PERM = true, AFTER_DRAIN = false;
    bf16* act; const float* ss;
    __device__ __forceinline__ void operator()(const f32x4 (&acc)[2][2][4][2], const pg8::Unit& u, int wr, int wc, int fr, int fq) const {
        const int col0 = u.pn * 128 + wc * 32 + 8 * fq;
#pragma unroll
        for (int ai = 0; ai < 2; ++ai)
#pragma unroll
            for (int m = 0; m < 4; ++m) {
                const int r = u.pm * 256 + ai * 128 + wr * 64 + m * 16 + fr;
                const float rs = rstd_from_ss(ss, r);
                float o[8];
#pragma unroll
                for (int n = 0; n < 2; ++n)
#pragma unroll
                    for (int e = 0; e < 4; ++e) { const float g = acc[ai][0][m][n][e] * rs, up = acc[ai][1][m][n][e] * rs; o[4 * n + e] = g * up / (1.0f + ex2(-g * LOG2E)); }
                u32x4 w; w.x = cvt_pk_bf16(o[0], o[1]); w.y = cvt_pk_bf16(o[2], o[3]); w.z = cvt_pk_bf16(o[4], o[5]); w.w = cvt_pk_bf16(o[6], o[7]);
                *(u32x4*)(act + (size_t)r * FF + col0) = w;
            }
    }
};
template <int SRC_INPUTS, int HALF_SCALE, int HAS_XN> struct EpiResid {
    static constexpr bool PERM = false, AFTER_DRAIN = false;
    const float* xp; const float* xs; const float* xm; float* X; bf16* XN; const float* gnext; float* ss;
    __device__ __forceinline__ void operator()(const f32x4 (&acc)[2][2][4][2], const pg8::Unit& u, int wr, int wc, int fr, int fq) const {
        const int col0 = u.pn * 256 + wc * 32 + 4 * fq;
#pragma unroll
        for (int ai = 0; ai < 2; ++ai)
#pragma unroll
            for (int m = 0; m < 4; ++m) {
                const int r = u.pm * 256 + ai * 128 + wr * 64 + m * 16 + fr;
                const float* srow = SRC_INPUTS ? (r < MP ? xp + (size_t)r * D : (r < MO ? xs + (size_t)(r - MP) * D : (r < MX ? xm + (size_t)(r - MO) * D : nullptr))) : (X + (size_t)r * D);
                float s = 0.f;
#pragma unroll
                for (int bj = 0; bj < 2; ++bj)
#pragma unroll
                    for (int n = 0; n < 2; ++n) {
                        const int c = col0 + bj * 128 + n * 16;
                        f32x4 v = acc[ai][bj][m][n] * (HALF_SCALE ? 0.5f : 1.0f);
                        if (srow) v += *(const f32x4*)(srow + c);
                        s += (v.x * v.x + v.y * v.y) + (v.z * v.z + v.w * v.w);
                        if (r < MO) *(f32x4*)(X + (size_t)r * D + c) = v;
                        if (HAS_XN) { const f32x4 g = *(const f32x4*)(gnext + c); u32x2 w; w.x = cvt_pk_bf16(v.x * g.x, v.y * g.y); w.y = cvt_pk_bf16(v.z * g.z, v.w * g.w); *(u32x2*)(XN + (size_t)r * D + c) = w; }
                    }
                s += __shfl_xor(s, 16); s += __shfl_xor(s, 32);
                if (fq == 0) ss[(size_t)r * 16 + u.pn * 4 + wc] = s;
            }
    }
};
struct EpiWin {
    static constexpr bool PERM = false, AFTER_DRAIN = false;
    unsigned char* ws; float* out; const float* lbp; const float* bgp; const float* ss;
    template <int TYPE> __device__ __forceinline__ void run(const f32x4 (&acc)[2][2][4][2], const pg8::Unit& u, int wr, int wc, int fr, int fq, int cbase) const {
        const int col0 = u.pn * 256 + wc * 32 + 4 * fq - cbase;
#pragma unroll
        for (int ai = 0; ai < 2; ++ai)
#pragma unroll
            for (int m = 0; m < 4; ++m) {
                const int r = u.pm * 256 + ai * 128 + wr * 64 + m * 16 + fr;
                const int rlim = (TYPE == 0 || TYPE >= 6) ? MO : MX;
                if (r < rlim) {
                const float rs = rstd_from_ss(ss, r);
#pragma unroll
                for (int bj = 0; bj < 2; ++bj)
#pragma unroll
                    for (int n = 0; n < 2; ++n) {
                        const int cc = col0 + bj * 128 + n * 16;
                        const f32x4 v = acc[ai][bj][m][n] * rs;
                        if (TYPE == 0) {
                            u32x2 w; w.x = cvt_pk_bf16(v.x * QSCALE, v.y * QSCALE); w.y = cvt_pk_bf16(v.z * QSCALE, v.w * QSCALE); *(u32x2*)((bf16*)(ws + WS_QB) + (size_t)r * 512 + cc) = w;
                        } else if (TYPE == 1 || TYPE == 2) {
                            const size_t ob = TYPE == 2 ? O_PV : O_PK, os = TYPE == 2 ? O_SV : O_SK;
                            if (r < MP) { const int b = r >> 12, t = r & 4095; *(f32x4*)(out + ob + ((size_t)(b * LP + 16 + t)) * 512 + cc) = v; }
                            else if (r < MO) { *(f32x4*)(out + os + (size_t)(r - MP) * 512 + cc) = v; }
                            else { const int mm = r - MO;
#pragma unroll
                                for (int b = 0; b < 4; ++b) *(f32x4*)(out + ob + ((size_t)(b * LP + mm)) * 512 + cc) = v; }
                        } else if (TYPE == 3) {
                            const f32x4 l0 = *(const f32x4*)(lbp + cc), l1 = *(const f32x4*)(lbp + 512 + cc);
                            _Float16 h[4];
#pragma unroll
                            for (int e = 0; e < 4; ++e) { const float oml = 1.0f / (1.0f + ex2((l1[e] - l0[e]) * LOG2E));
                                h[e] = (_Float16)(oml / (1.0f + ex2(v[e] * LOG2E))); }
                            u32x2 w; w.x = (unsigned)__builtin_bit_cast(unsigned short, h[0]) | ((unsigned)__builtin_bit_cast(unsigned short, h[1]) << 16);
                            w.y = (unsigned)__builtin_bit_cast(unsigned short, h[2]) | ((unsigned)__builtin_bit_cast(unsigned short, h[3]) << 16);
                            *(u32x2*)((unsigned short*)(ws + WS_KKH) + (size_t)r * 512 + cc) = w;
                        } else if (TYPE == 4) {
                            const int h = cc >> 7, vv = cc & 127;
                            const unsigned w01 = cvt_pk_bf16(v.x, v.y), w23 = cvt_pk_bf16(v.z, v.w);
                            const bf16 e0 = (bf16)(w01 & 0xffffu), e1 = (bf16)(w01 >> 16), e2 = (bf16)(w23 & 0xffffu), e3 = (bf16)(w23 >> 16);
                            if (r < MP) { const int b = r >> 12, t = r & 4095; bf16* p = (bf16*)(ws + WS_IVTP) + ((size_t)((b * 4 + h) * 128 + vv)) * LP + 16 + t; p[0] = e0; p[LP] = e1; p[2 * LP] = e2; p[3 * LP] = e3; }
                            else if (r < MO) { const int s = (r - MP) >> 5, t = (r - MP) & 31; bf16* p = (bf16*)(ws + WS_IVTS) + ((size_t)((s * 4 + h) * 128 + vv)) * 64 + t; p[0] = e0; p[64] = e1; p[128] = e2; p[192] = e3; }
                            else { const int mm = r - MO;
#pragma unroll
                                for (int b = 0; b < 4; ++b) { bf16* p = (bf16*)(ws + WS_IVTP) + ((size_t)((b * 4 + h) * 128 + vv)) * LP + mm; p[0] = e0; p[LP] = e1; p[2 * LP] = e2; p[3 * LP] = e3; } }
                        } else if (TYPE == 5) {
                            u32x2 w; w.x = cvt_pk_bf16(v.x, v.y); w.y = cvt_pk_bf16(v.z, v.w); *(u32x2*)((bf16*)(ws + WS_QH) + (size_t)r * 512 + cc) = w;
                        } else if (TYPE == 6) {
                            float o[4];
#pragma unroll
                            for (int e = 0; e < 4; ++e) o[e] = v[e] / (1.0f + ex2(-v[e] * LOG2E));
                            u32x2 w; w.x = cvt_pk_bf16(o[0], o[1]); w.y = cvt_pk_bf16(o[2], o[3]); *(u32x2*)((bf16*)(ws + WS_SG) + (size_t)r * 512 + cc) = w;
                        } else {
                            const f32x4 bg = *(const f32x4*)(bgp + (TYPE == 8 ? 1024 : 0) + cc); float o[4];
#pragma unroll
                            for (int e = 0; e < 4; ++e) o[e] = 1.0f / (1.0f + ex2(-(v[e] + bg[e]) * LOG2E));
                            u32x2 w; w.x = cvt_pk_bf16(o[0], o[1]); w.y = cvt_pk_bf16(o[2], o[3]); *(u32x2*)((bf16*)(ws + (TYPE == 8 ? WS_GB : WS_GA)) + (size_t)r * D + cc) = w;
                        }
                    }
                }
            }
    }
    __device__ __forceinline__ void operator()(const f32x4 (&acc)[2][2][4][2], const pg8::Unit& u, int wr, int wc, int fr, int fq) const {
        const int pn = u.pn;
        if (pn < 2) run<0>(acc, u, wr, wc, fr, fq, 0);
        else if (pn < 4) run<1>(acc, u, wr, wc, fr, fq, 512);
        else if (pn < 6) run<2>(acc, u, wr, wc, fr, fq, 1024);
        else if (pn < 8) run<3>(acc, u, wr, wc, fr, fq, 1536);
        else if (pn < 10) run<4>(acc, u, wr, wc, fr, fq, 2048);
        else if (pn < 12) run<5>(acc, u, wr, wc, fr, fq, 2560);
        else if (pn < 14) run<6>(acc, u, wr, wc, fr, fq, 3072);
        else if (pn < 18) run<7>(acc, u, wr, wc, fr, fq, 3584);
        else run<8>(acc, u, wr, wc, fr, fq, 4608);
    }
};
__device__ __forceinline__ float bf2f(unsigned short h) { return __builtin_bit_cast(float, (unsigned)h << 16); }
template <int PASS> struct EpiMerge {
    static constexpr bool PERM = false, AFTER_DRAIN = false;
    bf16* ga; const bf16* gb;
    __device__ __forceinline__ void operator()(const f32x4 (&acc)[2][2][4][2], const pg8::Unit& u, int wr, int wc, int fr, int fq) const {
        const int col0 = u.pn * 256 + wc * 32 + 4 * fq;
#pragma unroll
        for (int ai = 0; ai < 2; ++ai)
#pragma unroll
            for (int m = 0; m < 4; ++m) {
                const int r = u.pm * 256 + ai * 128 + wr * 64 + m * 16 + fr;
#pragma unroll
                for (int bj = 0; bj < 2; ++bj)
#pragma unroll
                    for (int n = 0; n < 2; ++n) {
                        const int c = col0 + bj * 128 + n * 16;
                        const f32x4 v = acc[ai][bj][m][n];
                        u32x2* pa = (u32x2*)(ga + (size_t)r * D + c);
                        const u32x2 wa = *pa;
                        const float a0 = bf2f(wa.x & 0xffffu), a1 = bf2f(wa.x >> 16), a2 = bf2f(wa.y & 0xffffu), a3 = bf2f(wa.y >> 16);
                        float o0, o1, o2, o3;
                        if (PASS == 0) { o0 = a0 * v.x; o1 = a1 * v.y; o2 = a2 * v.z; o3 = a3 * v.w; }
                        else { const u32x2 wb = *(const u32x2*)(gb + (size_t)r * D + c);
                            o0 = a0 + bf2f(wb.x & 0xffffu) * v.x; o1 = a1 + bf2f(wb.x >> 16) * v.y; o2 = a2 + bf2f(wb.y & 0xffffu) * v.z; o3 = a3 + bf2f(wb.y >> 16) * v.w; }
                        u32x2 w; w.x = cvt_pk_bf16(o0, o1); w.y = cvt_pk_bf16(o2, o3); *pa = w;
                    }
            }
    }
};

__device__ __forceinline__ bf16x8 pack8(const float* f) { u32x4 w; w.x = cvt_pk_bf16(f[0], f[1]); w.y = cvt_pk_bf16(f[2], f[3]); w.z = cvt_pk_bf16(f[4], f[5]); w.w = cvt_pk_bf16(f[6], f[7]); return __builtin_bit_cast(bf16x8, w); }
__device__ __forceinline__ void attn_item(ArgsP A, int item, int lane) {
    const float* kdiag; const float* vdiag; const float* klow; const float* vlow; int qrow0, posq0, nblk, h;
    if (item < 4096) { const int b = item >> 10; h = (item >> 7) & 7; const int qt = item & 127;
        qrow0 = b * 4096 + 32 * qt; posq0 = 16 + 32 * qt; nblk = qt + 2;
        klow = A->out + O_PK + (size_t)b * LP * 512 + h * 64; vlow = A->out + O_PV + (size_t)b * LP * 512 + h * 64;
        kdiag = klow + (size_t)posq0 * 512; vdiag = vlow + (size_t)posq0 * 512;
    } else { const int id = item - 4096, s = id >> 3; h = id & 7;
        qrow0 = MP + 32 * s; posq0 = LC; nblk = 66;
        klow = A->in[I_CK] + (size_t)s * LC * 512 + h * 64; vlow = A->in[I_CV] + (size_t)s * LC * 512 + h * 64;
        kdiag = A->out + O_SK + (size_t)s * 32 * 512 + h * 64; vdiag = A->out + O_SV + (size_t)s * 32 * 512 + h * 64;
    }
    bf16* qo = (bf16*)(A->ws + WS_QB) + (size_t)qrow0 * 512 + h * 64;
    const int ql = lane & 31, hi = lane >> 5;
    bf16x8 qf[4];
#pragma unroll
    for (int s = 0; s < 4; ++s) qf[s] = *(const bf16x8*)(qo + (size_t)ql * 512 + 16 * s + 8 * hi);
    const int rA = (ql & 3) + 4 * (ql >> 3), hA = (ql >> 2) & 1, kappaA = 8 * hA + rA + (rA >= 8 ? 8 : 0);
    f32x16 o0, o1;
#pragma unroll
    for (int r = 0; r < 16; ++r) { o0[r] = 0.f; o1[r] = 0.f; }
    float R = 0.f;
    for (int j = 0; j < nblk; ++j) {
        const int pos0 = posq0 - 32 * j;
        const float* kb = j == 0 ? kdiag : klow; const float* vb = j == 0 ? vdiag : vlow;
        const int rb = j == 0 ? 0 : pos0;
        int rowA = rb + kappaA; rowA = rowA < 0 ? 0 : rowA;
        const float* kp = kb + (size_t)rowA * 512 + 8 * hi;
        f32x16 sacc;
#pragma unroll
        for (int r = 0; r < 16; ++r) sacc[r] = 0.f;
        f32x4 kv[8];
#pragma unroll
        for (int s = 0; s < 4; ++s) { kv[2 * s] = *(const f32x4*)(kp + 16 * s); kv[2 * s + 1] = *(const f32x4*)(kp + 16 * s + 4); }
        float vv[2][2][8];
#pragma unroll
        for (int st = 0; st < 2; ++st)
#pragma unroll
            for (int i = 0; i < 8; ++i) { int row = rb + 16 * st + 8 * hi + i; row = row < 0 ? 0 : row; const float* vp = vb + (size_t)row * 512 + ql; vv[st][0][i] = vp[0]; vv[st][1][i] = vp[32]; }
#pragma unroll
        for (int s = 0; s < 4; ++s) { float kk[8] = {kv[2 * s].x, kv[2 * s].y, kv[2 * s].z, kv[2 * s].w, kv[2 * s + 1].x, kv[2 * s + 1].y, kv[2 * s + 1].z, kv[2 * s + 1].w};
            sacc = __builtin_amdgcn_mfma_f32_32x32x16_bf16(pack8(kk), qf[s], sacc, 0, 0, 0); }
        float sp[16];
#pragma unroll
        for (int r = 0; r < 16; ++r) { const int kappa = 8 * hi + r + (r >= 8 ? 8 : 0);
            const bool valid = (pos0 + kappa >= 0) && (j > 0 || kappa < ql);
            const float z = sacc[r];
            const float s_ = fmaxf(z, 0.f) + lg2(1.0f + ex2(-fabsf(z)));
            sp[r] = valid ? s_ : 0.f; sacc[r] = valid ? z : -1e30f; }
        float glo = 0.f, ghi = 0.f;
#pragma unroll
        for (int r = 0; r < 8; ++r) { glo += sp[r]; ghi += sp[8 + r]; }
        const float pglo = __shfl_xor(glo, 32), pghi = __shfl_xor(ghi, 32);
        const float base_hi = R + (hi == 0 ? pghi : 0.f);
        const float base_lo = R + ghi + pghi + (hi == 0 ? pglo : 0.f);
        float pa[16];
        { float c = base_hi;
#pragma unroll
          for (int r = 15; r >= 8; --r) { c += sp[r]; pa[r] = ex2(sacc[r] - c); }
          c = base_lo;
#pragma unroll
          for (int r = 7; r >= 0; --r) { c += sp[r]; pa[r] = ex2(sacc[r] - c); } }
        R += (glo + ghi) + (pglo + pghi);
        const bf16x8 p0 = pack8(pa), p1 = pack8(pa + 8);
        o0 = __builtin_amdgcn_mfma_f32_32x32x16_bf16(pack8(vv[0][0]), p0, o0, 0, 0, 0);
        o1 = __builtin_amdgcn_mfma_f32_32x32x16_bf16(pack8(vv[0][1]), p0, o1, 0, 0, 0);
        o0 = __builtin_amdgcn_mfma_f32_32x32x16_bf16(pack8(vv[1][0]), p1, o0, 0, 0, 0);
        o1 = __builtin_amdgcn_mfma_f32_32x32x16_bf16(pack8(vv[1][1]), p1, o1, 0, 0, 0);
        if (__all(R > SB_EXIT)) break;
    }
#pragma unroll
    for (int g = 0; g < 4; ++g) {
        u32x2 w; w.x = cvt_pk_bf16(o0[4 * g], o0[4 * g + 1]); w.y = cvt_pk_bf16(o0[4 * g + 2], o0[4 * g + 3]);
        *(u32x2*)(qo + (size_t)ql * 512 + 8 * g + 4 * hi) = w;
        u32x2 w1; w1.x = cvt_pk_bf16(o1[4 * g], o1[4 * g + 1]); w1.y = cvt_pk_bf16(o1[4 * g + 2], o1[4 * g + 3]);
        *(u32x2*)(qo + (size_t)ql * 512 + 32 + 8 * g + 4 * hi) = w1;
    }
}

constexpr int HQ_P = 136, HK_P = 136, HT_P = 72, HS_P = 72;
constexpr int L_QT = 0, L_KT = L_QT + 64 * HQ_P * 2, L_KHT = L_KT + 64 * HK_P * 2, L_SC = L_KHT + 128 * HT_P * 2, L_DV = L_SC + 64 * HS_P * 2, L_PART = L_DV + 512, L_SSQ = L_PART + 2048, L_HEND = L_SSQ + 2048;
static_assert(L_HEND <= 131072, "hgrn lds");
__device__ __forceinline__ void hgrn_stream(ArgsP A, LAS unsigned char* lds, int item, int tid) {
    const int lane = tid & 63, w = __builtin_amdgcn_readfirstlane(tid >> 6), l16 = lane & 15, g = lane >> 4;
    const bool prompt = item < 16; const int sidx = prompt ? (item >> 2) : ((item - 16) >> 2), h = item & 3;
    const int nchunk = prompt ? 65 : 1;
    LAS bf16* Qt = (LAS bf16*)(lds + L_QT); LAS bf16* Kt = (LAS bf16*)(lds + L_KT); LAS bf16* KhT = (LAS bf16*)(lds + L_KHT); LAS bf16* Sc = (LAS bf16*)(lds + L_SC);
    LAS float* dv = (LAS float*)(lds + L_DV); LAS float* part = (LAS float*)(lds + L_PART); LAS float* ssq = (LAS float*)(lds + L_SSQ);
    const unsigned short* kkh = (const unsigned short*)(A->ws + WS_KKH); const bf16* qh = (const bf16*)(A->ws + WS_QH);
    bf16* sg = (bf16*)(A->ws + WS_SG);
    const int vcol = 16 * w + l16;
    const float gn = A->in[I_HGN][h * 128 + vcol];
    f32x4 S[8];
    if (prompt) {
#pragma unroll
        for (int mt = 0; mt < 8; ++mt) S[mt] = (f32x4){0.f, 0.f, 0.f, 0.f};
    } else {
        const float* st = A->in[I_ST] + (size_t)(sidx * 4 + h) * 16384;
#pragma unroll
        for (int mt = 0; mt < 8; ++mt)
#pragma unroll
            for (int j = 0; j < 4; ++j) S[mt][j] = st[(size_t)(16 * mt + 4 * g + j) * 128 + vcol];
    }
    const int kch = tid & 127, tq = tid >> 7;
    for (int c = 0; c < nchunk; ++c) {
        int row0, nvalid, pos0; bool wr_out;
        if (prompt) { if (c == 0) { row0 = MO; nvalid = 16; pos0 = 0; wr_out = false; } else { row0 = sidx * 4096 + 64 * (c - 1); nvalid = 64; pos0 = 16 + 64 * (c - 1); wr_out = true; } }
        else { row0 = MP + 32 * sidx; nvalid = 32; pos0 = 0; wr_out = true; }
        const bf16* ivt = prompt ? ((const bf16*)(A->ws + WS_IVTP) + ((size_t)((sidx * 4 + h) * 128 + vcol)) * LP + pos0) : ((const bf16*)(A->ws + WS_IVTS) + ((size_t)((sidx * 4 + h) * 128 + vcol)) * 64);
        bf16x8 biv[2];
#pragma unroll
        for (int ss = 0; ss < 2; ++ss) { if (32 * ss + 8 * g < nvalid) biv[ss] = *(const bf16x8*)(ivt + 32 * ss + 8 * g); else biv[ss] = (bf16x8){0, 0, 0, 0, 0, 0, 0, 0}; }
        {
            float kk[16], qv[16], cb[16]; float run = 0.f;
#pragma unroll
            for (int i = 0; i < 16; ++i) { const int t = 16 * tq + i;
                if (t < nvalid) { const size_t off = (size_t)(row0 + t) * 512 + h * 128 + kch; kk[i] = (float)__builtin_bit_cast(_Float16, kkh[off]); qv[i] = bf2f(qh[off]); } else { kk[i] = 0.f; qv[i] = 0.f; } }
#pragma unroll
            for (int i = 0; i < 16; ++i) { run += lg2(1.0f - kk[i]); cb[i] = run; }
            part[tq * 128 + kch] = run;
            __syncthreads();
            const float p0 = part[kch], p1 = part[128 + kch], p2 = part[256 + kch], p3 = part[384 + kch];
            const float off = (tq > 0 ? p0 : 0.f) + (tq > 1 ? p1 : 0.f) + (tq > 2 ? p2 : 0.f), btot = (p0 + p1) + (p2 + p3);
            if (tq == 0) dv[kch] = ex2(btot);
            float kh8[16];
#pragma unroll
            for (int i = 0; i < 16; ++i) { const int t = 16 * tq + i; const float b = off + cb[i];
                const unsigned qk = cvt_pk_bf16(qv[i] * ex2(b), kk[i] * ex2(-b));
                Qt[t * HQ_P + kch] = (bf16)(qk & 0xffffu); Kt[t * HK_P + kch] = (bf16)(qk >> 16);
                kh8[i] = kk[i] * ex2(btot - b); }
            *(LAS bf16x8*)(KhT + kch * HT_P + 16 * tq) = pack8(kh8); *(LAS bf16x8*)(KhT + kch * HT_P + 16 * tq + 8) = pack8(kh8 + 8);
        }
        __syncthreads();
#pragma unroll
        for (int q = 0; q < 2; ++q) { const int id = 2 * w + q, mt = id >> 2, nt = id & 3;
            f32x4 sc = {0.f, 0.f, 0.f, 0.f};
            if (mt >= nt) {
#pragma unroll
                for (int ks = 0; ks < 4; ++ks) { const bf16x8 a = *(const LAS bf16x8*)(Qt + (16 * mt + l16) * HQ_P + 32 * ks + 8 * g), b = *(const LAS bf16x8*)(Kt + (16 * nt + l16) * HK_P + 32 * ks + 8 * g);
                    sc = __builtin_amdgcn_mfma_f32_16x16x32_bf16(a, b, sc, 0, 0, 0); }
            }
#pragma unroll
            for (int j = 0; j < 4; ++j) { const int t = 16 * mt + 4 * g + j, s = 16 * nt + l16; const float v = (t >= s) ? sc[j] : 0.f;
                Sc[t * HS_P + s] = (bf16)(cvt_pk_bf16(v, 0.f) & 0xffffu); }
        }
        __syncthreads();
        bf16x8 bs[4];
#pragma unroll
        for (int ks = 0; ks < 4; ++ks) { u32x4 t; t.x = cvt_pk_bf16(S[2 * ks][0], S[2 * ks][1]); t.y = cvt_pk_bf16(S[2 * ks][2], S[2 * ks][3]); t.z = cvt_pk_bf16(S[2 * ks + 1][0], S[2 * ks + 1][1]); t.w = cvt_pk_bf16(S[2 * ks + 1][2], S[2 * ks + 1][3]); bs[ks] = __builtin_bit_cast(bf16x8, t); }
        f32x4 o[4];
#pragma unroll
        for (int mt = 0; mt < 4; ++mt) { f32x4 a4 = {0.f, 0.f, 0.f, 0.f};
#pragma unroll
            for (int ss = 0; ss < 2; ++ss) { const bf16x8 a = *(const LAS bf16x8*)(Sc + (16 * mt + l16) * HS_P + 32 * ss + 8 * g); a4 = __builtin_amdgcn_mfma_f32_16x16x32_bf16(a, biv[ss], a4, 0, 0, 0); }
#pragma unroll
            for (int ks = 0; ks < 4; ++ks) { const u32x2 lo = *(const LAS u32x2*)(Qt + (16 * mt + l16) * HQ_P + 32 * ks + 4 * g), hi2 = *(const LAS u32x2*)(Qt + (16 * mt + l16) * HQ_P + 32 * ks + 16 + 4 * g);
                u32x4 t; t.x = lo.x; t.y = lo.y; t.z = hi2.x; t.w = hi2.y; a4 = __builtin_amdgcn_mfma_f32_16x16x32_bf16(__builtin_bit_cast(bf16x8, t), bs[ks], a4, 0, 0, 0); }
            o[mt] = a4; }
#pragma unroll
        for (int mt = 0; mt < 8; ++mt) { const f32x4 d4 = *(const LAS f32x4*)(dv + 16 * mt + 4 * g); f32x4 a4 = S[mt] * d4;
#pragma unroll
            for (int ss = 0; ss < 2; ++ss) { const bf16x8 a = *(const LAS bf16x8*)(KhT + (16 * mt + l16) * HT_P + 32 * ss + 8 * g); a4 = __builtin_amdgcn_mfma_f32_16x16x32_bf16(a, biv[ss], a4, 0, 0, 0); }
            S[mt] = a4; }
        if (wr_out) {
#pragma unroll
            for (int mt = 0; mt < 4; ++mt)
#pragma unroll
                for (int j = 0; j < 4; ++j) { float q2 = o[mt][j] * o[mt][j]; q2 += __shfl_xor(q2, 1); q2 += __shfl_xor(q2, 2); q2 += __shfl_xor(q2, 4); q2 += __shfl_xor(q2, 8);
                    if (l16 == 0) ssq[(16 * mt + 4 * g + j) * 8 + w] = q2; }
        }
        __syncthreads();
        if (wr_out) {
#pragma unroll
            for (int mt = 0; mt < 4; ++mt)
#pragma unroll
                for (int j = 0; j < 4; ++j) { const int t = 16 * mt + 4 * g + j;
                    if (t < nvalid) { const f32x4 s0 = *(const LAS f32x4*)(ssq + t * 8), s1 = *(const LAS f32x4*)(ssq + t * 8 + 4);
                        const float tot = ((s0.x + s0.y) + (s0.z + s0.w)) + ((s1.x + s1.y) + (s1.z + s1.w));
                        const float rs = rsqrtf(tot * (1.0f / 128.0f) + EPS);
                        bf16* p = sg + (size_t)(row0 + t) * 512 + h * 128 + vcol;
                        const float val = o[mt][j] * rs * gn * bf2f(*p);
                        *p = (bf16)(cvt_pk_bf16(val, 0.f) & 0xffffu); } }
        }
    }
    float* so = A->out + (prompt ? O_PH : O_SH) + (size_t)(sidx * 4 + h) * 16384;
#pragma unroll
    for (int mt = 0; mt < 8; ++mt)
#pragma unroll
        for (int j = 0; j < 4; ++j) so[(size_t)(16 * mt + 4 * g + j) * 128 + vcol] = S[mt][j];
    __syncthreads();
}

__global__ void __launch_bounds__(NTHREADS, 2) mega_fwd(Args Aunused) {
    extern __shared__ __attribute__((aligned(16))) unsigned char lds_raw[];
    LAS unsigned char* lds = (LAS unsigned char*)lds_raw;
    cg::grid_group grid = cg::this_grid();
#define TIDL ({ int t_ = threadIdx.x; asm volatile("" : "+v"(t_)); t_; })
#define LANE (tid & 63)
#define WAVE (__builtin_amdgcn_readfirstlane(tid >> 6))
#define GX ((int)gridDim.x)
#define BX ((int)blockIdx.x)
#define SSP(A, i) ((float*)((A)->ws + WS_SS + (size_t)(i) * SS_BYTES))

    { const int tid = TIDL; p0_phase(argsp(), lds, WAVE, LANE); }
    grid.sync();
    { ArgsP A = argsp(); unsigned char* ws = A->ws; pg8::Gemm g{(const bf16*)(ws + WS_XN), (const bf16*)(ws + WS_WGU1), MPAD, 2 * FF, D}; pg8::StaticOrder S; S.init(MPAD, 2 * FF, GX, BX); EpiSwiGLU E{(bf16*)(ws + WS_ACT), SSP(A, 0)};
      pg8::gemm_phase<EpiSwiGLU, pg8::StaticOrder, true, true>(lds, g, S, E); }
    grid.sync();
    { ArgsP A = argsp(); unsigned char* ws = A->ws; pg8::Gemm g{(const bf16*)(ws + WS_ACT), (const bf16*)(ws + WS_WD1), MPAD, D, FF}; pg8::StaticOrder S; S.init(MPAD, D, GX, BX);
      EpiResid<1, 1, 1> E{A->in[I_XP], A->in[I_XS], A->in[I_META], A->out, (bf16*)(ws + WS_XN), A->in[I_NMIX], SSP(A, 1)};
      pg8::gemm_phase<EpiResid<1, 1, 1>, pg8::StaticOrder, true, true>(lds, g, S, E); }
    grid.sync();
    { ArgsP A = argsp(); unsigned char* ws = A->ws; pg8::Gemm g{(const bf16*)(ws + WS_XN), (const bf16*)(ws + WS_WIN), MPAD, NIN, D}; pg8::StaticOrder S; S.init(MPAD, NIN, GX, BX); EpiWin E{ws, A->out, A->in[I_LB], A->in[I_BG], SSP(A, 1)};
      pg8::gemm_phase<EpiWin, pg8::StaticOrder, true, true>(lds, g, S, E); }
    grid.sync();
    {
        const int G = GX, bx = BX; const int tid = TIDL;
        if (G >= 96) {
            if (bx < 48) hgrn_stream(argsp(), lds, bx, tid);
            else { const int ws_ = (bx - 48) * NWAVES + WAVE, nws = (G - 48) * NWAVES; for (int it = ws_; it < 4160; it += nws) attn_item(argsp(), it, LANE); }
        } else {
            for (int it = bx; it < 48; it += G) hgrn_stream(argsp(), lds, it, tid);
            for (int it = bx * NWAVES + WAVE; it < 4160; it += G * NWAVES) attn_item(argsp(), it, LANE);
        }
    }
    grid.sync();
    { ArgsP A = argsp(); unsigned char* ws = A->ws; pg8::Gemm g{(const bf16*)(ws + WS_QB), (const bf16*)(ws + WS_WA), MO, D, 512}; pg8::StaticOrder S; S.init(MO, D, GX, BX); EpiMerge<0> E{(bf16*)(ws + WS_GA), (const bf16*)(ws + WS_GB)};
      pg8::gemm_phase<EpiMerge<0>, pg8::StaticOrder, true, true>(lds, g, S, E); }
    __threadfence(); __syncthreads();
    { ArgsP A = argsp(); unsigned char* ws = A->ws; pg8::Gemm g{(const bf16*)(ws + WS_SG), (const bf16*)(ws + WS_WB), MO, D, 512}; pg8::StaticOrder S; S.init(MO, D, GX, BX); EpiMerge<1> E{(bf16*)(ws + WS_GA), (const bf16*)(ws + WS_GB)};
      pg8::gemm_phase<EpiMerge<1>, pg8::StaticOrder, true, true>(lds, g, S, E); }
    grid.sync();
    { ArgsP A = argsp(); unsigned char* ws = A->ws; pg8::Gemm g{(const bf16*)(ws + WS_GA), (const bf16*)(ws + WS_WOUT), MO, D, D}; pg8::StaticOrder S; S.init(MO, D, GX, BX);
      EpiResid<0, 0, 1> E{nullptr, nullptr, nullptr, A->out, (bf16*)(ws + WS_XN), A->in[I_N2], SSP(A, 2)};
      pg8::gemm_phase<EpiResid<0, 0, 1>, pg8::StaticOrder, true, true>(lds, g, S, E); }
    grid.sync();
    { ArgsP A = argsp(); unsigned char* ws = A->ws; pg8::Gemm g{(const bf16*)(ws + WS_XN), (const bf16*)(ws + WS_WGU2), MO, 2 * FF, D}; pg8::StaticOrder S; S.init(MO, 2 * FF, GX, BX); EpiSwiGLU E{(bf16*)(ws + WS_ACT), SSP(A, 2)};
      pg8::gemm_phase<EpiSwiGLU, pg8::StaticOrder, true, true>(lds, g, S, E); }
    grid.sync();
    { ArgsP A = argsp(); unsigned char* ws = A->ws; pg8::Gemm g{(const bf16*)(ws + WS_ACT), (const bf16*)(ws + WS_WD2), MO, D, FF}; pg8::StaticOrder S; S.init(MO, D, GX, BX);
      EpiResid<0, 1, 0> E{nullptr, nullptr, nullptr, A->out, nullptr, nullptr, SSP(A, 3)};
      pg8::gemm_phase<EpiResid<0, 1, 0>, pg8::StaticOrder, true, true>(lds, g, S, E); }
    grid.sync();
    {
        const int tid = TIDL; ArgsP A = argsp(); float* X = A->out; const float* SS3 = SSP(A, 3);
        const int gw = BX * NWAVES + WAVE, NGW = GX * NWAVES; const f32x4* gf = (const f32x4*)A->in[I_NF] + LANE;
        for (int m = gw; m < MO; m += NGW) { const float rs = rstd_from_ss(SS3, m); f32x4* x4 = (f32x4*)(X + (size_t)m * D) + LANE;
#pragma unroll
            for (int j = 0; j < 4; ++j) { f32x4 v = x4[64 * j]; const f32x4 gg = gf[64 * j]; x4[64 * j] = v * rs * gg; } }
    }
}

extern "C" void kernel_launch(void* const* d_in, const int* in_sizes, int n_in, void* d_out, int out_size, void* d_ws, size_t ws_size, hipStream_t stream) {
    static int grid = 0;
    if (grid == 0) {
        if (n_in != 23 || ws_size < WS_END || out_size != 34930688) { fprintf(stderr, "kernel_launch: unexpected problem shape (n_in %d, out %d, ws %zu)\n", n_in, out_size, ws_size); grid = -1; return; }
        int dev = 0, cus = 0, per_cu = 0;
        hipGetDevice(&dev); hipDeviceGetAttribute(&cus, hipDeviceAttributeMultiprocessorCount, dev);
        hipFuncSetAttribute((const void*)mega_fwd, hipFuncAttributeMaxDynamicSharedMemorySize, LDS_BYTES);
        hipOccupancyMaxActiveBlocksPerMultiprocessor(&per_cu, (const void*)mega_fwd, NTHREADS, LDS_BYTES);
        if (per_cu < 1) { fprintf(stderr, "kernel_launch: occupancy query returned %d\n", per_cu); per_cu = 1; }
        (void)hipGetLastError();
        grid = cus * per_cu;
    }
    if (grid < 0) return;
    Args a{};
    for (int i = 0; i < 23; ++i) a.in[i] = (const float*)d_in[i];
    a.out = (float*)d_out; a.ws = (unsigned char*)d_ws;
    void* args[] = {&a};
    hipError_t e = hipLaunchCooperativeKernel((const void*)mega_fwd, dim3(grid), dim3(NTHREADS), args, LDS_BYTES, stream);
    if (e != hipSuccess) fprintf(stderr, "cooperative launch failed: %s (grid %d)\n", hipGetErrorString(e), grid);
}
```

```cpp
#include <hip/hip_runtime.h>
#include <hip/hip_cooperative_groups.h>
#include <cstdio>
#include <cstdint>
namespace cg = cooperative_groups;
namespace pg8 {
#define PG8_LAS __attribute__((address_space(3)))
typedef unsigned short bf16_t;
typedef short bf16x8 __attribute__((ext_vector_type(8)));
typedef float f32x4 __attribute__((ext_vector_type(4)));
typedef unsigned u32x4 __attribute__((ext_vector_type(4)));
constexpr int BM = 256, BK = 64, HALF = 128, HTB = HALF * BK * 2  , STAGE_BYTES = 8 * HTB, NXCD = 8, WGM = 8;

__host__ __device__ __forceinline__ int lds_byte(int r, int c) { const int st = (r >> 4) * 2 + (c >> 5), rr = r & 15, cc = c & 31, ob = rr * 64 + cc * 2; return st * 1024 + (ob ^ (((ob >> 9) & 1) << 5)); }
__host__ __device__ __forceinline__ void stage_rc(int b, int& R, int& C) { const int st = b / 1024, sb = b % 1024, swz = sb ^ (((sb >> 9) & 1) << 5); R = (st >> 1) * 16 + swz / 64; C = (st & 1) * 32 + (swz % 64) / 2; }
__host__ __device__ __forceinline__ int perm32(int rho) { const int n = rho >> 4, i = rho & 15; return 8 * (i >> 2) + 4 * n + (i & 3); }

struct Unit { int pm, pn; };
struct Gemm { const bf16_t* A; const bf16_t* Bt; int M, N, K; };

struct StaticOrder {
    int nM, nN, nwg, G, c;
    __host__ __device__ void init(int M, int N, int G_, int c_) { nM = M / BM; nN = N / BM; nwg = nM * nN; G = G_; c = c_; }
    __host__ __device__ bool next(int i, Unit& u) const {
        const long L = (long)i * G + c; if (L >= nwg) return false;
        int wgid = (int)L; { const int q = nwg / NXCD, r = nwg % NXCD, xcd = wgid % NXCD, off = wgid / NXCD; wgid = (xcd < r ? xcd * (q + 1) : r * (q + 1) + (xcd - r) * q) + off; }
        const int nig = WGM * nN, gid = wgid / nig, fm = gid * WGM, gsz = (nM - fm) < WGM ? (nM - fm) : WGM;
        u.pm = fm + ((wgid % nig) % gsz); u.pn = (wgid % nig) / gsz; return true;
    }
    __device__ __forceinline__ void a_ready(const Unit&) const {}
    __device__ __forceinline__ void done(const Unit&) const {}
};

__device__ __forceinline__ unsigned cvt_pk_bf16(float lo, float hi) { unsigned r; asm volatile("v_cvt_pk_bf16_f32 %0, %1, %2" : "=v"(r) : "v"(lo), "v"(hi)); return r; }
template <class Epi, class Sched, bool ALIGN_EPI = false, bool SP2 = false>
__device__ __forceinline__ void gemm_phase(PG8_LAS unsigned char* lds, const Gemm g, const Sched S, const Epi E) {
    int tid_l = threadIdx.x; asm volatile("" : "+v"(tid_l)); const int tid = tid_l, wid = __builtin_amdgcn_readfirstlane(tid >> 6), lane = tid & 63, wr = wid >> 2, wc = wid & 3, fr = lane & 15, fq = lane >> 4;
    const int K = g.K, nt = K / BK;
    unsigned voffA[2], voffB[2];
#pragma unroll
    for (int i = 0; i < 2; ++i) { int R, C; stage_rc(tid * 16 + i * 8192, R, C); const int Rb = Epi::PERM ? ((R & ~31) + perm32(R & 31)) : R;
        voffA[i] = (unsigned)(R * K + C) * 2u; voffB[i] = (unsigned)(Rb * K + C) * 2u; }
    const size_t kstep = (size_t)(BK * 2);
    const size_t hstep = (size_t)HALF * K * 2;
    const size_t tstep = 2 * hstep;
    const unsigned ldsw = (unsigned)wid * 1024u;
    const int aoff = lds_byte(wr * 64 + fr, fq * 8), boff = lds_byte(wc * 32 + fr, fq * 8);
#define PG8_SA(b, h) (((b) * 2 + (h)) * HTB)
#define PG8_SB(b, h) ((4 + (b) * 2 + (h)) * HTB)
#define PG8_STAGE(bufoff, gbase, voff) do { _Pragma("unroll") for (int _i = 0; _i < 2; ++_i) \
        __builtin_amdgcn_global_load_lds((const unsigned*)((const char*)(gbase) + (voff)[_i]), (PG8_LAS unsigned*)(lds + (bufoff) + ldsw + _i * 8192), 16, 0, 0); } while (0)
#define PG8_LDA(dst, b, h) do { _Pragma("unroll") for (int m = 0; m < 4; ++m) _Pragma("unroll") for (int k = 0; k < 2; ++k) dst[m][k] = *(const PG8_LAS bf16x8*)(lds + PG8_SA(b, h) + aoff + m * 2048 + k * 1024); } while (0)
#define PG8_LDB(dst, b, h) do { _Pragma("unroll") for (int n = 0; n < 2; ++n) _Pragma("unroll") for (int k = 0; k < 2; ++k) dst[n][k] = *(const PG8_LAS bf16x8*)(lds + PG8_SB(b, h) + boff + n * 2048 + k * 1024); } while (0)
#define PG8_MMA(ai, bj, At, Bt) do { __builtin_amdgcn_s_setprio(1); _Pragma("unroll") for (int m = 0; m < 4; ++m) _Pragma("unroll") for (int n = 0; n < 2; ++n) _Pragma("unroll") for (int k = 0; k < 2; ++k) \
        acc[ai][bj][m][n] = __builtin_amdgcn_mfma_f32_16x16x32_bf16(Bt[n][k], At[m][k], acc[ai][bj][m][n], 0, 0, 0); __builtin_amdgcn_s_setprio(0); } while (0)
#define PG8_WAIT_V(n) asm volatile("s_waitcnt vmcnt(" #n ")" ::: "memory")
#define PG8_WAIT_L(n) asm volatile("s_waitcnt lgkmcnt(" #n ")" ::: "memory")
#define PG8_BAR __builtin_amdgcn_s_barrier()
#define PG8_SCHED __builtin_amdgcn_sched_barrier(0)
    Unit cur, nxt; int ui = 0;
    if (!S.next(0, cur)) return;
    f32x4 acc[2][2][4][2];
#pragma unroll
    for (int a = 0; a < 2; ++a)
#pragma unroll
        for (int b = 0; b < 2; ++b)
#pragma unroll
            for (int m = 0; m < 4; ++m)
#pragma unroll
                for (int n = 0; n < 2; ++n) acc[a][b][m][n] = (f32x4){0.f, 0.f, 0.f, 0.f};
    bf16x8 At[4][2], B0[2][2], B1[2][2];
    const char* cA = (const char*)g.A + (size_t)cur.pm * tstep; const char* cB = (const char*)g.Bt + (size_t)cur.pn * tstep;
    S.a_ready(cur);
    if constexpr (SP2) {
        PG8_STAGE(PG8_SB(0, 0), cB, voffB); PG8_STAGE(PG8_SB(0, 1), cB + hstep, voffB); PG8_STAGE(PG8_SA(0, 0), cA, voffA); PG8_STAGE(PG8_SA(0, 1), cA + hstep, voffA);
        if (wr == 1) PG8_BAR;
        PG8_WAIT_V(2); PG8_BAR;
        PG8_STAGE(PG8_SB(1, 0), cB + kstep, voffB); PG8_STAGE(PG8_SA(1, 0), cA + kstep, voffA); PG8_STAGE(PG8_SB(1, 1), cB + hstep + kstep, voffB);
        PG8_WAIT_V(6); PG8_BAR;
    } else {
        PG8_STAGE(PG8_SB(0, 0), cB, voffB); PG8_STAGE(PG8_SA(0, 0), cA, voffA); PG8_STAGE(PG8_SB(0, 1), cB + hstep, voffB); PG8_STAGE(PG8_SA(0, 1), cA + hstep, voffA);
        if (wr == 1) PG8_BAR;
        PG8_WAIT_V(4); PG8_BAR;
        PG8_STAGE(PG8_SB(1, 0), cB + kstep, voffB); PG8_STAGE(PG8_SA(1, 0), cA + kstep, voffA); PG8_STAGE(PG8_SB(1, 1), cB + hstep + kstep, voffB);
        PG8_WAIT_V(6); PG8_BAR;
    }
    for (;;) {
        const bool has_next = S.next(ui + 1, nxt);
        const char* nA = has_next ? (const char*)g.A + (size_t)nxt.pm * tstep : cA; const char* nB = has_next ? (const char*)g.Bt + (size_t)nxt.pn * tstep : cB;
        for (int t = 0; t < nt; t += 2) {
            const bool last = (t == nt - 2);
            const char* a1 = cA + (size_t)(t + 1) * kstep;
            const char* a2 = last ? nA : cA + (size_t)(t + 2) * kstep; const char* b2 = last ? nB : cB + (size_t)(t + 2) * kstep;
            const char* a3 = a2 + kstep; const char* b3 = b2 + kstep;
            if (last && has_next) S.a_ready(nxt);
            if constexpr (SP2) {
            PG8_LDB(B0, 0, 0); PG8_LDB(B1, 0, 1); PG8_SCHED; PG8_LDA(At, 0, 0); PG8_STAGE(PG8_SA(1, 1), a1 + hstep, voffA);
            PG8_WAIT_V(8); PG8_WAIT_L(0); PG8_BAR; PG8_MMA(0, 0, At, B0); PG8_MMA(0, 1, At, B1); PG8_BAR; PG8_SCHED;
            PG8_LDA(At, 0, 1); PG8_STAGE(PG8_SB(0, 0), b2, voffB); PG8_STAGE(PG8_SB(0, 1), b2 + hstep, voffB); PG8_STAGE(PG8_SA(0, 0), a2, voffA);
            PG8_WAIT_V(8); PG8_WAIT_L(0); PG8_BAR; PG8_MMA(1, 0, At, B0); PG8_MMA(1, 1, At, B1); PG8_BAR; PG8_SCHED;
            PG8_LDB(B0, 1, 0); PG8_LDB(B1, 1, 1); PG8_SCHED; PG8_LDA(At, 1, 0); PG8_STAGE(PG8_SA(0, 1), a2 + hstep, voffA);
            PG8_WAIT_V(8); PG8_WAIT_L(0); PG8_BAR; PG8_MMA(0, 0, At, B0); PG8_MMA(0, 1, At, B1); PG8_BAR; PG8_SCHED;
            PG8_LDA(At, 1, 1); PG8_STAGE(PG8_SB(1, 0), b3, voffB); PG8_STAGE(PG8_SB(1, 1), b3 + hstep, voffB); PG8_STAGE(PG8_SA(1, 0), a3, voffA);
            PG8_WAIT_V(8); PG8_WAIT_L(0); PG8_BAR; PG8_MMA(1, 0, At, B0); PG8_MMA(1, 1, At, B1); PG8_BAR; PG8_SCHED;
            } else {
            PG8_LDB(B0, 0, 0); PG8_SCHED; PG8_LDA(At, 0, 0); PG8_STAGE(PG8_SA(1, 1), a1 + hstep, voffA);
            PG8_WAIT_L(8); PG8_BAR; PG8_WAIT_L(0); PG8_MMA(0, 0, At, B0); PG8_BAR; PG8_SCHED;
            PG8_LDB(B1, 0, 1); PG8_STAGE(PG8_SB(0, 0), b2, voffB);
            PG8_BAR; PG8_WAIT_L(0); PG8_MMA(0, 1, At, B1); PG8_BAR;
            PG8_LDA(At, 0, 1); PG8_STAGE(PG8_SA(0, 0), a2, voffA);
            PG8_BAR; PG8_WAIT_L(0); PG8_MMA(1, 0, At, B0); PG8_BAR; PG8_SCHED;
            PG8_STAGE(PG8_SB(0, 1), b2 + hstep, voffB);
            PG8_WAIT_V(6); PG8_BAR; PG8_MMA(1, 1, At, B1); PG8_BAR;
            PG8_LDB(B0, 1, 0); PG8_SCHED; PG8_LDA(At, 1, 0); PG8_STAGE(PG8_SA(0, 1), a2 + hstep, voffA);
            PG8_WAIT_L(8); PG8_BAR; PG8_WAIT_L(0); PG8_MMA(0, 0, At, B0); PG8_BAR; PG8_SCHED;
            PG8_LDB(B1, 1, 1); PG8_STAGE(PG8_SB(1, 0), b3, voffB);
            PG8_BAR; PG8_WAIT_L(0); PG8_MMA(0, 1, At, B1); PG8_BAR;
            PG8_LDA(At, 1, 1); PG8_STAGE(PG8_SA(1, 0), a3, voffA);
            PG8_BAR; PG8_WAIT_L(0); PG8_MMA(1, 0, At, B0); PG8_BAR; PG8_SCHED;
            PG8_STAGE(PG8_SB(1, 1), b3 + hstep, voffB);
            PG8_WAIT_V(6); PG8_BAR; PG8_MMA(1, 1, At, B1); PG8_BAR;
            }
        }
        if constexpr (ALIGN_EPI) { if (wr == 0) PG8_BAR; }
        if constexpr (!Epi::AFTER_DRAIN) { E(acc, cur, wr, wc, fr, fq); S.done(cur); }
        if (!has_next) break;
#pragma unroll
        for (int a = 0; a < 2; ++a)
#pragma unroll
            for (int b = 0; b < 2; ++b)
#pragma unroll
                for (int m = 0; m < 4; ++m)
#pragma unroll
                    for (int n = 0; n < 2; ++n) acc[a][b][m][n] = (f32x4){0.f, 0.f, 0.f, 0.f};
        cur = nxt; cA = nA; cB = nB; ++ui;
        if constexpr (ALIGN_EPI) { if (wr == 1) PG8_BAR; }
    }
    PG8_WAIT_V(0);
    if constexpr (!ALIGN_EPI) { if (wr == 0) PG8_BAR; }
    PG8_BAR;
    if constexpr (Epi::AFTER_DRAIN) { E.fused(acc, cur, wr, wc, fr, fq, lds, wid, lane); S.done(cur); }
#undef PG8_SA
#undef PG8_SB
#undef PG8_STAGE
#undef PG8_LDA
#undef PG8_LDB
#undef PG8_MMA
#undef PG8_WAIT_V
#undef PG8_WAIT_L
#undef PG8_BAR
#undef PG8_SCHED
}
}

#define LAS __attribute__((address_space(3)))
typedef unsigned short bf16;
typedef float f32x4 __attribute__((ext_vector_type(4)));
typedef float f32x16 __attribute__((ext_vector_type(16)));
typedef short bf16x8 __attribute__((ext_vector_type(8)));
typedef unsigned u32x4 __attribute__((ext_vector_type(4)));
typedef unsigned u32x2 __attribute__((ext_vector_type(2)));
typedef float f32x2 __attribute__((ext_vector_type(2)));
using pg8::cvt_pk_bf16;

constexpr int NWAVES = 8, NTHREADS = 512;
constexpr int D = 1024, FF = 2816, NIN = 5632;
constexpr int MP = 16384;
constexpr int MS = 256;
constexpr int MO = MP + MS;
constexpr int MX = MO + 16;
constexpr int MPAD = 16896;
constexpr int LP = 4112;
constexpr int LC = 2064;
constexpr float EPS = 1e-6f;
constexpr float LOG2E = 1.4426950408889634f;
constexpr float QSCALE = 0.125f * LOG2E;
constexpr float SB_EXIT = 152.0f;

constexpr size_t O_YP = 0, O_YS = 16777216, O_PK = 17039360, O_PV = 25460736, O_PH = 33882112, O_SK = 34144256, O_SV = 34275328, O_SH = 34406400;
constexpr size_t WS_WGU1 = 0, WS_WD1 = 11534336, WS_WIN = 17301504, WS_WA = 28835840, WS_WB = 29884416, WS_WOUT = 30932992, WS_WGU2 = 33030144, WS_WD2 = 44564480;
constexpr size_t WS_SS = 50331648, SS_BYTES = (size_t)MPAD * 16 * 4;
constexpr size_t WS_XN = 54657024, WS_ACT = 89260032;
constexpr size_t WS_KKH = 184418304, WS_QB = 201719808, WS_QH = 219021312, WS_IVTP = 236322816, WS_IVTS = 253165568, WS_END = 253689856;
constexpr size_t WS_GA = WS_ACT, WS_GB = WS_ACT + 34603008, WS_SG = WS_ACT + 69206016;
constexpr int LDS_BYTES = 147456;

struct Args { const float* in[23]; float* out; unsigned char* ws; };
typedef const Args __attribute__((address_space(4)))* ArgsP;
__device__ __forceinline__ ArgsP argsp() { ArgsP p = (ArgsP)__builtin_amdgcn_kernarg_segment_ptr(); asm volatile("" : "+s"(p)); return p; }
enum { I_XP = 0, I_XS, I_CK, I_CV, I_ST, I_META, I_N1, I_WG1, I_WU1, I_WD1, I_NMIX, I_WIN, I_BG, I_LB, I_HGN, I_WA, I_WB, I_WOUT, I_N2, I_WG2, I_WU2, I_WD2, I_NF };

__device__ __forceinline__ float wave_sum(float v) {
#pragma unroll
    for (int o = 1; o < 64; o <<= 1) v += __shfl_xor(v, o);
    return v;
}
__device__ __forceinline__ float ex2(float x) { return __builtin_amdgcn_exp2f(x); }
__device__ __forceinline__ float lg2(float x) { return __builtin_amdgcn_logf(x); }
__device__ __forceinline__ float sigmoidf_(float x) { return 1.0f / (1.0f + ex2(-x * LOG2E)); }
__device__ __forceinline__ float rstd_from_ss(const float* ss, int r) {
    const f32x4* p = (const f32x4*)(ss + (size_t)r * 16);
    f32x4 a = p[0], b = p[1], c = p[2], d = p[3];
    float s = ((a.x + a.y) + (a.z + a.w)) + ((b.x + b.y) + (b.z + b.w)) + ((c.x + c.y) + (c.z + c.w)) + ((d.x + d.y) + (d.z + d.w));
    return rsqrtf(s * (1.0f / 1024.0f) + EPS);
}
__device__ __forceinline__ const float* xin_row(ArgsP A, int r) {
    if (r < MP) return A->in[I_XP] + (size_t)r * D;
    if (r < MO) return A->in[I_XS] + (size_t)(r - MP) * D;
    if (r < MX) return A->in[I_META] + (size_t)(r - MO) * D;
    return nullptr;
}

__device__ __forceinline__ void p0_transpose_item(const float* W, int K, int N, bf16* WT, int il, LAS float* scr, int item, int lane) {
    const int nblk = N / 32, kb = item / nblk, nb = item % nblk, k0 = 64 * kb, n0 = 32 * nb;
#pragma unroll 8
    for (int i = 0; i < 32; ++i) { const int kk = 2 * i + (lane >> 5); scr[kk * 33 + (lane & 31)] = W[(size_t)(k0 + kk) * N + n0 + (lane & 31)]; }
    asm volatile("s_waitcnt lgkmcnt(0)" ::: "memory");
    const int rbase = il == 0 ? n0 : ((n0 >> 7) * 256 + (n0 & 127) + (il == 2 ? 128 : 0));
    const int c = lane & 7;
#pragma unroll
    for (int j = 0; j < 4; ++j) { const int n = (lane >> 3) + 8 * j; const LAS float* s = scr + (8 * c) * 33 + n;
        u32x4 o; o.x = cvt_pk_bf16(s[0 * 33], s[1 * 33]); o.y = cvt_pk_bf16(s[2 * 33], s[3 * 33]); o.z = cvt_pk_bf16(s[4 * 33], s[5 * 33]); o.w = cvt_pk_bf16(s[6 * 33], s[7 * 33]);
        *(u32x4*)(WT + (size_t)(rbase + n) * K + k0 + 8 * c) = o; }
    asm volatile("s_waitcnt lgkmcnt(0)" ::: "memory");
}
__device__ __forceinline__ void p0_phase(ArgsP A, LAS unsigned char* lds, int wave, int lane) {
    LAS float* scr = (LAS float*)(lds + wave * 16384);
    const int G = gridDim.x, gw = blockIdx.x * NWAVES + wave, NGW = G * NWAVES;
    unsigned char* ws = A->ws;
    constexpr int I_GU = (D / 64) * (FF / 32), I_DN = (FF / 64) * (D / 32), I_IN = (D / 64) * (NIN / 32), I_BR = (512 / 64) * (D / 32), I_OU = (D / 64) * (D / 32);
    constexpr int NITEMS = 4 * I_GU + 2 * I_DN + I_IN + 2 * I_BR + I_OU;
    for (int it = gw; it < NITEMS; it += NGW) {
        int r = it;
        if (r < I_GU) { p0_transpose_item(A->in[I_WG1], D, FF, (bf16*)(ws + WS_WGU1), 1, scr, r, lane); continue; } r -= I_GU;
        if (r < I_GU) { p0_transpose_item(A->in[I_WU1], D, FF, (bf16*)(ws + WS_WGU1), 2, scr, r, lane); continue; } r -= I_GU;
        if (r < I_DN) { p0_transpose_item(A->in[I_WD1], FF, D, (bf16*)(ws + WS_WD1), 0, scr, r, lane); continue; } r -= I_DN;
        if (r < I_IN) { p0_transpose_item(A->in[I_WIN], D, NIN, (bf16*)(ws + WS_WIN), 0, scr, r, lane); continue; } r -= I_IN;
        if (r < I_BR) { p0_transpose_item(A->in[I_WA], 512, D, (bf16*)(ws + WS_WA), 0, scr, r, lane); continue; } r -= I_BR;
        if (r < I_BR) { p0_transpose_item(A->in[I_WB], 512, D, (bf16*)(ws + WS_WB), 0, scr, r, lane); continue; } r -= I_BR;
        if (r < I_OU) { p0_transpose_item(A->in[I_WOUT], D, D, (bf16*)(ws + WS_WOUT), 0, scr, r, lane); continue; } r -= I_OU;
        if (r < I_GU) { p0_transpose_item(A->in[I_WG2], D, FF, (bf16*)(ws + WS_WGU2), 1, scr, r, lane); continue; } r -= I_GU;
        if (r < I_GU) { p0_transpose_item(A->in[I_WU2], D, FF, (bf16*)(ws + WS_WGU2), 2, scr, r, lane); continue; } r -= I_GU;
        p0_transpose_item(A->in[I_WD2], FF, D, (bf16*)(ws + WS_WD2), 0, scr, r, lane);
    }
    bf16* XN = (bf16*)(ws + WS_XN); float* SS0 = (float*)(ws + WS_SS);
    const f32x4* g1 = (const f32x4*)A->in[I_N1] + lane;
    for (int m = gw; m < MPAD; m += NGW) {
        const float* xr = xin_row(A, m);
        unsigned long long* o8 = (unsigned long long*)(XN + (size_t)m * D) + lane;
        float s = 0.f;
        if (xr) {
            const f32x4* x4 = (const f32x4*)xr + lane;
#pragma unroll
            for (int j = 0; j < 4; ++j) { f32x4 v = x4[64 * j]; const f32x4 g = g1[64 * j]; s += (v.x * v.x + v.y * v.y) + (v.z * v.z + v.w * v.w);
                o8[64 * j] = (unsigned long long)cvt_pk_bf16(v.x * g.x, v.y * g.y) | ((unsigned long long)cvt_pk_bf16(v.z * g.z, v.w * g.w) << 32); }
        } else {
#pragma unroll
            for (int j = 0; j < 4; ++j) o8[64 * j] = 0ull;
        }
        s = wave_sum(s);
        if (lane < 16) SS0[(size_t)m * 16 + lane] = lane == 0 ? s : 0.f;
    }
}

struct EpiSwiGLU {
    static constexpr bool PERM = true, AFTER_DRAIN = false;
    bf16* act; const float* ss;
    __device__ __forceinline__ void operator()(const f32x4 (&acc)[2][2][4][2], const pg8::Unit& u, int wr, int wc, int fr, int fq) const {
        const int col0 = u.pn * 128 + wc * 32 + 8 * fq;
#pragma unroll
        for (int ai = 0; ai < 2; ++ai)
#pragma unroll
            for (int m = 0; m < 4; ++m) {
                const int r = u.pm * 256 + ai * 128 + wr * 64 + m * 16 + fr;
                const float rs = rstd_from_ss(ss, r);
                float o[8];
#pragma unroll
                for (int n = 0; n < 2; ++n)
#pragma unroll
                    for (int e = 0; e < 4; ++e) { const float g = acc[ai][0][m][n][e] * rs, up = acc[ai][1][m][n][e] * rs; o[4 * n + e] = g * up / (1.0f + ex2(-g * LOG2E)); }
                u32x4 w; w.x = cvt_pk_bf16(o[0], o[1]); w.y = cvt_pk_bf16(o[2], o[3]); w.z = cvt_pk_bf16(o[4], o[5]); w.w = cvt_pk_bf16(o[6], o[7]);
                *(u32x4*)(act + (size_t)r * FF + col0) = w;
            }
    }
};
template <int SRC_INPUTS, int HALF_SCALE, int HAS_XN> struct EpiResid {
    static constexpr bool PERM = false, AFTER_DRAIN = false;
    const float* xp; const float* xs; const float* xm; float* X; bf16* XN; const float* gnext; float* ss;
    __device__ __forceinline__ void operator()(const f32x4 (&acc)[2][2][4][2], const pg8::Unit& u, int wr, int wc, int fr, int fq) const {
        const int col0 = u.pn * 256 + wc * 32 + 4 * fq;
#pragma unroll
        for (int ai = 0; ai < 2; ++ai)
#pragma unroll
            for (int m = 0; m < 4; ++m) {
                const int r = u.pm * 256 + ai * 128 + wr * 64 + m * 16 + fr;
                const float* srow = SRC_INPUTS ? (r < MP ? xp + (size_t)r * D : (r < MO ? xs + (size_t)(r - MP) * D : (r < MX ? xm + (size_t)(r - MO) * D : nullptr))) : (X + (size_t)r * D);
                float s = 0.f;
#pragma unroll
                for (int bj = 0; bj < 2; ++bj)
#pragma unroll
                    for (int n = 0; n < 2; ++n) {
                        const int c = col0 + bj * 128 + n * 16;
                        f32x4 v = acc[ai][bj][m][n] * (HALF_SCALE ? 0.5f : 1.0f);
                        if (srow) v += *(const f32x4*)(srow + c);
                        s += (v.x * v.x + v.y * v.y) + (v.z * v.z + v.w * v.w);
                        if (r < MO) *(f32x4*)(X + (size_t)r * D + c) = v;
                        if (HAS_XN) { const f32x4 g = *(const f32x4*)(gnext + c); u32x2 w; w.x = cvt_pk_bf16(v.x * g.x, v.y * g.y); w.y = cvt_pk_bf16(v.z * g.z, v.w * g.w); *(u32x2*)(XN + (size_t)r * D + c) = w; }
                    }
                s += __shfl_xor(s, 16); s += __shfl_xor(s, 32);
                if (fq == 0) ss[(size_t)r * 16 + u.pn * 4 + wc] = s;
            }
    }
};
struct EpiWin {
    static constexpr bool PERM = false, AFTER_DRAIN = false;
    unsigned char* ws; float* out; const float* lbp; const float* bgp; const float* ss;
    template <int TYPE> __device__ __forceinline__ void run(const f32x4 (&acc)[2][2][4][2], const pg8::Unit& u, int wr, int wc, int fr, int fq, int cbase) const {
        const int col0 = u.pn * 256 + wc * 32 + 4 * fq - cbase;
#pragma unroll
        for (int ai = 0; ai < 2; ++ai)
#pragma unroll
            for (int m = 0; m < 4; ++m) {
                const int r = u.pm * 256 + ai * 128 + wr * 64 + m * 16 + fr;
                const int rlim = (TYPE == 0 || TYPE >= 6) ? MO : MX;
                if (r < rlim) {
                const float rs = rstd_from_ss(ss, r);
#pragma unroll
                for (int bj = 0; bj < 2; ++bj)
#pragma unroll
                    for (int n = 0; n < 2; ++n) {
                        const int cc = col0 + bj * 128 + n * 16;
                        const f32x4 v = acc[ai][bj][m][n] * rs;
                        if (TYPE == 0) {
                            u32x2 w; w.x = cvt_pk_bf16(v.x * QSCALE, v.y * QSCALE); w.y = cvt_pk_bf16(v.z * QSCALE, v.w * QSCALE); *(u32x2*)((bf16*)(ws + WS_QB) + (size_t)r * 512 + cc) = w;
                        } else if (TYPE == 1 || TYPE == 2) {
                            const size_t ob = TYPE == 2 ? O_PV : O_PK, os = TYPE == 2 ? O_SV : O_SK;
                            if (r < MP) { const int b = r >> 12, t = r & 4095; *(f32x4*)(out + ob + ((size_t)(b * LP + 16 + t)) * 512 + cc) = v; }
                            else if (r < MO) { *(f32x4*)(out + os + (size_t)(r - MP) * 512 + cc) = v; }
                            else { const int mm = r - MO;
#pragma unroll
                                for (int b = 0; b < 4; ++b) *(f32x4*)(out + ob + ((size_t)(b * LP + mm)) * 512 + cc) = v; }
                        } else if (TYPE == 3) {
                            const f32x4 l0 = *(const f32x4*)(lbp + cc), l1 = *(const f32x4*)(lbp + 512 + cc);
                            _Float16 h[4];
#pragma unroll
                            for (int e = 0; e < 4; ++e) { const float oml = 1.0f / (1.0f + ex2((l1[e] - l0[e]) * LOG2E));
                                h[e] = (_Float16)(oml / (1.0f + ex2(v[e] * LOG2E))); }
                            u32x2 w; w.x = (unsigned)__builtin_bit_cast(unsigned short, h[0]) | ((unsigned)__builtin_bit_cast(unsigned short, h[1]) << 16);
                            w.y = (unsigned)__builtin_bit_cast(unsigned short, h[2]) | ((unsigned)__builtin_bit_cast(unsigned short, h[3]) << 16);
                            *(u32x2*)((unsigned short*)(ws + WS_KKH) + (size_t)r * 512 + cc) = w;
                        } else if (TYPE == 4) {
                            const int h = cc >> 7, vv = cc & 127;
                            const unsigned w01 = cvt_pk_bf16(v.x, v.y), w23 = cvt_pk_bf16(v.z, v.w);
                            const bf16 e0 = (bf16)(w01 & 0xffffu), e1 = (bf16)(w01 >> 16), e2 = (bf16)(w23 & 0xffffu), e3 = (bf16)(w23 >> 16);
                            if (r < MP) { const int b = r >> 12, t = r & 4095; bf16* p = (bf16*)(ws + WS_IVTP) + ((size_t)((b * 4 + h) * 128 + vv)) * LP + 16 + t; p[0] = e0; p[LP] = e1; p[2 * LP] = e2; p[3 * LP] = e3; }
                            else if (r < MO) { const int s = (r - MP) >> 5, t = (r - MP) & 31; bf16* p = (bf16*)(ws + WS_IVTS) + ((size_t)((s * 4 + h) * 128 + vv)) * 64 + t; p[0] = e0; p[64] = e1; p[128] = e2; p[192] = e3; }
                            else { const int mm = r - MO;
#pragma unroll
                                for (int b = 0; b < 4; ++b) { bf16* p = (bf16*)(ws + WS_IVTP) + ((size_t)((b * 4 + h) * 128 + vv)) * LP + mm; p[0] = e0; p[LP] = e1; p[2 * LP] = e2; p[3 * LP] = e3; } }
                        } else if (TYPE == 5) {
                            u32x2 w; w.x = cvt_pk_bf16(v.x, v.y); w.y = cvt_pk_bf16(v.z, v.w); *(u32x2*)((bf16*)(ws + WS_QH) + (size_t)r * 512 + cc) = w;
                        } else if (TYPE == 6) {
                            float o[4];
#pragma unroll
                            for (int e = 0; e < 4; ++e) o[e] = v[e] / (1.0f + ex2(-v[e] * LOG2E));
                            u32x2 w; w.x = cvt_pk_bf16(o[0], o[1]); w.y = cvt_pk_bf16(o[2], o[3]); *(u32x2*)((bf16*)(ws + WS_SG) + (size_t)r * 512 + cc) = w;
                        } else {
                            const f32x4 bg = *(const f32x4*)(bgp + (TYPE == 8 ? 1024 : 0) + cc); float o[4];
#pragma unroll
                            for (int e = 0; e < 4; ++e) o[e] = 1.0f / (1.0f + ex2(-(v[e] + bg[e]) * LOG2E));
                            u32x2 w; w.x = cvt_pk_bf16(o[0], o[1]); w.y = cvt_pk_bf16(o[2], o[3]); *(u32x2*)((bf16*)(ws + (TYPE == 8 ? WS_GB : WS_GA)) + (size_t)r * D + cc) = w;
                        }
                    }
                }
            }
    }
    __device__ __forceinline__ void operator()(const f32x4 (&acc)[2][2][4][2], const pg8::Unit& u, int wr, int wc, int fr, int fq) const {
        const int pn = u.pn;
        if (pn < 2) run<0>(acc, u, wr, wc, fr, fq, 0);
        else if (pn < 4) run<1>(acc, u, wr, wc, fr, fq, 512);
        else if (pn < 6) run<2>(acc, u, wr, wc, fr, fq, 1024);
        else if (pn < 8) run<3>(acc, u, wr, wc, fr, fq, 1536);
        else if (pn < 10) run<4>(acc, u, wr, wc, fr, fq, 2048);
        else if (pn < 12) run<5>(acc, u, wr, wc, fr, fq, 2560);
        else if (pn < 14) run<6>(acc, u, wr, wc, fr, fq, 3072);
        else if (pn < 18) run<7>(acc, u, wr, wc, fr, fq, 3584);
        else run<8>(acc, u, wr, wc, fr, fq, 4608);
    }
};
__device__ __forceinline__ float bf2f(unsigned short h) { return __builtin_bit_cast(float, (unsigned)h << 16); }
template <int PASS> struct EpiMerge {
    static constexpr bool PERM = false, AFTER_DRAIN = false;
    bf16* ga; const bf16* gb;
    __device__ __forceinline__ void operator()(const f32x4 (&acc)[2][2][4][2], const pg8::Unit& u, int wr, int wc, int fr, int fq) const {
        const int col0 = u.pn * 256 + wc * 32 + 4 * fq;
#pragma unroll
        for (int ai = 0; ai < 2; ++ai)
#pragma unroll
            for (int m = 0; m < 4; ++m) {
                const int r = u.pm * 256 + ai * 128 + wr * 64 + m * 16 + fr;
#pragma unroll
                for (int bj = 0; bj < 2; ++bj)
#pragma unroll
                    for (int n = 0; n < 2; ++n) {
                        const int c = col0 + bj * 128 + n * 16;
                        const f32x4 v = acc[ai][bj][m][n];
                        u32x2* pa = (u32x2*)(ga + (size_t)r * D + c);
                        const u32x2 wa = *pa;
                        const float a0 = bf2f(wa.x & 0xffffu), a1 = bf2f(wa.x >> 16), a2 = bf2f(wa.y & 0xffffu), a3 = bf2f(wa.y >> 16);
                        float o0, o1, o2, o3;
                        if (PASS == 0) { o0 = a0 * v.x; o1 = a1 * v.y; o2 = a2 * v.z; o3 = a3 * v.w; }
                        else { const u32x2 wb = *(const u32x2*)(gb + (size_t)r * D + c);
                            o0 = a0 + bf2f(wb.x & 0xffffu) * v.x; o1 = a1 + bf2f(wb.x >> 16) * v.y; o2 = a2 + bf2f(wb.y & 0xffffu) * v.z; o3 = a3 + bf2f(wb.y >> 16) * v.w; }
                        u32x2 w; w.x = cvt_pk_bf16(o0, o1); w.y = cvt_pk_bf16(o2, o3); *pa = w;
                    }
            }
    }
};

__device__ __forceinline__ bf16x8 pack8(const float* f) { u32x4 w; w.x = cvt_pk_bf16(f[0], f[1]); w.y = cvt_pk_bf16(f[2], f[3]); w.z = cvt_pk_bf16(f[4], f[5]); w.w = cvt_pk_bf16(f[6], f[7]); return __builtin_bit_cast(bf16x8, w); }
__device__ __forceinline__ void attn_item(ArgsP A, int item, int lane) {
    const float* kdiag; const float* vdiag; const float* klow; const float* vlow; int qrow0, posq0, nblk, h;
    if (item < 4096) { const int b = item >> 10; h = (item >> 7) & 7; const int qt = item & 127;
        qrow0 = b * 4096 + 32 * qt; posq0 = 16 + 32 * qt; nblk = qt + 2;
        klow = A->out + O_PK + (size_t)b * LP * 512 + h * 64; vlow = A->out + O_PV + (size_t)b * LP * 512 + h * 64;
        kdiag = klow + (size_t)posq0 * 512; vdiag = vlow + (size_t)posq0 * 512;
    } else { const int id = item - 4096, s = id >> 3; h = id & 7;
        qrow0 = MP + 32 * s; posq0 = LC; nblk = 66;
        klow = A->in[I_CK] + (size_t)s * LC * 512 + h * 64; vlow = A->in[I_CV] + (size_t)s * LC * 512 + h * 64;
        kdiag = A->out + O_SK + (size_t)s * 32 * 512 + h * 64; vdiag = A->out + O_SV + (size_t)s * 32 * 512 + h * 64;
    }
    bf16* qo = (bf16*)(A->ws + WS_QB) + (size_t)qrow0 * 512 + h * 64;
    const int ql = lane & 31, hi = lane >> 5;
    bf16x8 qf[4];
#pragma unroll
    for (int s = 0; s < 4; ++s) qf[s] = *(const bf16x8*)(qo + (size_t)ql * 512 + 16 * s + 8 * hi);
    const int rA = (ql & 3) + 4 * (ql >> 3), hA = (ql >> 2) & 1, kappaA = 8 * hA + rA + (rA >= 8 ? 8 : 0);
    f32x16 o0, o1;
#pragma unroll
    for (int r = 0; r < 16; ++r) { o0[r] = 0.f; o1[r] = 0.f; }
    float R = 0.f;
    for (int j = 0; j < nblk; ++j) {
        const int pos0 = posq0 - 32 * j;
        const float* kb = j == 0 ? kdiag : klow; const float* vb = j == 0 ? vdiag : vlow;
        const int rb = j == 0 ? 0 : pos0;
        int rowA = rb + kappaA; rowA = rowA < 0 ? 0 : rowA;
        const float* kp = kb + (size_t)rowA * 512 + 8 * hi;
        f32x16 sacc;
#pragma unroll
        for (int r = 0; r < 16; ++r) sacc[r] = 0.f;
        f32x4 kv[8];
#pragma unroll
        for (int s = 0; s < 4; ++s) { kv[2 * s] = *(const f32x4*)(kp + 16 * s); kv[2 * s + 1] = *(const f32x4*)(kp + 16 * s + 4); }
        float vv[2][2][8];
#pragma unroll
        for (int st = 0; st < 2; ++st)
#pragma unroll
            for (int i = 0; i < 8; ++i) { int row = rb + 16 * st + 8 * hi + i; row = row < 0 ? 0 : row; const float* vp = vb + (size_t)row * 512 + ql; vv[st][0][i] = vp[0]; vv[st][1][i] = vp[32]; }
#pragma unroll
        for (int s = 0; s < 4; ++s) { float kk[8] = {kv[2 * s].x, kv[2 * s].y, kv[2 * s].z, kv[2 * s].w, kv[2 * s + 1].x, kv[2 * s + 1].y, kv[2 * s + 1].z, kv[2 * s + 1].w};
            sacc = __builtin_amdgcn_mfma_f32_32x32x16_bf16(pack8(kk), qf[s], sacc, 0, 0, 0); }
        float sp[16];
#pragma unroll
        for (int r = 0; r < 16; ++r) { const int kappa = 8 * hi + r + (r >= 8 ? 8 : 0);
            const bool valid = (pos0 + kappa >= 0) && (j > 0 || kappa < ql);
            const float z = sacc[r];
            const float s_ = fmaxf(z, 0.f) + lg2(1.0f + ex2(-fabsf(z)));
            sp[r] = valid ? s_ : 0.f; sacc[r] = valid ? z : -1e30f; }
        float glo = 0.f, ghi = 0.f;
#pragma unroll
        for (int r = 0; r < 8; ++r) { glo += sp[r]; ghi += sp[8 + r]; }
        const float pglo = __shfl_xor(glo, 32), pghi = __shfl_xor(ghi, 32);
        const float base_hi = R + (hi == 0 ? pghi : 0.f);
        const float base_lo = R + ghi + pghi + (hi == 0 ? pglo : 0.f);
        float pa[16];
        { float c = base_hi;
#pragma unroll
          for (int r = 15; r >= 8; --r) { c += sp[r]; pa[r] = ex2(sacc[r] - c); }
          c = base_lo;
#pragma unroll
          for (int r = 7; r >= 0; --r) { c += sp[r]; pa[r] = ex2(sacc[r] - c); } }
        R += (glo + ghi) + (pglo + pghi);
        const bf16x8 p0 = pack8(pa), p1 = pack8(pa + 8);
        o0 = __builtin_amdgcn_mfma_f32_32x32x16_bf16(pack8(vv[0][0]), p0, o0, 0, 0, 0);
        o1 = __builtin_amdgcn_mfma_f32_32x32x16_bf16(pack8(vv[0][1]), p0, o1, 0, 0, 0);
        o0 = __builtin_amdgcn_mfma_f32_32x32x16_bf16(pack8(vv[1][0]), p1, o0, 0, 0, 0);
        o1 = __builtin_amdgcn_mfma_f32_32x32x16_bf16(pack8(vv[1][1]), p1, o1, 0, 0, 0);
        if (__all(R > SB_EXIT)) break;
    }
#pragma unroll
    for (int g = 0; g < 4; ++g) {
        u32x2 w; w.x = cvt_pk_bf16(o0[4 * g], o0[4 * g + 1]); w.y = cvt_pk_bf16(o0[4 * g + 2], o0[4 * g + 3]);
        *(u32x2*)(qo + (size_t)ql * 512 + 8 * g + 4 * hi) = w;
        u32x2 w1; w1.x = cvt_pk_bf16(o1[4 * g], o1[4 * g + 1]); w1.y = cvt_pk_bf16(o1[4 * g + 2], o1[4 * g + 3]);
        *(u32x2*)(qo + (size_t)ql * 512 + 32 + 8 * g + 4 * hi) = w1;
    }
}

constexpr int HQ_P = 136, HT_P = 72, HS_P = 72;
constexpr int IMG_KHT = 0, IMG_SC = 128 * HT_P * 2, IMG_DV = IMG_SC + 64 * HS_P * 2, IMG_BYTES = IMG_DV + 512;
constexpr int NPREP = 16 * 65 + 32;
constexpr size_t WS_IMG = WS_XN;
static_assert((size_t)NPREP * IMG_BYTES <= 34603008, "image region");
constexpr int LP_QT = 0, LP_KT = LP_QT + 64 * HQ_P * 2, LP_PART = LP_KT + 64 * HQ_P * 2, LP_END = LP_PART + 8 * 128 * 4;
__device__ __forceinline__ void hgrn_chunk_params(bool prompt, int sidx, int c, int& row0, int& nvalid, int& pos0) {
    if (prompt) { if (c == 0) { row0 = MO; nvalid = 16; pos0 = 0; } else { row0 = sidx * 4096 + 64 * (c - 1); nvalid = 64; pos0 = 16 + 64 * (c - 1); } }
    else { row0 = MP + 32 * sidx; nvalid = 32; pos0 = 0; }
}
__device__ __forceinline__ void hgrn_prep(ArgsP A, LAS unsigned char* lds, int item, int tid) {
    const int lane = tid & 63, w = __builtin_amdgcn_readfirstlane(tid >> 6), l16 = lane & 15, g = lane >> 4;
    const bool prompt = item < 1040; const int bh = prompt ? item / 65 : item - 1040, c = prompt ? item % 65 : 0, sidx = bh >> 2, h = bh & 3;
    int row0, nvalid, pos0; hgrn_chunk_params(prompt, sidx, c, row0, nvalid, pos0);
    LAS bf16* Qt = (LAS bf16*)(lds + LP_QT); LAS bf16* Kt = (LAS bf16*)(lds + LP_KT); LAS float* part = (LAS float*)(lds + LP_PART);
    unsigned char* img = A->ws + WS_IMG + (size_t)item * IMG_BYTES;
    const unsigned short* kkh = (const unsigned short*)(A->ws + WS_KKH); bf16* qh = (bf16*)(A->ws + WS_QH);
    const int kp = lane, tg = w;
    float kk[8][2], qv[8][2], cb[8][2]; float run0 = 0.f, run1 = 0.f;
#pragma unroll
    for (int i = 0; i < 8; ++i) { const int t = 8 * tg + i;
        if (t < nvalid) { const size_t off = (size_t)(row0 + t) * 512 + h * 128 + 2 * kp; const unsigned k2 = *(const unsigned*)(kkh + off), q2 = *(const unsigned*)(qh + off);
            kk[i][0] = (float)__builtin_bit_cast(_Float16, (unsigned short)(k2 & 0xffffu)); kk[i][1] = (float)__builtin_bit_cast(_Float16, (unsigned short)(k2 >> 16));
            qv[i][0] = bf2f((unsigned short)(q2 & 0xffffu)); qv[i][1] = bf2f((unsigned short)(q2 >> 16)); }
        else { kk[i][0] = 0.f; kk[i][1] = 0.f; qv[i][0] = 0.f; qv[i][1] = 0.f; } }
#pragma unroll
    for (int i = 0; i < 8; ++i) { run0 += lg2(1.0f - kk[i][0]); run1 += lg2(1.0f - kk[i][1]); cb[i][0] = run0; cb[i][1] = run1; }
    *(LAS f32x2*)(part + tg * 128 + 2 * kp) = (f32x2){run0, run1};
    __syncthreads();
    float off0 = 0.f, off1 = 0.f, tot0 = 0.f, tot1 = 0.f;
#pragma unroll
    for (int q = 0; q < 8; ++q) { const f32x2 p = *(const LAS f32x2*)(part + q * 128 + 2 * kp); if (q < tg) { off0 += p.x; off1 += p.y; } tot0 += p.x; tot1 += p.y; }
    if (tg == 0) *(f32x2*)(img + IMG_DV + 8 * kp) = (f32x2){ex2(tot0), ex2(tot1)};
    float kh0[8], kh1[8];
#pragma unroll
    for (int i = 0; i < 8; ++i) { const int t = 8 * tg + i; const float b0 = off0 + cb[i][0], b1 = off1 + cb[i][1];
        const unsigned qq = cvt_pk_bf16(qv[i][0] * ex2(b0), qv[i][1] * ex2(b1)), kq = cvt_pk_bf16(kk[i][0] * ex2(-b0), kk[i][1] * ex2(-b1));
        *(LAS unsigned*)(Qt + t * HQ_P + 2 * kp) = qq; *(LAS unsigned*)(Kt + t * HQ_P + 2 * kp) = kq;
        if (t < nvalid) *(unsigned*)(qh + (size_t)(row0 + t) * 512 + h * 128 + 2 * kp) = qq;
        kh0[i] = kk[i][0] * ex2(tot0 - b0); kh1[i] = kk[i][1] * ex2(tot1 - b1); }
    *(bf16x8*)(img + IMG_KHT + ((2 * kp) * HT_P + 8 * tg) * 2) = pack8(kh0);
    *(bf16x8*)(img + IMG_KHT + ((2 * kp + 1) * HT_P + 8 * tg) * 2) = pack8(kh1);
    __syncthreads();
    bf16* sci = (bf16*)(img + IMG_SC);
#pragma unroll
    for (int q = 0; q < 2; ++q) { const int id = 2 * w + q, mt = id >> 2, nt = id & 3;
        f32x4 sc = {0.f, 0.f, 0.f, 0.f};
        if (mt >= nt) {
#pragma unroll
            for (int ks = 0; ks < 4; ++ks) { const bf16x8 a = *(const LAS bf16x8*)(Qt + (16 * mt + l16) * HQ_P + 32 * ks + 8 * g), b = *(const LAS bf16x8*)(Kt + (16 * nt + l16) * HQ_P + 32 * ks + 8 * g);
                sc = __builtin_amdgcn_mfma_f32_16x16x32_bf16(a, b, sc, 0, 0, 0); }
        }
#pragma unroll
        for (int j = 0; j < 4; ++j) { const int t = 16 * mt + 4 * g + j, s_ = 16 * nt + l16; const float v = (t >= s_) ? sc[j] : 0.f;
            sci[t * HS_P + s_] = (bf16)(cvt_pk_bf16(v, 0.f) & 0xffffu); }
    }
    __syncthreads();
}
constexpr int LS_QT = 0, LS_SG = LS_QT + 64 * HQ_P * 2, LS_IMG = LS_SG + 64 * HQ_P * 2, LS_BUF = LS_IMG + IMG_BYTES, LS_SSQ = 2 * LS_BUF, LS_END = LS_SSQ + 2 * 2048;
static_assert(LS_END <= 131072 && (LS_BUF % 16) == 0, "hgrn scan lds");
__device__ __forceinline__ void hgrn_scan(ArgsP A, LAS unsigned char* lds, int item, int tid) {
    const int lane = tid & 63, w = __builtin_amdgcn_readfirstlane(tid >> 6), l16 = lane & 15, g = lane >> 4;
    const bool prompt = item < 16; const int sidx = prompt ? (item >> 2) : ((item - 16) >> 2), h = item & 3;
    const int nchunk = prompt ? 65 : 1;
    const bf16* qh = (const bf16*)(A->ws + WS_QH); bf16* sg = (bf16*)(A->ws + WS_SG);
    const unsigned char* imgb = A->ws + WS_IMG + (size_t)(prompt ? (sidx * 4 + h) * 65 : 1040 + (sidx * 4 + h)) * IMG_BYTES;
    const int vcol = 16 * w + l16;
    const bf16* ivtb = prompt ? ((const bf16*)(A->ws + WS_IVTP) + ((size_t)((sidx * 4 + h) * 128 + vcol)) * LP) : ((const bf16*)(A->ws + WS_IVTS) + ((size_t)((sidx * 4 + h) * 128 + vcol)) * 64);
    const float gn = A->in[I_HGN][h * 128 + vcol];
    f32x4 S[8];
    if (prompt) {
#pragma unroll
        for (int mt = 0; mt < 8; ++mt) S[mt] = (f32x4){0.f, 0.f, 0.f, 0.f};
    } else {
        const float* st = A->in[I_ST] + (size_t)(sidx * 4 + h) * 16384;
#pragma unroll
        for (int mt = 0; mt < 8; ++mt)
#pragma unroll
            for (int j = 0; j < 4; ++j) S[mt][j] = st[(size_t)(16 * mt + 4 * g + j) * 128 + vcol];
    }
    const int prow = tid >> 4, pseg = tid & 15;
    const unsigned qoff = (unsigned)(prow * (HQ_P * 2) + pseg * 16);
    const u32x4 Z4 = {0u, 0u, 0u, 0u};
    u32x4 X[10], Y[10];
#define HG_ISSUE(SET, cidx) do { const int c_ = (cidx); if (c_ < nchunk) { int row0_, nv_, pos0_; hgrn_chunk_params(prompt, sidx, c_, row0_, nv_, pos0_); \
        const size_t go_ = (size_t)(row0_ + prow) * 512 + h * 128 + pseg * 8; \
        _Pragma("unroll") for (int i_ = 0; i_ < 2; ++i_) { const bool ok_ = prow + 32 * i_ < nv_; SET[i_] = ok_ ? *(const u32x4*)(qh + go_ + (size_t)i_ * 32 * 512) : Z4; SET[2 + i_] = ok_ ? *(const u32x4*)(sg + go_ + (size_t)i_ * 32 * 512) : Z4; } \
        const unsigned char* im_ = imgb + (size_t)c_ * IMG_BYTES + tid * 16; \
        _Pragma("unroll") for (int i_ = 0; i_ < 4; ++i_) { if (tid + 512 * i_ < IMG_BYTES / 16) SET[4 + i_] = *(const u32x4*)(im_ + 8192 * i_); } \
        _Pragma("unroll") for (int s_ = 0; s_ < 2; ++s_) SET[8 + s_] = (32 * s_ + 8 * g < nv_) ? *(const u32x4*)(ivtb + pos0_ + 32 * s_ + 8 * g) : Z4; } } while (0)
#define HG_COMMIT(SET, boff) do { LAS unsigned char* b_ = lds + (boff); \
        _Pragma("unroll") for (int i_ = 0; i_ < 2; ++i_) { *(LAS u32x4*)(b_ + LS_QT + qoff + i_ * 32 * HQ_P * 2) = SET[i_]; *(LAS u32x4*)(b_ + LS_SG + qoff + i_ * 32 * HQ_P * 2) = SET[2 + i_]; } \
        _Pragma("unroll") for (int i_ = 0; i_ < 4; ++i_) { if (tid + 512 * i_ < IMG_BYTES / 16) *(LAS u32x4*)(b_ + LS_IMG + tid * 16 + 8192 * i_) = SET[4 + i_]; } } while (0)
#define HG_COMPUTE(cidx, boff) do { const int c_ = (cidx); int row0_, nv_, pos0_; hgrn_chunk_params(prompt, sidx, c_, row0_, nv_, pos0_); const bool wr_ = !(prompt && c_ == 0); \
        LAS unsigned char* b_ = lds + (boff); const LAS bf16* Qt = (const LAS bf16*)(b_ + LS_QT); const LAS bf16* Sg = (const LAS bf16*)(b_ + LS_SG); \
        const LAS bf16* KhT = (const LAS bf16*)(b_ + LS_IMG + IMG_KHT); const LAS bf16* Sc = (const LAS bf16*)(b_ + LS_IMG + IMG_SC); const LAS float* dv = (const LAS float*)(b_ + LS_IMG + IMG_DV); \
        LAS float* ssq = (LAS float*)(lds + LS_SSQ + (c_ & 1) * 2048); \
        bf16x8 bs[4]; \
        _Pragma("unroll") for (int ks = 0; ks < 4; ++ks) { u32x4 t_; t_.x = cvt_pk_bf16(S[2 * ks][0], S[2 * ks][1]); t_.y = cvt_pk_bf16(S[2 * ks][2], S[2 * ks][3]); t_.z = cvt_pk_bf16(S[2 * ks + 1][0], S[2 * ks + 1][1]); t_.w = cvt_pk_bf16(S[2 * ks + 1][2], S[2 * ks + 1][3]); bs[ks] = __builtin_bit_cast(bf16x8, t_); } \
        const bf16x8 biv0 = __builtin_bit_cast(bf16x8, bivc[0]), biv1 = __builtin_bit_cast(bf16x8, bivc[1]); \
        f32x4 o[4]; \
        _Pragma("unroll") for (int mt = 0; mt < 4; ++mt) { f32x4 a4 = {0.f, 0.f, 0.f, 0.f}; \
            a4 = __builtin_amdgcn_mfma_f32_16x16x32_bf16(*(const LAS bf16x8*)(Sc + (16 * mt + l16) * HS_P + 8 * g), biv0, a4, 0, 0, 0); \
            a4 = __builtin_amdgcn_mfma_f32_16x16x32_bf16(*(const LAS bf16x8*)(Sc + (16 * mt + l16) * HS_P + 32 + 8 * g), biv1, a4, 0, 0, 0); \
            _Pragma("unroll") for (int ks = 0; ks < 4; ++ks) { const u32x2 lo_ = *(const LAS u32x2*)(Qt + (16 * mt + l16) * HQ_P + 32 * ks + 4 * g), hi_ = *(const LAS u32x2*)(Qt + (16 * mt + l16) * HQ_P + 32 * ks + 16 + 4 * g); \
                u32x4 t_; t_.x = lo_.x; t_.y = lo_.y; t_.z = hi_.x; t_.w = hi_.y; a4 = __builtin_amdgcn_mfma_f32_16x16x32_bf16(__builtin_bit_cast(bf16x8, t_), bs[ks], a4, 0, 0, 0); } \
            o[mt] = a4; } \
        _Pragma("unroll") for (int mt = 0; mt < 8; ++mt) { const f32x4 d4 = *(const LAS f32x4*)(dv + 16 * mt + 4 * g); f32x4 a4 = S[mt] * d4; \
            a4 = __builtin_amdgcn_mfma_f32_16x16x32_bf16(*(const LAS bf16x8*)(KhT + (16 * mt + l16) * HT_P + 8 * g), biv0, a4, 0, 0, 0); \
            a4 = __builtin_amdgcn_mfma_f32_16x16x32_bf16(*(const LAS bf16x8*)(KhT + (16 * mt + l16) * HT_P + 32 + 8 * g), biv1, a4, 0, 0, 0); \
            S[mt] = a4; } \
        if (wr_) { _Pragma("unroll") for (int mt = 0; mt < 4; ++mt) _Pragma("unroll") for (int j = 0; j < 4; ++j) { float q2 = o[mt][j] * o[mt][j]; q2 += __shfl_xor(q2, 1); q2 += __shfl_xor(q2, 2); q2 += __shfl_xor(q2, 4); q2 += __shfl_xor(q2, 8); \
            if (l16 == 0) ssq[(16 * mt + 4 * g + j) * 8 + w] = q2; } } \
        __syncthreads(); \
        if (wr_) { _Pragma("unroll") for (int mt = 0; mt < 4; ++mt) _Pragma("unroll") for (int j = 0; j < 4; ++j) { const int t = 16 * mt + 4 * g + j; \
            if (t < nv_) { const f32x4 s0 = *(const LAS f32x4*)(ssq + t * 8), s1 = *(const LAS f32x4*)(ssq + t * 8 + 4); \
                const float tot = ((s0.x + s0.y) + (s0.z + s0.w)) + ((s1.x + s1.y) + (s1.z + s1.w)); \
                const float rs = rsqrtf(tot * (1.0f / 128.0f) + EPS); \
                const float val = o[mt][j] * rs * gn * bf2f(Sg[t * HQ_P + vcol]); \
                sg[(size_t)(row0_ + t) * 512 + h * 128 + vcol] = (bf16)(cvt_pk_bf16(val, 0.f) & 0xffffu); } } } \
        __syncthreads(); } while (0)
    u32x4 bivc[2], bivn[2];
    HG_ISSUE(X, 0); HG_ISSUE(Y, 1);
    HG_COMMIT(X, 0); bivc[0] = X[8]; bivc[1] = X[9];
    HG_ISSUE(X, 2);
    __syncthreads();
    for (int c = 0; c < nchunk; c += 2) {
        if (c + 1 < nchunk) { HG_COMMIT(Y, LS_BUF); bivn[0] = Y[8]; bivn[1] = Y[9]; }
        HG_ISSUE(Y, c + 3);
        HG_COMPUTE(c, 0);
        bivc[0] = bivn[0]; bivc[1] = bivn[1];
        if (c + 1 < nchunk) {
            if (c + 2 < nchunk) { HG_COMMIT(X, 0); bivn[0] = X[8]; bivn[1] = X[9]; }
            HG_ISSUE(X, c + 4);
            HG_COMPUTE(c + 1, LS_BUF);
            bivc[0] = bivn[0]; bivc[1] = bivn[1];
        }
    }
#undef HG_ISSUE
#undef HG_COMMIT
#undef HG_COMPUTE
    float* so = A->out + (prompt ? O_PH : O_SH) + (size_t)(sidx * 4 + h) * 16384;
#pragma unroll
    for (int mt = 0; mt < 8; ++mt)
#pragma unroll
        for (int j = 0; j < 4; ++j) so[(size_t)(16 * mt + 4 * g + j) * 128 + vcol] = S[mt][j];
    __syncthreads();
}

__global__ void __launch_bounds__(NTHREADS, 2) mega_fwd(Args Aunused) {
    extern __shared__ __attribute__((aligned(16))) unsigned char lds_raw[];
    LAS unsigned char* lds = (LAS unsigned char*)lds_raw;
    cg::grid_group grid = cg::this_grid();
#define TIDL ({ int t_ = threadIdx.x; asm volatile("" : "+v"(t_)); t_; })
#define LANE (tid & 63)
#define WAVE (__builtin_amdgcn_readfirstlane(tid >> 6))
#define GX ((int)gridDim.x)
#define BX ((int)blockIdx.x)
#define SSP(A, i) ((float*)((A)->ws + WS_SS + (size_t)(i) * SS_BYTES))

    { const int tid = TIDL; p0_phase(argsp(), lds, WAVE, LANE); }
    grid.sync();
    { ArgsP A = argsp(); unsigned char* ws = A->ws; pg8::Gemm g{(const bf16*)(ws + WS_XN), (const bf16*)(ws + WS_WGU1), MPAD, 2 * FF, D}; pg8::StaticOrder S; S.init(MPAD, 2 * FF, GX, BX); EpiSwiGLU E{(bf16*)(ws + WS_ACT), SSP(A, 0)};
      pg8::gemm_phase<EpiSwiGLU, pg8::StaticOrder, true, true>(lds, g, S, E); }
    grid.sync();
    { ArgsP A = argsp(); unsigned char* ws = A->ws; pg8::Gemm g{(const bf16*)(ws + WS_ACT), (const bf16*)(ws + WS_WD1), MPAD, D, FF}; pg8::StaticOrder S; S.init(MPAD, D, GX, BX);
      EpiResid<1, 1, 1> E{A->in[I_XP], A->in[I_XS], A->in[I_META], A->out, (bf16*)(ws + WS_XN), A->in[I_NMIX], SSP(A, 1)};
      pg8::gemm_phase<EpiResid<1, 1, 1>, pg8::StaticOrder, true, true>(lds, g, S, E); }
    grid.sync();
#ifndef REP_P3
#define REP_P3 1
#endif
#ifndef REP_P34
#define REP_P34 1
#endif
    for (int rep34 = 0; rep34 < REP_P34; ++rep34) {
    for (int rep3 = 0; rep3 < REP_P3; ++rep3) {
    { ArgsP A = argsp(); unsigned char* ws = A->ws; pg8::Gemm g{(const bf16*)(ws + WS_XN), (const bf16*)(ws + WS_WIN), MPAD, NIN, D}; pg8::StaticOrder S; S.init(MPAD, NIN, GX, BX); EpiWin E{ws, A->out, A->in[I_LB], A->in[I_BG], SSP(A, 1)};
      pg8::gemm_phase<EpiWin, pg8::StaticOrder, true, true>(lds, g, S, E); }
    grid.sync();
    }
    { const int tid = TIDL; for (int it = BX; it < NPREP; it += GX) hgrn_prep(argsp(), lds, it, tid); }
    grid.sync();
    {
        const int G = GX, bx = BX; const int tid = TIDL;
        if (G >= 96) {
            if (bx < 48) hgrn_scan(argsp(), lds, bx, tid);
            else { const int ws_ = (bx - 48) * NWAVES + WAVE, nws = (G - 48) * NWAVES; for (int it = ws_; it < 4160; it += nws) attn_item(argsp(), it, LANE); }
        } else {
            for (int it = bx; it < 48; it += G) hgrn_scan(argsp(), lds, it, tid);
            for (int it = bx * NWAVES + WAVE; it < 4160; it += G * NWAVES) attn_item(argsp(), it, LANE);
        }
    }
    grid.sync();
    }
    { ArgsP A = argsp(); unsigned char* ws = A->ws; pg8::Gemm g{(const bf16*)(ws + WS_QB), (const bf16*)(ws + WS_WA), MO, D, 512}; pg8::StaticOrder S; S.init(MO, D, GX, BX); EpiMerge<0> E{(bf16*)(ws + WS_GA), (const bf16*)(ws + WS_GB)};
      pg8::gemm_phase<EpiMerge<0>, pg8::StaticOrder, true, true>(lds, g, S, E); }
    __threadfence(); __syncthreads();
    { ArgsP A = argsp(); unsigned char* ws = A->ws; pg8::Gemm g{(const bf16*)(ws + WS_SG), (const bf16*)(ws + WS_WB), MO, D, 512}; pg8::StaticOrder S; S.init(MO, D, GX, BX); EpiMerge<1> E{(bf16*)(ws + WS_GA), (const bf16*)(ws + WS_GB)};
      pg8::gemm_phase<EpiMerge<1>, pg8::StaticOrder, true, true>(lds, g, S, E); }
    grid.sync();
    { ArgsP A = argsp(); unsigned char* ws = A->ws; pg8::Gemm g{(const bf16*)(ws + WS_GA), (const bf16*)(ws + WS_WOUT), MO, D, D}; pg8::StaticOrder S; S.init(MO, D, GX, BX);
      EpiResid<0, 0, 1> E{nullptr, nullptr, nullptr, A->out, (bf16*)(ws + WS_XN), A->in[I_N2], SSP(A, 2)};
      pg8::gemm_phase<EpiResid<0, 0, 1>, pg8::StaticOrder, true, true>(lds, g, S, E); }
    grid.sync();
    { ArgsP A = argsp(); unsigned char* ws = A->ws; pg8::Gemm g{(const bf16*)(ws + WS_XN), (const bf16*)(ws + WS_WGU2), MO, 2 * FF, D}; pg8::StaticOrder S; S.init(MO, 2 * FF, GX, BX); EpiSwiGLU E{(bf16*)(ws + WS_ACT), SSP(A, 2)};
      pg8::gemm_phase<EpiSwiGLU, pg8::StaticOrder, true, true>(lds, g, S, E); }
    grid.sync();
    { ArgsP A = argsp(); unsigned char* ws = A->ws; pg8::Gemm g{(const bf16*)(ws + WS_ACT), (const bf16*)(ws + WS_WD2), MO, D, FF}; pg8::StaticOrder S; S.init(MO, D, GX, BX);
      EpiResid<0, 1, 0> E{nullptr, nullptr, nullptr, A->out, nullptr, nullptr, SSP(A, 3)};
      pg8::gemm_phase<EpiResid<0, 1, 0>, pg8::StaticOrder, true, true>(lds, g, S, E); }
    grid.sync();
    {
        const int tid = TIDL; ArgsP A = argsp(); float* X = A->out; const float* SS3 = SSP(A, 3);
        const int gw = BX * NWAVES + WAVE, NGW = GX * NWAVES; const f32x4* gf = (const f32x4*)A->in[I_NF] + LANE;
        for (int m = gw; m < MO; m += NGW) { const float rs = rstd_from_ss(SS3, m); f32x4* x4 = (f32x4*)(X + (size_t)m * D) + LANE;
#pragma unroll
            for (int j = 0; j < 4; ++j) { f32x4 v = x4[64 * j]; const f32x4 gg = gf[64 * j]; x4[64 * j] = v * rs * gg; } }
    }
}

extern "C" void kernel_launch(void* const* d_in, const int* in_sizes, int n_in, void* d_out, int out_size, void* d_ws, size_t ws_size, hipStream_t stream) {
    static int grid = 0;
    if (grid == 0) {
        if (n_in != 23 || ws_size < WS_END || out_size != 34930688) { fprintf(stderr, "kernel_launch: unexpected problem shape (n_in %d, out %d, ws %zu)\n", n_in, out_size, ws_size); grid = -1; return; }
        int dev = 0, cus = 0, per_cu = 0;
        hipGetDevice(&dev); hipDeviceGetAttribute(&cus, hipDeviceAttributeMultiprocessorCount, dev);
        hipFuncSetAttribute((const void*)mega_fwd, hipFuncAttributeMaxDynamicSharedMemorySize, LDS_BYTES);
        hipOccupancyMaxActiveBlocksPerMultiprocessor(&per_cu, (const void*)mega_fwd, NTHREADS, LDS_BYTES);
        if (per_cu < 1) { fprintf(stderr, "kernel_launch: occupancy query returned %d\n", per_cu); per_cu = 1; }
        (void)hipGetLastError();
        grid = cus * per_cu;
    }
    if (grid < 0) return;
    Args a{};
    for (int i = 0; i < 23; ++i) a.in[i] = (const float*)d_in[i];
    a.out = (float*)d_out; a.ws = (unsigned char*)d_ws;
    void* args[] = {&a};
    hipError_t e = hipLaunchCooperativeKernel((const void*)mega_fwd, dim3(grid), dim3(NTHREADS), args, LDS_BYTES, stream);
    if (e != hipSuccess) fprintf(stderr, "cooperative launch failed: %s (grid %d)\n", hipGetErrorString(e), grid);
}
```

```cpp
#include <hip/hip_runtime.h>
#include <hip/hip_cooperative_groups.h>
#include <cstdio>
#include <cstdint>
namespace cg = cooperative_groups;
namespace pg8 {
#define PG8_LAS __attribute__((address_space(3)))
typedef unsigned short bf16_t;
typedef short bf16x8 __attribute__((ext_vector_type(8)));
typedef float f32x4 __attribute__((ext_vector_type(4)));
typedef unsigned u32x4 __attribute__((ext_vector_type(4)));
constexpr int BM = 256, BK = 64, HALF = 128, HTB = HALF * BK * 2  , STAGE_BYTES = 8 * HTB, NXCD = 8, WGM = 8;

__host__ __device__ __forceinline__ int lds_byte(int r, int c) { const int st = (r >> 4) * 2 + (c >> 5), rr = r & 15, cc = c & 31, ob = rr * 64 + cc * 2; return st * 1024 + (ob ^ (((ob >> 9) & 1) << 5)); }
__host__ __device__ __forceinline__ void stage_rc(int b, int& R, int& C) { const int st = b / 1024, sb = b % 1024, swz = sb ^ (((sb >> 9) & 1) << 5); R = (st >> 1) * 16 + swz / 64; C = (st & 1) * 32 + (swz % 64) / 2; }
__host__ __device__ __forceinline__ int perm32(int rho) { const int n = rho >> 4, i = rho & 15; return 8 * (i >> 2) + 4 * n + (i & 3); }

struct Unit { int pm, pn; };
struct Gemm { const bf16_t* A; const bf16_t* Bt; int M, N, K; };

struct StaticOrder {
    int nM, nN, nwg, G, c;
    __host__ __device__ void init(int M, int N, int G_, int c_) { nM = M / BM; nN = N / BM; nwg = nM * nN; G = G_; c = c_; }
    __host__ __device__ bool next(int i, Unit& u) const {
        const long L = (long)i * G + c; if (L >= nwg) return false;
        int wgid = (int)L; { const int q = nwg / NXCD, r = nwg % NXCD, xcd = wgid % NXCD, off = wgid / NXCD; wgid = (xcd < r ? xcd * (q + 1) : r * (q + 1) + (xcd - r) * q) + off; }
        const int nig = WGM * nN, gid = wgid / nig, fm = gid * WGM, gsz = (nM - fm) < WGM ? (nM - fm) : WGM;
        u.pm = fm + ((wgid % nig) % gsz); u.pn = (wgid % nig) / gsz; return true;
    }
    __device__ __forceinline__ void a_ready(const Unit&) const {}
    __device__ __forceinline__ void done(const Unit&) const {}
};

__device__ __forceinline__ unsigned cvt_pk_bf16(float lo, float hi) { unsigned r; asm volatile("v_cvt_pk_bf16_f32 %0, %1, %2" : "=v"(r) : "v"(lo), "v"(hi)); return r; }
template <class Epi, class Sched, bool ALIGN_EPI = false, bool SP2 = false>
__device__ __forceinline__ void gemm_phase(PG8_LAS unsigned char* lds, const Gemm g, const Sched S, const Epi E) {
    int tid_l = threadIdx.x; asm volatile("" : "+v"(tid_l)); const int tid = tid_l, wid = __builtin_amdgcn_readfirstlane(tid >> 6), lane = tid & 63, wr = wid >> 2, wc = wid & 3, fr = lane & 15, fq = lane >> 4;
    const int K = g.K, nt = K / BK;
    unsigned voffA[2], voffB[2];
#pragma unroll
    for (int i = 0; i < 2; ++i) { int R, C; stage_rc(tid * 16 + i * 8192, R, C); const int Rb = Epi::PERM ? ((R & ~31) + perm32(R & 31)) : R;
        voffA[i] = (unsigned)(R * K + C) * 2u; voffB[i] = (unsigned)(Rb * K + C) * 2u; }
    const size_t kstep = (size_t)(BK * 2);
    const size_t hstep = (size_t)HALF * K * 2;
    const size_t tstep = 2 * hstep;
    const unsigned ldsw = (unsigned)wid * 1024u;
    const int aoff = lds_byte(wr * 64 + fr, fq * 8), boff = lds_byte(wc * 32 + fr, fq * 8);
#define PG8_SA(b, h) (((b) * 2 + (h)) * HTB)
#define PG8_SB(b, h) ((4 + (b) * 2 + (h)) * HTB)
#define PG8_STAGE(bufoff, gbase, voff) do { _Pragma("unroll") for (int _i = 0; _i < 2; ++_i) \
        __builtin_amdgcn_global_load_lds((const unsigned*)((const char*)(gbase) + (voff)[_i]), (PG8_LAS unsigned*)(lds + (bufoff) + ldsw + _i * 8192), 16, 0, 0); } while (0)
#define PG8_LDA(dst, b, h) do { _Pragma("unroll") for (int m = 0; m < 4; ++m) _Pragma("unroll") for (int k = 0; k < 2; ++k) dst[m][k] = *(const PG8_LAS bf16x8*)(lds + PG8_SA(b, h) + aoff + m * 2048 + k * 1024); } while (0)
#define PG8_LDB(dst, b, h) do { _Pragma("unroll") for (int n = 0; n < 2; ++n) _Pragma("unroll") for (int k = 0; k < 2; ++k) dst[n][k] = *(const PG8_LAS bf16x8*)(lds + PG8_SB(b, h) + boff + n * 2048 + k * 1024); } while (0)
#define PG8_MMA(ai, bj, At, Bt) do { __builtin_amdgcn_s_setprio(1); _Pragma("unroll") for (int m = 0; m < 4; ++m) _Pragma("unroll") for (int n = 0; n < 2; ++n) _Pragma("unroll") for (int k = 0; k < 2; ++k) \
        acc[ai][bj][m][n] = __builtin_amdgcn_mfma_f32_16x16x32_bf16(Bt[n][k], At[m][k], acc[ai][bj][m][n], 0, 0, 0); __builtin_amdgcn_s_setprio(0); } while (0)
#define PG8_WAIT_V(n) asm volatile("s_waitcnt vmcnt(" #n ")" ::: "memory")
#define PG8_WAIT_L(n) asm volatile("s_waitcnt lgkmcnt(" #n ")" ::: "memory")
#define PG8_BAR __builtin_amdgcn_s_barrier()
#define PG8_SCHED __builtin_amdgcn_sched_barrier(0)
    Unit cur, nxt; int ui = 0;
    if (!S.next(0, cur)) return;
    f32x4 acc[2][2][4][2];
#pragma unroll
    for (int a = 0; a < 2; ++a)
#pragma unroll
        for (int b = 0; b < 2; ++b)
#pragma unroll
            for (int m = 0; m < 4; ++m)
#pragma unroll
                for (int n = 0; n < 2; ++n) acc[a][b][m][n] = (f32x4){0.f, 0.f, 0.f, 0.f};
    bf16x8 At[4][2], B0[2][2], B1[2][2];
    const char* cA = (const char*)g.A + (size_t)cur.pm * tstep; const char* cB = (const char*)g.Bt + (size_t)cur.pn * tstep;
    S.a_ready(cur);
    if constexpr (SP2) {
        PG8_STAGE(PG8_SB(0, 0), cB, voffB); PG8_STAGE(PG8_SB(0, 1), cB + hstep, voffB); PG8_STAGE(PG8_SA(0, 0), cA, voffA); PG8_STAGE(PG8_SA(0, 1), cA + hstep, voffA);
        if (wr == 1) PG8_BAR;
        PG8_WAIT_V(2); PG8_BAR;
        PG8_STAGE(PG8_SB(1, 0), cB + kstep, voffB); PG8_STAGE(PG8_SA(1, 0), cA + kstep, voffA); PG8_STAGE(PG8_SB(1, 1), cB + hstep + kstep, voffB);
        PG8_WAIT_V(6); PG8_BAR;
    } else {
        PG8_STAGE(PG8_SB(0, 0), cB, voffB); PG8_STAGE(PG8_SA(0, 0), cA, voffA); PG8_STAGE(PG8_SB(0, 1), cB + hstep, voffB); PG8_STAGE(PG8_SA(0, 1), cA + hstep, voffA);
        if (wr == 1) PG8_BAR;
        PG8_WAIT_V(4); PG8_BAR;
        PG8_STAGE(PG8_SB(1, 0), cB + kstep, voffB); PG8_STAGE(PG8_SA(1, 0), cA + kstep, voffA); PG8_STAGE(PG8_SB(1, 1), cB + hstep + kstep, voffB);
        PG8_WAIT_V(6); PG8_BAR;
    }
    for (;;) {
        const bool has_next = S.next(ui + 1, nxt);
        const char* nA = has_next ? (const char*)g.A + (size_t)nxt.pm * tstep : cA; const char* nB = has_next ? (const char*)g.Bt + (size_t)nxt.pn * tstep : cB;
        for (int t = 0; t < nt; t += 2) {
            const bool last = (t == nt - 2);
            const char* a1 = cA + (size_t)(t + 1) * kstep;
            const char* a2 = last ? nA : cA + (size_t)(t + 2) * kstep; const char* b2 = last ? nB : cB + (size_t)(t + 2) * kstep;
            const char* a3 = a2 + kstep; const char* b3 = b2 + kstep;
            if (last && has_next) S.a_ready(nxt);
            if constexpr (SP2) {
            PG8_LDB(B0, 0, 0); PG8_LDB(B1, 0, 1); PG8_SCHED; PG8_LDA(At, 0, 0); PG8_STAGE(PG8_SA(1, 1), a1 + hstep, voffA);
            PG8_WAIT_V(8); PG8_WAIT_L(0); PG8_BAR; PG8_MMA(0, 0, At, B0); PG8_MMA(0, 1, At, B1); PG8_BAR; PG8_SCHED;
            PG8_LDA(At, 0, 1); PG8_STAGE(PG8_SB(0, 0), b2, voffB); PG8_STAGE(PG8_SB(0, 1), b2 + hstep, voffB); PG8_STAGE(PG8_SA(0, 0), a2, voffA);
            PG8_WAIT_V(8); PG8_WAIT_L(0); PG8_BAR; PG8_MMA(1, 0, At, B0); PG8_MMA(1, 1, At, B1); PG8_BAR; PG8_SCHED;
            PG8_LDB(B0, 1, 0); PG8_LDB(B1, 1, 1); PG8_SCHED; PG8_LDA(At, 1, 0); PG8_STAGE(PG8_SA(0, 1), a2 + hstep, voffA);
            PG8_WAIT_V(8); PG8_WAIT_L(0); PG8_BAR; PG8_MMA(0, 0, At, B0); PG8_MMA(0, 1, At, B1); PG8_BAR; PG8_SCHED;
            PG8_LDA(At, 1, 1); PG8_STAGE(PG8_SB(1, 0), b3, voffB); PG8_STAGE(PG8_SB(1, 1), b3 + hstep, voffB); PG8_STAGE(PG8_SA(1, 0), a3, voffA);
            PG8_WAIT_V(8); PG8_WAIT_L(0); PG8_BAR; PG8_MMA(1, 0, At, B0); PG8_MMA(1, 1, At, B1); PG8_BAR; PG8_SCHED;
            } else {
            PG8_LDB(B0, 0, 0); PG8_SCHED; PG8_LDA(At, 0, 0); PG8_STAGE(PG8_SA(1, 1), a1 + hstep, voffA);
            PG8_WAIT_L(8); PG8_BAR; PG8_WAIT_L(0); PG8_MMA(0, 0, At, B0); PG8_BAR; PG8_SCHED;
            PG8_LDB(B1, 0, 1); PG8_STAGE(PG8_SB(0, 0), b2, voffB);
            PG8_BAR; PG8_WAIT_L(0); PG8_MMA(0, 1, At, B1); PG8_BAR;
            PG8_LDA(At, 0, 1); PG8_STAGE(PG8_SA(0, 0), a2, voffA);
            PG8_BAR; PG8_WAIT_L(0); PG8_MMA(1, 0, At, B0); PG8_BAR; PG8_SCHED;
            PG8_STAGE(PG8_SB(0, 1), b2 + hstep, voffB);
            PG8_WAIT_V(6); PG8_BAR; PG8_MMA(1, 1, At, B1); PG8_BAR;
            PG8_LDB(B0, 1, 0); PG8_SCHED; PG8_LDA(At, 1, 0); PG8_STAGE(PG8_SA(0, 1), a2 + hstep, voffA);
            PG8_WAIT_L(8); PG8_BAR; PG8_WAIT_L(0); PG8_MMA(0, 0, At, B0); PG8_BAR; PG8_SCHED;
            PG8_LDB(B1, 1, 1); PG8_STAGE(PG8_SB(1, 0), b3, voffB);
            PG8_BAR; PG8_WAIT_L(0); PG8_MMA(0, 1, At, B1); PG8_BAR;
            PG8_LDA(At, 1, 1); PG8_STAGE(PG8_SA(1, 0), a3, voffA);
            PG8_BAR; PG8_WAIT_L(0); PG8_MMA(1, 0, At, B0); PG8_BAR; PG8_SCHED;
            PG8_STAGE(PG8_SB(1, 1), b3 + hstep, voffB);
            PG8_WAIT_V(6); PG8_BAR; PG8_MMA(1, 1, At, B1); PG8_BAR;
            }
        }
        if constexpr (ALIGN_EPI) { if (wr == 0) PG8_BAR; }
        if constexpr (!Epi::AFTER_DRAIN) { E(acc, cur, wr, wc, fr, fq); S.done(cur); }
        if (!has_next) break;
#pragma unroll
        for (int a = 0; a < 2; ++a)
#pragma unroll
            for (int b = 0; b < 2; ++b)
#pragma unroll
                for (int m = 0; m < 4; ++m)
#pragma unroll
                    for (int n = 0; n < 2; ++n) acc[a][b][m][n] = (f32x4){0.f, 0.f, 0.f, 0.f};
        cur = nxt; cA = nA; cB = nB; ++ui;
        if constexpr (ALIGN_EPI) { if (wr == 1) PG8_BAR; }
    }
    PG8_WAIT_V(0);
    if constexpr (!ALIGN_EPI) { if (wr == 0) PG8_BAR; }
    PG8_BAR;
    if constexpr (Epi::AFTER_DRAIN) { E.fused(acc, cur, wr, wc, fr, fq, lds, wid, lane); S.done(cur); }
#undef PG8_SA
#undef PG8_SB
#undef PG8_STAGE
#undef PG8_LDA
#undef PG8_LDB
#undef PG8_MMA
#undef PG8_WAIT_V
#undef PG8_WAIT_L
#undef PG8_BAR
#undef PG8_SCHED
}
}

#define LAS __attribute__((address_space(3)))
typedef unsigned short bf16;
typedef float f32x4 __attribute__((ext_vector_type(4)));
typedef float f32x16 __attribute__((ext_vector_type(16)));
typedef short bf16x8 __attribute__((ext_vector_type(8)));
typedef unsigned u32x4 __attribute__((ext_vector_type(4)));
typedef unsigned u32x2 __attribute__((ext_vector_type(2)));
typedef float f32x2 __attribute__((ext_vector_type(2)));
using pg8::cvt_pk_bf16;

constexpr int NWAVES = 8, NTHREADS = 512;
constexpr int D = 1024, FF = 2816, NIN = 5632;
constexpr int MP = 16384;
constexpr int MS = 256;
constexpr int MO = MP + MS;
constexpr int MX = MO + 16;
constexpr int MPAD = 16896;
constexpr int LP = 4112;
constexpr int LC = 2064;
constexpr float EPS = 1e-6f;
constexpr float LOG2E = 1.4426950408889634f;
constexpr float QSCALE = 0.125f * LOG2E;
constexpr float SB_EXIT = 152.0f;

constexpr size_t O_YP = 0, O_YS = 16777216, O_PK = 17039360, O_PV = 25460736, O_PH = 33882112, O_SK = 34144256, O_SV = 34275328, O_SH = 34406400;
constexpr size_t WS_WGU1 = 0, WS_WD1 = 11534336, WS_WIN = 17301504, WS_WA = 28835840, WS_WB = 29884416, WS_WOUT = 30932992, WS_WGU2 = 33030144, WS_WD2 = 44564480;
constexpr size_t WS_SS = 50331648, SS_BYTES = (size_t)MPAD * 16 * 4;
constexpr size_t WS_XN = 54657024, WS_ACT = 89260032;
constexpr size_t WS_KKH = 184418304, WS_QB = 201719808, WS_QH = 219021312, WS_IVTP = 236322816, WS_IVTS = 253165568, WS_END = 253689856;
constexpr size_t WS_GA = WS_ACT, WS_GB = WS_ACT + 34603008, WS_SG = WS_ACT + 69206016;
constexpr int LDS_BYTES = 147456;

struct Args { const float* in[23]; float* out; unsigned char* ws; };
typedef const Args __attribute__((address_space(4)))* ArgsP;
__device__ __forceinline__ ArgsP argsp() { ArgsP p = (ArgsP)__builtin_amdgcn_kernarg_segment_ptr(); asm volatile("" : "+s"(p)); return p; }
enum { I_XP = 0, I_XS, I_CK, I_CV, I_ST, I_META, I_N1, I_WG1, I_WU1, I_WD1, I_NMIX, I_WIN, I_BG, I_LB, I_HGN, I_WA, I_WB, I_WOUT, I_N2, I_WG2, I_WU2, I_WD2, I_NF };

__device__ __forceinline__ float wave_sum(float v) {
#pragma unroll
    for (int o = 1; o < 64; o <<= 1) v += __shfl_xor(v, o);
    return v;
}
__device__ __forceinline__ float ex2(float x) { return __builtin_amdgcn_exp2f(x); }
__device__ __forceinline__ float lg2(float x) { return __builtin_amdgcn_logf(x); }
__device__ __forceinline__ float sigmoidf_(float x) { return 1.0f / (1.0f + ex2(-x * LOG2E)); }
__device__ __forceinline__ float rstd_from_ss(const float* ss, int r) {
    const f32x4* p = (const f32x4*)(ss + (size_t)r * 16);
    f32x4 a = p[0], b = p[1], c = p[2], d = p[3];
    float s = ((a.x + a.y) + (a.z + a.w)) + ((b.x + b.y) + (b.z + b.w)) + ((c.x + c.y) + (c.z + c.w)) + ((d.x + d.y) + (d.z + d.w));
    return rsqrtf(s * (1.0f / 1024.0f) + EPS);
}
__device__ __forceinline__ const float* xin_row(ArgsP A, int r) {
    if (r < MP) return A->in[I_XP] + (size_t)r * D;
    if (r < MO) return A->in[I_XS] + (size_t)(r - MP) * D;
    if (r < MX) return A->in[I_META] + (size_t)(r - MO) * D;
    return nullptr;
}

__device__ __forceinline__ void p0_transpose_item(const float* W, int K, int N, bf16* WT, int il, LAS float* scr, int item, int lane) {
    const int nblk = N / 32, kb = item / nblk, nb = item % nblk, k0 = 64 * kb, n0 = 32 * nb;
#pragma unroll 8
    for (int i = 0; i < 32; ++i) { const int kk = 2 * i + (lane >> 5); scr[kk * 33 + (lane & 31)] = W[(size_t)(k0 + kk) * N + n0 + (lane & 31)]; }
    asm volatile("s_waitcnt lgkmcnt(0)" ::: "memory");
    const int rbase = il == 0 ? n0 : ((n0 >> 7) * 256 + (n0 & 127) + (il == 2 ? 128 : 0));
    const int c = lane & 7;
#pragma unroll
    for (int j = 0; j < 4; ++j) { const int n = (lane >> 3) + 8 * j; const LAS float* s = scr + (8 * c) * 33 + n;
        u32x4 o; o.x = cvt_pk_bf16(s[0 * 33], s[1 * 33]); o.y = cvt_pk_bf16(s[2 * 33], s[3 * 33]); o.z = cvt_pk_bf16(s[4 * 33], s[5 * 33]); o.w = cvt_pk_bf16(s[6 * 33], s[7 * 33]);
        *(u32x4*)(WT + (size_t)(rbase + n) * K + k0 + 8 * c) = o; }
    asm volatile("s_waitcnt lgkmcnt(0)" ::: "memory");
}
__device__ __forceinline__ void p0_phase(ArgsP A, LAS unsigned char* lds, int wave, int lane) {
    LAS float* scr = (LAS float*)(lds + wave * 16384);
    const int G = gridDim.x, gw = blockIdx.x * NWAVES + wave, NGW = G * NWAVES;
    unsigned char* ws = A->ws;
    constexpr int I_GU = (D / 64) * (FF / 32), I_DN = (FF / 64) * (D / 32), I_IN = (D / 64) * (NIN / 32), I_BR = (512 / 64) * (D / 32), I_OU = (D / 64) * (D / 32);
    constexpr int NITEMS = 4 * I_GU + 2 * I_DN + I_IN + 2 * I_BR + I_OU;
    for (int it = gw; it < NITEMS; it += NGW) {
        int r = it;
        if (r < I_GU) { p0_transpose_item(A->in[I_WG1], D, FF, (bf16*)(ws + WS_WGU1), 1, scr, r, lane); continue; } r -= I_GU;
        if (r < I_GU) { p0_transpose_item(A->in[I_WU1], D, FF, (bf16*)(ws + WS_WGU1), 2, scr, r, lane); continue; } r -= I_GU;
        if (r < I_DN) { p0_transpose_item(A->in[I_WD1], FF, D, (bf16*)(ws + WS_WD1), 0, scr, r, lane); continue; } r -= I_DN;
        if (r < I_IN) { p0_transpose_item(A->in[I_WIN], D, NIN, (bf16*)(ws + WS_WIN), 0, scr, r, lane); continue; } r -= I_IN;
        if (r < I_BR) { p0_transpose_item(A->in[I_WA], 512, D, (bf16*)(ws + WS_WA), 0, scr, r, lane); continue; } r -= I_BR;
        if (r < I_BR) { p0_transpose_item(A->in[I_WB], 512, D, (bf16*)(ws + WS_WB), 0, scr, r, lane); continue; } r -= I_BR;
        if (r < I_OU) { p0_transpose_item(A->in[I_WOUT], D, D, (bf16*)(ws + WS_WOUT), 0, scr, r, lane); continue; } r -= I_OU;
        if (r < I_GU) { p0_transpose_item(A->in[I_WG2], D, FF, (bf16*)(ws + WS_WGU2), 1, scr, r, lane); continue; } r -= I_GU;
        if (r < I_GU) { p0_transpose_item(A->in[I_WU2], D, FF, (bf16*)(ws + WS_WGU2), 2, scr, r, lane); continue; } r -= I_GU;
        p0_transpose_item(A->in[I_WD2], FF, D, (bf16*)(ws + WS_WD2), 0, scr, r, lane);
    }
    bf16* XN = (bf16*)(ws + WS_XN); float* SS0 = (float*)(ws + WS_SS);
    const f32x4* g1 = (const f32x4*)A->in[I_N1] + lane;
    for (int m = gw; m < MPAD; m += NGW) {
        const float* xr = xin_row(A, m);
        unsigned long long* o8 = (unsigned long long*)(XN + (size_t)m * D) + lane;
        float s = 0.f;
        if (xr) {
            const f32x4* x4 = (const f32x4*)xr + lane;
#pragma unroll
            for (int j = 0; j < 4; ++j) { f32x4 v = x4[64 * j]; const f32x4 g = g1[64 * j]; s += (v.x * v.x + v.y * v.y) + (v.z * v.z + v.w * v.w);
                o8[64 * j] = (unsigned long long)cvt_pk_bf16(v.x * g.x, v.y * g.y) | ((unsigned long long)cvt_pk_bf16(v.z * g.z, v.w * g.w) << 32); }
        } else {
#pragma unroll
            for (int j = 0; j < 4; ++j) o8[64 * j] = 0ull;
        }
        s = wave_sum(s);
        if (lane < 16) SS0[(size_t)m * 16 + lane] = lane == 0 ? s : 0.f;
    }
}

struct EpiSwiGLU {
    static constexpr bool PERM = true, AFTER_DRAIN = false;
    bf16* act; const float* ss;
    __device__ __forceinline__ void operator()(const f32x4 (&acc)[2][2][4][2], const pg8::Unit& u, int wr, int wc, int fr, int fq) const {
        const int col0 = u.pn * 128 + wc * 32 + 8 * fq;
#pragma unroll
        for (int ai = 0; ai < 2; ++ai)
#pragma unroll
            for (int m = 0; m < 4; ++m) {
                const int r = u.pm * 256 + ai * 128 + wr * 64 + m * 16 + fr;
                const float rs = rstd_from_ss(ss, r);
                float o[8];
#pragma unroll
                for (int n = 0; n < 2; ++n)
#pragma unroll
                    for (int e = 0; e < 4; ++e) { const float g = acc[ai][0][m][n][e] * rs, up = acc[ai][1][m][n][e] * rs; o[4 * n + e] = g * up / (1.0f + ex2(-g * LOG2E)); }
                u32x4 w; w.x = cvt_pk_bf16(o[0], o[1]); w.y = cvt_pk_bf16(o[2], o[3]); w.z = cvt_pk_bf16(o[4], o[5]); w.w = cvt_pk_bf16(o[6], o[7]);
                *(u32x4*)(act + (size_t)r * FF + col0) = w;
            }
    }
};
template <int SRC_INPUTS, int HALF_SCALE, int HAS_XN> struct EpiResid {
    static constexpr bool PERM = false, AFTER_DRAIN = false;
    const float* xp; const float* xs; const float* xm; float* X; bf16* XN; const float* gnext; float* ss;
    __device__ __forceinline__ void operator()(const f32x4 (&acc)[2][2][4][2], const pg8::Unit& u, int wr, int wc, int fr, int fq) const {
        const int col0 = u.pn * 256 + wc * 32 + 4 * fq;
#pragma unroll
        for (int ai = 0; ai < 2; ++ai)
#pragma unroll
            for (int m = 0; m < 4; ++m) {
                const int r = u.pm * 256 + ai * 128 + wr * 64 + m * 16 + fr;
                const float* srow = SRC_INPUTS ? (r < MP ? xp + (size_t)r * D : (r < MO ? xs + (size_t)(r - MP) * D : (r < MX ? xm + (size_t)(r - MO) * D : nullptr))) : (X + (size_t)r * D);
                float s = 0.f;
#pragma unroll
                for (int bj = 0; bj < 2; ++bj)
#pragma unroll
                    for (int n = 0; n < 2; ++n) {
                        const int c = col0 + bj * 128 + n * 16;
                        f32x4 v = acc[ai][bj][m][n] * (HALF_SCALE ? 0.5f : 1.0f);
                        if (srow) v += *(const f32x4*)(srow + c);
                        s += (v.x * v.x + v.y * v.y) + (v.z * v.z + v.w * v.w);
                        if (r < MO) *(f32x4*)(X + (size_t)r * D + c) = v;
                        if (HAS_XN) { const f32x4 g = *(const f32x4*)(gnext + c); u32x2 w; w.x = cvt_pk_bf16(v.x * g.x, v.y * g.y); w.y = cvt_pk_bf16(v.z * g.z, v.w * g.w); *(u32x2*)(XN + (size_t)r * D + c) = w; }
                    }
                s += __shfl_xor(s, 16); s += __shfl_xor(s, 32);
                if (fq == 0) ss[(size_t)r * 16 + u.pn * 4 + wc] = s;
            }
    }
};
struct EpiWin {
    static constexpr bool PERM = false, AFTER_DRAIN = false;
    unsigned char* ws; float* out; const float* lbp; const float* bgp; const float* ss;
    template <int TYPE> __device__ __forceinline__ void run(const f32x4 (&acc)[2][2][4][2], const pg8::Unit& u, int wr, int wc, int fr, int fq, int cbase) const {
        const int col0 = u.pn * 256 + wc * 32 + 4 * fq - cbase;
#pragma unroll
        for (int ai = 0; ai < 2; ++ai)
#pragma unroll
            for (int m = 0; m < 4; ++m) {
                const int r = u.pm * 256 + ai * 128 + wr * 64 + m * 16 + fr;
                const int rlim = (TYPE == 0 || TYPE >= 6) ? MO : MX;
                if (r < rlim) {
                const float rs = rstd_from_ss(ss, r);
#pragma unroll
                for (int bj = 0; bj < 2; ++bj)
#pragma unroll
                    for (int n = 0; n < 2; ++n) {
                        const int cc = col0 + bj * 128 + n * 16;
                        const f32x4 v = acc[ai][bj][m][n] * rs;
                        if (TYPE == 0) {
                            u32x2 w; w.x = cvt_pk_bf16(v.x * QSCALE, v.y * QSCALE); w.y = cvt_pk_bf16(v.z * QSCALE, v.w * QSCALE); *(u32x2*)((bf16*)(ws + WS_QB) + (size_t)r * 512 + cc) = w;
                        } else if (TYPE == 1 || TYPE == 2) {
                            const size_t ob = TYPE == 2 ? O_PV : O_PK, os = TYPE == 2 ? O_SV : O_SK;
                            if (r < MP) { const int b = r >> 12, t = r & 4095; *(f32x4*)(out + ob + ((size_t)(b * LP + 16 + t)) * 512 + cc) = v; }
                            else if (r < MO) { *(f32x4*)(out + os + (size_t)(r - MP) * 512 + cc) = v; }
                            else { const int mm = r - MO;
#pragma unroll
                                for (int b = 0; b < 4; ++b) *(f32x4*)(out + ob + ((size_t)(b * LP + mm)) * 512 + cc) = v; }
                        } else if (TYPE == 3) {
                            const f32x4 l0 = *(const f32x4*)(lbp + cc), l1 = *(const f32x4*)(lbp + 512 + cc);
                            _Float16 h[4];
#pragma unroll
                            for (int e = 0; e < 4; ++e) { const float oml = 1.0f / (1.0f + ex2((l1[e] - l0[e]) * LOG2E));
                                h[e] = (_Float16)(oml / (1.0f + ex2(v[e] * LOG2E))); }
                            u32x2 w; w.x = (unsigned)__builtin_bit_cast(unsigned short, h[0]) | ((unsigned)__builtin_bit_cast(unsigned short, h[1]) << 16);
                            w.y = (unsigned)__builtin_bit_cast(unsigned short, h[2]) | ((unsigned)__builtin_bit_cast(unsigned short, h[3]) << 16);
                            *(u32x2*)((unsigned short*)(ws + WS_KKH) + (size_t)r * 512 + cc) = w;
                        } else if (TYPE == 4) {
                            const int h = cc >> 7, vv = cc & 127;
                            const unsigned w01 = cvt_pk_bf16(v.x, v.y), w23 = cvt_pk_bf16(v.z, v.w);
                            const bf16 e0 = (bf16)(w01 & 0xffffu), e1 = (bf16)(w01 >> 16), e2 = (bf16)(w23 & 0xffffu), e3 = (bf16)(w23 >> 16);
                            if (r < MP) { const int b = r >> 12, t = r & 4095; bf16* p = (bf16*)(ws + WS_IVTP) + ((size_t)((b * 4 + h) * 128 + vv)) * LP + 16 + t; p[0] = e0; p[LP] = e1; p[2 * LP] = e2; p[3 * LP] = e3; }
                            else if (r < MO) { const int s = (r - MP) >> 5, t = (r - MP) & 31; bf16* p = (bf16*)(ws + WS_IVTS) + ((size_t)((s * 4 + h) * 128 + vv)) * 64 + t; p[0] = e0; p[64] = e1; p[128] = e2; p[192] = e3; }
                            else { const int mm = r - MO;
#pragma unroll
                                for (int b = 0; b < 4; ++b) { bf16* p = (bf16*)(ws + WS_IVTP) + ((size_t)((b * 4 + h) * 128 + vv)) * LP + mm; p[0] = e0; p[LP] = e1; p[2 * LP] = e2; p[3 * LP] = e3; } }
                        } else if (TYPE == 5) {
                            u32x2 w; w.x = cvt_pk_bf16(v.x, v.y); w.y = cvt_pk_bf16(v.z, v.w); *(u32x2*)((bf16*)(ws + WS_QH) + (size_t)r * 512 + cc) = w;
                        } else if (TYPE == 6) {
                            float o[4];
#pragma unroll
                            for (int e = 0; e < 4; ++e) o[e] = v[e] / (1.0f + ex2(-v[e] * LOG2E));
                            u32x2 w; w.x = cvt_pk_bf16(o[0], o[1]); w.y = cvt_pk_bf16(o[2], o[3]); *(u32x2*)((bf16*)(ws + WS_SG) + (size_t)r * 512 + cc) = w;
                        } else {
                            const f32x4 bg = *(const f32x4*)(bgp + (TYPE == 8 ? 1024 : 0) + cc); float o[4];
#pragma unroll
                            for (int e = 0; e < 4; ++e) o[e] = 1.0f / (1.0f + ex2(-(v[e] + bg[e]) * LOG2E));
                            u32x2 w; w.x = cvt_pk_bf16(o[0], o[1]); w.y = cvt_pk_bf16(o[2], o[3]); *(u32x2*)((bf16*)(ws + (TYPE == 8 ? WS_GB : WS_GA)) + (size_t)r * D + cc) = w;
                        }
                    }
                }
            }
    }
    __device__ __forceinline__ void operator()(const f32x4 (&acc)[2][2][4][2], const pg8::Unit& u, int wr, int wc, int fr, int fq) const {
        const int pn = u.pn;
        if (pn < 2) run<0>(acc, u, wr, wc, fr, fq, 0);
        else if (pn < 4) run<1>(acc, u, wr, wc, fr, fq, 512);
        else if (pn < 6) run<2>(acc, u, wr, wc, fr, fq, 1024);
        else if (pn < 8) run<3>(acc, u, wr, wc, fr, fq, 1536);
        else if (pn < 10) run<4>(acc, u, wr, wc, fr, fq, 2048);
        else if (pn < 12) run<5>(acc, u, wr, wc, fr, fq, 2560);
        else if (pn < 14) run<6>(acc, u, wr, wc, fr, fq, 3072);
        else if (pn < 18) run<7>(acc, u, wr, wc, fr, fq, 3584);
        else run<8>(acc, u, wr, wc, fr, fq, 4608);
    }
};
__device__ __forceinline__ float bf2f(unsigned short h) { return __builtin_bit_cast(float, (unsigned)h << 16); }
template <int PASS> struct EpiMerge {
    static constexpr bool PERM = false, AFTER_DRAIN = false;
    bf16* ga; const bf16* gb;
    __device__ __forceinline__ void operator()(const f32x4 (&acc)[2][2][4][2], const pg8::Unit& u, int wr, int wc, int fr, int fq) const {
        const int col0 = u.pn * 256 + wc * 32 + 4 * fq;
#pragma unroll
        for (int ai = 0; ai < 2; ++ai)
#pragma unroll
            for (int m = 0; m < 4; ++m) {
                const int r = u.pm * 256 + ai * 128 + wr * 64 + m * 16 + fr;
#pragma unroll
                for (int bj = 0; bj < 2; ++bj)
#pragma unroll
                    for (int n = 0; n < 2; ++n) {
                        const int c = col0 + bj * 128 + n * 16;
                        const f32x4 v = acc[ai][bj][m][n];
                        u32x2* pa = (u32x2*)(ga + (size_t)r * D + c);
                        const u32x2 wa = *pa;
                        const float a0 = bf2f(wa.x & 0xffffu), a1 = bf2f(wa.x >> 16), a2 = bf2f(wa.y & 0xffffu), a3 = bf2f(wa.y >> 16);
                        float o0, o1, o2, o3;
                        if (PASS == 0) { o0 = a0 * v.x; o1 = a1 * v.y; o2 = a2 * v.z; o3 = a3 * v.w; }
                        else { const u32x2 wb = *(const u32x2*)(gb + (size_t)r * D + c);
                            o0 = a0 + bf2f(wb.x & 0xffffu) * v.x; o1 = a1 + bf2f(wb.x >> 16) * v.y; o2 = a2 + bf2f(wb.y & 0xffffu) * v.z; o3 = a3 + bf2f(wb.y >> 16) * v.w; }
                        u32x2 w; w.x = cvt_pk_bf16(o0, o1); w.y = cvt_pk_bf16(o2, o3); *pa = w;
                    }
            }
    }
};

__device__ __forceinline__ bf16x8 pack8(const float* f) { u32x4 w; w.x = cvt_pk_bf16(f[0], f[1]); w.y = cvt_pk_bf16(f[2], f[3]); w.z = cvt_pk_bf16(f[4], f[5]); w.w = cvt_pk_bf16(f[6], f[7]); return __builtin_bit_cast(bf16x8, w); }
template <bool WRITE> __device__ __forceinline__ void attn_item(ArgsP A, int item, int lane) {
    const float* kdiag; const float* vdiag; const float* klow; const float* vlow; int qrow0, posq0, nblk, h;
    if (item < 4096) { const int b = item >> 10; h = (item >> 7) & 7; const int qt = item & 127;
        qrow0 = b * 4096 + 32 * qt; posq0 = 16 + 32 * qt; nblk = qt + 2;
        klow = A->out + O_PK + (size_t)b * LP * 512 + h * 64; vlow = A->out + O_PV + (size_t)b * LP * 512 + h * 64;
        kdiag = klow + (size_t)posq0 * 512; vdiag = vlow + (size_t)posq0 * 512;
    } else { const int id = item - 4096, s = id >> 3; h = id & 7;
        qrow0 = MP + 32 * s; posq0 = LC; nblk = 66;
        klow = A->in[I_CK] + (size_t)s * LC * 512 + h * 64; vlow = A->in[I_CV] + (size_t)s * LC * 512 + h * 64;
        kdiag = A->out + O_SK + (size_t)s * 32 * 512 + h * 64; vdiag = A->out + O_SV + (size_t)s * 32 * 512 + h * 64;
    }
    bf16* qo = (bf16*)(A->ws + WS_QB) + (size_t)qrow0 * 512 + h * 64;
    const int ql = lane & 31, hi = lane >> 5;
    bf16x8 qf[4];
#pragma unroll
    for (int s = 0; s < 4; ++s) qf[s] = *(const bf16x8*)(qo + (size_t)ql * 512 + 16 * s + 8 * hi);
    const int rA = (ql & 3) + 4 * (ql >> 3), hA = (ql >> 2) & 1, kappaA = 8 * hA + rA + (rA >= 8 ? 8 : 0);
    f32x16 o0, o1;
#pragma unroll
    for (int r = 0; r < 16; ++r) { o0[r] = 0.f; o1[r] = 0.f; }
    float R = 0.f;
    for (int j = 0; j < nblk; ++j) {
        const int pos0 = posq0 - 32 * j;
        const float* kb = j == 0 ? kdiag : klow; const float* vb = j == 0 ? vdiag : vlow;
        const int rb = j == 0 ? 0 : pos0;
        int rowA = rb + kappaA; rowA = rowA < 0 ? 0 : rowA;
        const float* kp = kb + (size_t)rowA * 512 + 8 * hi;
        f32x16 sacc;
#pragma unroll
        for (int r = 0; r < 16; ++r) sacc[r] = 0.f;
        f32x4 kv[8];
#pragma unroll
        for (int s = 0; s < 4; ++s) { kv[2 * s] = *(const f32x4*)(kp + 16 * s); kv[2 * s + 1] = *(const f32x4*)(kp + 16 * s + 4); }
        float vv[2][2][8];
#pragma unroll
        for (int st = 0; st < 2; ++st)
#pragma unroll
            for (int i = 0; i < 8; ++i) { int row = rb + 16 * st + 8 * hi + i; row = row < 0 ? 0 : row; const float* vp = vb + (size_t)row * 512 + ql; vv[st][0][i] = vp[0]; vv[st][1][i] = vp[32]; }
#pragma unroll
        for (int s = 0; s < 4; ++s) { float kk[8] = {kv[2 * s].x, kv[2 * s].y, kv[2 * s].z, kv[2 * s].w, kv[2 * s + 1].x, kv[2 * s + 1].y, kv[2 * s + 1].z, kv[2 * s + 1].w};
            sacc = __builtin_amdgcn_mfma_f32_32x32x16_bf16(pack8(kk), qf[s], sacc, 0, 0, 0); }
        float sp[16];
#pragma unroll
        for (int r = 0; r < 16; ++r) { const int kappa = 8 * hi + r + (r >= 8 ? 8 : 0);
            const bool valid = (pos0 + kappa >= 0) && (j > 0 || kappa < ql);
            const float z = sacc[r];
            const float s_ = fmaxf(z, 0.f) + lg2(1.0f + ex2(-fabsf(z)));
            sp[r] = valid ? s_ : 0.f; sacc[r] = valid ? z : -1e30f; }
        float glo = 0.f, ghi = 0.f;
#pragma unroll
        for (int r = 0; r < 8; ++r) { glo += sp[r]; ghi += sp[8 + r]; }
        const float pglo = __shfl_xor(glo, 32), pghi = __shfl_xor(ghi, 32);
        const float base_hi = R + (hi == 0 ? pghi : 0.f);
        const float base_lo = R + ghi + pghi + (hi == 0 ? pglo : 0.f);
        float pa[16];
        { float c = base_hi;
#pragma unroll
          for (int r = 15; r >= 8; --r) { c += sp[r]; pa[r] = ex2(sacc[r] - c); }
          c = base_lo;
#pragma unroll
          for (int r = 7; r >= 0; --r) { c += sp[r]; pa[r] = ex2(sacc[r] - c); } }
        R += (glo + ghi) + (pglo + pghi);
        const bf16x8 p0 = pack8(pa), p1 = pack8(pa + 8);
        o0 = __builtin_amdgcn_mfma_f32_32x32x16_bf16(pack8(vv[0][0]), p0, o0, 0, 0, 0);
        o1 = __builtin_amdgcn_mfma_f32_32x32x16_bf16(pack8(vv[0][1]), p0, o1, 0, 0, 0);
        o0 = __builtin_amdgcn_mfma_f32_32x32x16_bf16(pack8(vv[1][0]), p1, o0, 0, 0, 0);
        o1 = __builtin_amdgcn_mfma_f32_32x32x16_bf16(pack8(vv[1][1]), p1, o1, 0, 0, 0);
        if (__all(R > SB_EXIT)) break;
    }
    if (!WRITE) { if (o0[0] + o1[5] != 12345.678f) return; }
#pragma unroll
    for (int g = 0; g < 4; ++g) {
        u32x2 w; w.x = cvt_pk_bf16(o0[4 * g], o0[4 * g + 1]); w.y = cvt_pk_bf16(o0[4 * g + 2], o0[4 * g + 3]);
        *(u32x2*)(qo + (size_t)ql * 512 + 8 * g + 4 * hi) = w;
        u32x2 w1; w1.x = cvt_pk_bf16(o1[4 * g], o1[4 * g + 1]); w1.y = cvt_pk_bf16(o1[4 * g + 2], o1[4 * g + 3]);
        *(u32x2*)(qo + (size_t)ql * 512 + 32 + 8 * g + 4 * hi) = w1;
    }
}

constexpr int HQ_P = 136, HT_P = 72, HS_P = 72;
constexpr int IMG_KHT = 0, IMG_SC = 128 * HT_P * 2, IMG_DV = IMG_SC + 64 * HS_P * 2, IMG_BYTES = IMG_DV + 512;
constexpr int NPREP = 16 * 65 + 32;
constexpr size_t WS_IMG = WS_XN;
constexpr size_t WS_ORAW = WS_WGU1;
static_assert((size_t)NPREP * IMG_BYTES <= 34603008, "image region");
constexpr int LP_QT = 0, LP_KT = LP_QT + 64 * HQ_P * 2, LP_PART = LP_KT + 64 * HQ_P * 2, LP_END = LP_PART + 8 * 128 * 4;
__device__ __forceinline__ void hgrn_chunk_params(bool prompt, int sidx, int c, int& row0, int& nvalid, int& pos0) {
    if (prompt) { if (c == 0) { row0 = MO; nvalid = 16; pos0 = 0; } else { row0 = sidx * 4096 + 64 * (c - 1); nvalid = 64; pos0 = 16 + 64 * (c - 1); } }
    else { row0 = MP + 32 * sidx; nvalid = 32; pos0 = 0; }
}
template <bool WRITE> __device__ __forceinline__ void hgrn_prep(ArgsP A, LAS unsigned char* lds, int item, int tid) {
    const int lane = tid & 63, w = __builtin_amdgcn_readfirstlane(tid >> 6), l16 = lane & 15, g = lane >> 4;
    const bool prompt = item < 1040; const int bh = prompt ? item / 65 : item - 1040, c = prompt ? item % 65 : 0, sidx = bh >> 2, h = bh & 3;
    int row0, nvalid, pos0; hgrn_chunk_params(prompt, sidx, c, row0, nvalid, pos0);
    LAS bf16* Qt = (LAS bf16*)(lds + LP_QT); LAS bf16* Kt = (LAS bf16*)(lds + LP_KT); LAS float* part = (LAS float*)(lds + LP_PART);
    unsigned char* img = A->ws + WS_IMG + (size_t)item * IMG_BYTES;
    const unsigned short* kkh = (const unsigned short*)(A->ws + WS_KKH); bf16* qh = (bf16*)(A->ws + WS_QH);
    const int kp = lane, tg = w;
    float kk[8][2], qv[8][2], cb[8][2]; float run0 = 0.f, run1 = 0.f;
#pragma unroll
    for (int i = 0; i < 8; ++i) { const int t = 8 * tg + i;
        if (t < nvalid) { const size_t off = (size_t)(row0 + t) * 512 + h * 128 + 2 * kp; const unsigned k2 = *(const unsigned*)(kkh + off), q2 = *(const unsigned*)(qh + off);
            kk[i][0] = (float)__builtin_bit_cast(_Float16, (unsigned short)(k2 & 0xffffu)); kk[i][1] = (float)__builtin_bit_cast(_Float16, (unsigned short)(k2 >> 16));
            qv[i][0] = bf2f((unsigned short)(q2 & 0xffffu)); qv[i][1] = bf2f((unsigned short)(q2 >> 16)); }
        else { kk[i][0] = 0.f; kk[i][1] = 0.f; qv[i][0] = 0.f; qv[i][1] = 0.f; } }
#pragma unroll
    for (int i = 0; i < 8; ++i) { run0 += lg2(1.0f - kk[i][0]); run1 += lg2(1.0f - kk[i][1]); cb[i][0] = run0; cb[i][1] = run1; }
    *(LAS f32x2*)(part + tg * 128 + 2 * kp) = (f32x2){run0, run1};
    __syncthreads();
    float off0 = 0.f, off1 = 0.f, tot0 = 0.f, tot1 = 0.f;
#pragma unroll
    for (int q = 0; q < 8; ++q) { const f32x2 p = *(const LAS f32x2*)(part + q * 128 + 2 * kp); if (q < tg) { off0 += p.x; off1 += p.y; } tot0 += p.x; tot1 += p.y; }
    if (WRITE && tg == 0) *(f32x2*)(img + IMG_DV + 8 * kp) = (f32x2){ex2(tot0), ex2(tot1)};
    float kh0[8], kh1[8];
#pragma unroll
    for (int i = 0; i < 8; ++i) { const int t = 8 * tg + i; const float b0 = off0 + cb[i][0], b1 = off1 + cb[i][1];
        const unsigned qq = cvt_pk_bf16(qv[i][0] * ex2(b0), qv[i][1] * ex2(b1)), kq = cvt_pk_bf16(kk[i][0] * ex2(-b0), kk[i][1] * ex2(-b1));
        *(LAS unsigned*)(Qt + t * HQ_P + 2 * kp) = qq; *(LAS unsigned*)(Kt + t * HQ_P + 2 * kp) = kq;
        if (WRITE && t < nvalid) *(unsigned*)(qh + (size_t)(row0 + t) * 512 + h * 128 + 2 * kp) = qq;
        kh0[i] = kk[i][0] * ex2(tot0 - b0); kh1[i] = kk[i][1] * ex2(tot1 - b1); }
    if (WRITE) { *(bf16x8*)(img + IMG_KHT + ((2 * kp) * HT_P + 8 * tg) * 2) = pack8(kh0);
    *(bf16x8*)(img + IMG_KHT + ((2 * kp + 1) * HT_P + 8 * tg) * 2) = pack8(kh1); }
    else if (kh0[0] + kh1[7] == 12345.678f) part[0] = kh0[1];
    __syncthreads();
    bf16* sci = (bf16*)(img + IMG_SC);
#pragma unroll
    for (int q = 0; q < 2; ++q) { const int id = 2 * w + q, mt = id >> 2, nt = id & 3;
        f32x4 sc = {0.f, 0.f, 0.f, 0.f};
        if (mt >= nt) {
#pragma unroll
            for (int ks = 0; ks < 4; ++ks) { const bf16x8 a = *(const LAS bf16x8*)(Qt + (16 * mt + l16) * HQ_P + 32 * ks + 8 * g), b = *(const LAS bf16x8*)(Kt + (16 * nt + l16) * HQ_P + 32 * ks + 8 * g);
                sc = __builtin_amdgcn_mfma_f32_16x16x32_bf16(a, b, sc, 0, 0, 0); }
        }
#pragma unroll
        for (int j = 0; j < 4; ++j) { const int t = 16 * mt + 4 * g + j, s_ = 16 * nt + l16; const float v = (t >= s_) ? sc[j] : 0.f;
            if (WRITE || v == 12345.678f) sci[t * HS_P + s_] = (bf16)(cvt_pk_bf16(v, 0.f) & 0xffffu); }
    }
    __syncthreads();
}
constexpr int LS_QT = 0, LS_SG = LS_QT + 64 * HQ_P * 2, LS_IMG = LS_SG + 64 * HQ_P * 2, LS_BUF = LS_IMG + IMG_BYTES, LS_SSQ = 2 * LS_BUF, LS_END = LS_SSQ + 2 * 2048;
static_assert(LS_END <= 131072 && (LS_BUF % 16) == 0, "hgrn scan lds");
#define WG_BAR() do { asm volatile("s_waitcnt lgkmcnt(0)" ::: "memory"); __builtin_amdgcn_s_barrier(); asm volatile("" ::: "memory"); } while (0)
template <bool WRITE> __device__ __forceinline__ void hgrn_scan(ArgsP A, LAS unsigned char* lds, int item, int tid) {
    const int lane = tid & 63, w = __builtin_amdgcn_readfirstlane(tid >> 6), l16 = lane & 15, g = lane >> 4;
    const bool prompt = item < 16; const int sidx = prompt ? (item >> 2) : ((item - 16) >> 2), h = item & 3;
    const int nchunk = prompt ? 65 : 1;
    const bf16* qh = (const bf16*)(A->ws + WS_QH); bf16* oraw = (bf16*)(A->ws + WS_ORAW);
    const unsigned char* imgb = A->ws + WS_IMG + (size_t)(prompt ? (sidx * 4 + h) * 65 : 1040 + (sidx * 4 + h)) * IMG_BYTES;
    const int vcol = 16 * w + l16;
    const bf16* ivtb = prompt ? ((const bf16*)(A->ws + WS_IVTP) + ((size_t)((sidx * 4 + h) * 128 + vcol)) * LP) : ((const bf16*)(A->ws + WS_IVTS) + ((size_t)((sidx * 4 + h) * 128 + vcol)) * 64);
    const float gn = A->in[I_HGN][h * 128 + vcol];
    f32x4 S[8];
    if (prompt) {
#pragma unroll
        for (int mt = 0; mt < 8; ++mt) S[mt] = (f32x4){0.f, 0.f, 0.f, 0.f};
    } else {
        const float* st = A->in[I_ST] + (size_t)(sidx * 4 + h) * 16384;
#pragma unroll
        for (int mt = 0; mt < 8; ++mt)
#pragma unroll
            for (int j = 0; j < 4; ++j) S[mt][j] = st[(size_t)(16 * mt + 4 * g + j) * 128 + vcol];
    }
    const int prow = tid >> 4, pseg = tid & 15;
    const unsigned qoff = (unsigned)(prow * (HQ_P * 2) + pseg * 16);
    const u32x4 Z4 = {0u, 0u, 0u, 0u};
    u32x4 X[8], Y[8];
#define HG_ISSUE(SET, cidx) do { int c_ = (cidx); c_ = c_ < nchunk ? c_ : nchunk - 1; int row0_, nv_, pos0_; hgrn_chunk_params(prompt, sidx, c_, row0_, nv_, pos0_); \
        const size_t go_ = (size_t)(row0_ + prow) * 512 + h * 128 + pseg * 8; \
        _Pragma("unroll") for (int i_ = 0; i_ < 2; ++i_) { const unsigned m_ = (prow + 32 * i_ < nv_) ? 0xffffffffu : 0u; SET[i_] = *(const u32x4*)(qh + go_ + (size_t)i_ * 32 * 512) & m_; } \
        const unsigned char* im_ = imgb + (size_t)c_ * IMG_BYTES + tid * 16; \
        _Pragma("unroll") for (int i_ = 0; i_ < 4; ++i_) SET[4 + i_] = *(const u32x4*)(im_ + 8192 * i_); } while (0)
#define HG_BIV(DST, cidx) do { int c_ = (cidx); c_ = c_ < nchunk ? c_ : nchunk - 1; int row0_, nv_, pos0_; hgrn_chunk_params(prompt, sidx, c_, row0_, nv_, pos0_); \
        _Pragma("unroll") for (int s_ = 0; s_ < 2; ++s_) { const unsigned m_ = (32 * s_ + 8 * g < nv_) ? 0xffffffffu : 0u; DST[s_] = *(const u32x4*)(ivtb + pos0_ + 32 * s_ + 8 * g) & m_; } } while (0)
#define HG_COMMIT(SET, boff) do { LAS unsigned char* b_ = lds + (boff); \
        _Pragma("unroll") for (int i_ = 0; i_ < 2; ++i_) { *(LAS u32x4*)(b_ + LS_QT + qoff + i_ * 32 * HQ_P * 2) = SET[i_]; } \
        _Pragma("unroll") for (int i_ = 0; i_ < 4; ++i_) { if (tid + 512 * i_ < IMG_BYTES / 16) *(LAS u32x4*)(b_ + LS_IMG + tid * 16 + 8192 * i_) = SET[4 + i_]; } } while (0)
#define HG_COMPUTE(cidx, boff, bivc) do { const int c_ = (cidx); int row0_, nv_, pos0_; hgrn_chunk_params(prompt, sidx, c_, row0_, nv_, pos0_); const bool wr_ = !(prompt && c_ == 0); \
        LAS unsigned char* b_ = lds + (boff); const LAS bf16* Qt = (const LAS bf16*)(b_ + LS_QT); const LAS bf16* Sg = (const LAS bf16*)(b_ + LS_SG); \
        const LAS bf16* KhT = (const LAS bf16*)(b_ + LS_IMG + IMG_KHT); const LAS bf16* Sc = (const LAS bf16*)(b_ + LS_IMG + IMG_SC); const LAS float* dv = (const LAS float*)(b_ + LS_IMG + IMG_DV); \
        LAS float* ssq = (LAS float*)(lds + LS_SSQ + (c_ & 1) * 2048); \
        bf16x8 bs[4]; \
        _Pragma("unroll") for (int ks = 0; ks < 4; ++ks) { u32x4 t_; t_.x = cvt_pk_bf16(S[2 * ks][0], S[2 * ks][1]); t_.y = cvt_pk_bf16(S[2 * ks][2], S[2 * ks][3]); t_.z = cvt_pk_bf16(S[2 * ks + 1][0], S[2 * ks + 1][1]); t_.w = cvt_pk_bf16(S[2 * ks + 1][2], S[2 * ks + 1][3]); bs[ks] = __builtin_bit_cast(bf16x8, t_); } \
        const bf16x8 biv0 = __builtin_bit_cast(bf16x8, bivc[0]), biv1 = __builtin_bit_cast(bf16x8, bivc[1]); \
        f32x4 o[4]; \
        _Pragma("unroll") for (int mt = 0; mt < 4; ++mt) { f32x4 a4 = {0.f, 0.f, 0.f, 0.f}; \
            a4 = __builtin_amdgcn_mfma_f32_16x16x32_bf16(*(const LAS bf16x8*)(Sc + (16 * mt + l16) * HS_P + 8 * g), biv0, a4, 0, 0, 0); \
            a4 = __builtin_amdgcn_mfma_f32_16x16x32_bf16(*(const LAS bf16x8*)(Sc + (16 * mt + l16) * HS_P + 32 + 8 * g), biv1, a4, 0, 0, 0); \
            _Pragma("unroll") for (int ks = 0; ks < 4; ++ks) { const u32x2 lo_ = *(const LAS u32x2*)(Qt + (16 * mt + l16) * HQ_P + 32 * ks + 4 * g), hi_ = *(const LAS u32x2*)(Qt + (16 * mt + l16) * HQ_P + 32 * ks + 16 + 4 * g); \
                u32x4 t_; t_.x = lo_.x; t_.y = lo_.y; t_.z = hi_.x; t_.w = hi_.y; a4 = __builtin_amdgcn_mfma_f32_16x16x32_bf16(__builtin_bit_cast(bf16x8, t_), bs[ks], a4, 0, 0, 0); } \
            o[mt] = a4; } \
        _Pragma("unroll") for (int mt = 0; mt < 8; ++mt) { const f32x4 d4 = *(const LAS f32x4*)(dv + 16 * mt + 4 * g); f32x4 a4 = S[mt] * d4; \
            a4 = __builtin_amdgcn_mfma_f32_16x16x32_bf16(*(const LAS bf16x8*)(KhT + (16 * mt + l16) * HT_P + 8 * g), biv0, a4, 0, 0, 0); \
            a4 = __builtin_amdgcn_mfma_f32_16x16x32_bf16(*(const LAS bf16x8*)(KhT + (16 * mt + l16) * HT_P + 32 + 8 * g), biv1, a4, 0, 0, 0); \
            S[mt] = a4; } \
        if (wr_) { _Pragma("unroll") for (int mt = 0; mt < 4; ++mt) _Pragma("unroll") for (int j = 0; j < 4; ++j) { const int t = 16 * mt + 4 * g + j; \
            if (t < nv_) oraw[(size_t)(row0_ + t) * 512 + h * 128 + vcol] = (bf16)(cvt_pk_bf16(o[mt][j], 0.f) & 0xffffu); } } \
        WG_BAR(); } while (0)
    u32x4 bivA[2], bivB[2];
    HG_ISSUE(X, 0); HG_BIV(bivA, 0); HG_ISSUE(Y, 1); HG_BIV(bivB, 1);
    HG_COMMIT(X, 0);
    HG_ISSUE(X, 2);
    WG_BAR();
    for (int c = 0; c < nchunk; c += 2) {
        if (c + 1 < nchunk) HG_COMMIT(Y, LS_BUF);
        HG_ISSUE(Y, c + 3);
        HG_COMPUTE(c, 0, bivA);
        HG_BIV(bivA, c + 2);
        if (c + 1 < nchunk) {
            if (c + 2 < nchunk) HG_COMMIT(X, 0);
            HG_ISSUE(X, c + 4);
            HG_COMPUTE(c + 1, LS_BUF, bivB);
            HG_BIV(bivB, c + 3);
        }
    }
#undef HG_ISSUE
#undef HG_BIV
#undef HG_COMMIT
#undef HG_COMPUTE
    float* so = A->out + (prompt ? O_PH : O_SH) + (size_t)(sidx * 4 + h) * 16384;
#pragma unroll
    for (int mt = 0; mt < 8; ++mt)
#pragma unroll
        for (int j = 0; j < 4; ++j) so[(size_t)(16 * mt + 4 * g + j) * 128 + vcol] = S[mt][j];
    WG_BAR();
}

__device__ __forceinline__ void hgrn_finalize(ArgsP A, int gw, int ngw, int lane) {
    const bf16* oraw = (const bf16*)(A->ws + WS_ORAW); bf16* sg = (bf16*)(A->ws + WS_SG); const float* gnp = A->in[I_HGN];
    for (int it = gw; it < MO * 4; it += ngw) { const int row = it >> 2, h = it & 3; const size_t off = (size_t)row * 512 + h * 128 + 2 * lane;
        const unsigned ow = *(const unsigned*)(oraw + off), sw = *(const unsigned*)(sg + off);
        const float o0 = bf2f((unsigned short)(ow & 0xffffu)), o1 = bf2f((unsigned short)(ow >> 16));
        const float tot = wave_sum(o0 * o0 + o1 * o1);
        const float rs = rsqrtf(tot * (1.0f / 128.0f) + EPS);
        const f32x2 gn = *(const f32x2*)(gnp + h * 128 + 2 * lane);
        *(unsigned*)(sg + off) = cvt_pk_bf16(o0 * rs * gn.x * bf2f((unsigned short)(sw & 0xffffu)), o1 * rs * gn.y * bf2f((unsigned short)(sw >> 16))); }
}

__global__ void __launch_bounds__(NTHREADS, 2) mega_fwd(Args Aunused) {
    extern __shared__ __attribute__((aligned(16))) unsigned char lds_raw[];
    LAS unsigned char* lds = (LAS unsigned char*)lds_raw;
    cg::grid_group grid = cg::this_grid();
#define GRID_SYNC() do { asm volatile("s_waitcnt vmcnt(0)" ::: "memory"); grid.sync(); \
        if (threadIdx.x < 64) { __builtin_amdgcn_fence(__ATOMIC_ACQUIRE, "agent"); asm volatile("s_waitcnt vmcnt(0)" ::: "memory"); } __syncthreads(); } while (0)
#define TIDL ({ int t_ = threadIdx.x; asm volatile("" : "+v"(t_)); t_; })
#define LANE (tid & 63)
#define WAVE (__builtin_amdgcn_readfirstlane(tid >> 6))
#define GX ((int)gridDim.x)
#define BX ((int)blockIdx.x)
#define SSP(A, i) ((float*)((A)->ws + WS_SS + (size_t)(i) * SS_BYTES))

#ifndef REP_P0
#define REP_P0 1
#endif
#ifndef REP_P1
#define REP_P1 1
#endif
#ifndef REP_P2
#define REP_P2 1
#endif
#ifndef REP_SYNC
#define REP_SYNC 0
#endif
    for (int rep = 0; rep < REP_P0; ++rep) {
    { const int tid = TIDL; p0_phase(argsp(), lds, WAVE, LANE); }
    GRID_SYNC();
    }
    for (int rep = 0; rep < REP_SYNC; ++rep) GRID_SYNC();
    for (int rep = 0; rep < REP_P1; ++rep) {
    { ArgsP A = argsp(); unsigned char* ws = A->ws; pg8::Gemm g{(const bf16*)(ws + WS_XN), (const bf16*)(ws + WS_WGU1), MPAD, 2 * FF, D}; pg8::StaticOrder S; S.init(MPAD, 2 * FF, GX, BX); EpiSwiGLU E{(bf16*)(ws + WS_ACT), SSP(A, 0)};
      pg8::gemm_phase<EpiSwiGLU, pg8::StaticOrder, true, true>(lds, g, S, E); }
    GRID_SYNC();
    }
    for (int rep = 0; rep < REP_P2; ++rep) {
    { ArgsP A = argsp(); unsigned char* ws = A->ws; pg8::Gemm g{(const bf16*)(ws + WS_ACT), (const bf16*)(ws + WS_WD1), MPAD, D, FF}; pg8::StaticOrder S; S.init(MPAD, D, GX, BX);
      EpiResid<1, 1, 1> E{A->in[I_XP], A->in[I_XS], A->in[I_META], A->out, (bf16*)(ws + WS_XN), A->in[I_NMIX], SSP(A, 1)};
      pg8::gemm_phase<EpiResid<1, 1, 1>, pg8::StaticOrder, true, true>(lds, g, S, E); }
    GRID_SYNC();
    }
#ifndef REP_P3
#define REP_P3 1
#endif
#ifndef REP_P34
#define REP_P34 1
#endif
    for (int rep34 = 0; rep34 < REP_P34; ++rep34) {
    for (int rep3 = 0; rep3 < REP_P3; ++rep3) {
    { ArgsP A = argsp(); unsigned char* ws = A->ws; pg8::Gemm g{(const bf16*)(ws + WS_XN), (const bf16*)(ws + WS_WIN), MPAD, NIN, D}; pg8::StaticOrder S; S.init(MPAD, NIN, GX, BX); EpiWin E{ws, A->out, A->in[I_LB], A->in[I_BG], SSP(A, 1)};
      pg8::gemm_phase<EpiWin, pg8::StaticOrder, true, true>(lds, g, S, E); }
    GRID_SYNC();
    }
#ifdef REP_PREP
    { const int tid = TIDL; for (int it = BX; it < NPREP; it += GX) hgrn_prep<false>(argsp(), lds, it, tid); }
#endif
    { const int tid = TIDL; for (int it = BX; it < NPREP; it += GX) hgrn_prep<true>(argsp(), lds, it, tid); }
    GRID_SYNC();
    {
        const int G = GX, bx = BX; const int tid = TIDL;
        const int abase = G > 48 ? 48 : 0, na = G - abase;
#ifdef REP_SCAN
        for (int it = bx; it < 48; it += G) hgrn_scan<false>(argsp(), lds, it, tid);
#endif
        for (int it = bx; it < 48; it += G) hgrn_scan<true>(argsp(), lds, it, tid);
#ifdef REP_ATT
        if (bx >= abase) for (int it = (bx - abase) * NWAVES + WAVE; it < 4160; it += na * NWAVES) attn_item<false>(argsp(), it, LANE);
#endif
        if (bx >= abase) for (int it = (bx - abase) * NWAVES + WAVE; it < 4160; it += na * NWAVES) attn_item<true>(argsp(), it, LANE);
    }
    GRID_SYNC();
    { const int tid = TIDL; hgrn_finalize(argsp(), BX * NWAVES + WAVE, GX * NWAVES, LANE); }
    GRID_SYNC();
    }
    { ArgsP A = argsp(); unsigned char* ws = A->ws; pg8::Gemm g{(const bf16*)(ws + WS_QB), (const bf16*)(ws + WS_WA), MO, D, 512}; pg8::StaticOrder S; S.init(MO, D, GX, BX); EpiMerge<0> E{(bf16*)(ws + WS_GA), (const bf16*)(ws + WS_GB)};
      pg8::gemm_phase<EpiMerge<0>, pg8::StaticOrder, true, true>(lds, g, S, E); }
    __threadfence(); __syncthreads();
    { ArgsP A = argsp(); unsigned char* ws = A->ws; pg8::Gemm g{(const bf16*)(ws + WS_SG), (const bf16*)(ws + WS_WB), MO, D, 512}; pg8::StaticOrder S; S.init(MO, D, GX, BX); EpiMerge<1> E{(bf16*)(ws + WS_GA), (const bf16*)(ws + WS_GB)};
      pg8::gemm_phase<EpiMerge<1>, pg8::StaticOrder, true, true>(lds, g, S, E); }
    GRID_SYNC();
    { ArgsP A = argsp(); unsigned char* ws = A->ws; pg8::Gemm g{(const bf16*)(ws + WS_GA), (const bf16*)(ws + WS_WOUT), MO, D, D}; pg8::StaticOrder S; S.init(MO, D, GX, BX);
      EpiResid<0, 0, 1> E{nullptr, nullptr, nullptr, A->out, (bf16*)(ws + WS_XN), A->in[I_N2], SSP(A, 2)};
      pg8::gemm_phase<EpiResid<0, 0, 1>, pg8::StaticOrder, true, true>(lds, g, S, E); }
    GRID_SYNC();
    { ArgsP A = argsp(); unsigned char* ws = A->ws; pg8::Gemm g{(const bf16*)(ws + WS_XN), (const bf16*)(ws + WS_WGU2), MO, 2 * FF, D}; pg8::StaticOrder S; S.init(MO, 2 * FF, GX, BX); EpiSwiGLU E{(bf16*)(ws + WS_ACT), SSP(A, 2)};
      pg8::gemm_phase<EpiSwiGLU, pg8::StaticOrder, true, true>(lds, g, S, E); }
    GRID_SYNC();
    { ArgsP A = argsp(); unsigned char* ws = A->ws; pg8::Gemm g{(const bf16*)(ws + WS_ACT), (const bf16*)(ws + WS_WD2), MO, D, FF}; pg8::StaticOrder S; S.init(MO, D, GX, BX);
      EpiResid<0, 1, 0> E{nullptr, nullptr, nullptr, A->out, nullptr, nullptr, SSP(A, 3)};
      pg8::gemm_phase<EpiResid<0, 1, 0>, pg8::StaticOrder, true, true>(lds, g, S, E); }
    GRID_SYNC();
    {
        const int tid = TIDL; ArgsP A = argsp(); float* X = A->out; const float* SS3 = SSP(A, 3);
        const int gw = BX * NWAVES + WAVE, NGW = GX * NWAVES; const f32x4* gf = (const f32x4*)A->in[I_NF] + LANE;
        for (int m = gw; m < MO; m += NGW) { const float rs = rstd_from_ss(SS3, m); f32x4* x4 = (f32x4*)(X + (size_t)m * D) + LANE;
#pragma unroll
            for (int j = 0; j < 4; ++j) { f32x4 v = x4[64 * j]; const f32x4 gg = gf[64 * j]; x4[64 * j] = v * rs * gg; } }
    }
}

extern "C" void kernel_launch(void* const* d_in, const int* in_sizes, int n_in, void* d_out, int out_size, void* d_ws, size_t ws_size, hipStream_t stream) {
    static int grid = 0;
    if (grid == 0) {
        if (n_in != 23 || ws_size < WS_END || out_size != 34930688) { fprintf(stderr, "kernel_launch: unexpected problem shape (n_in %d, out %d, ws %zu)\n", n_in, out_size, ws_size); grid = -1; return; }
        int dev = 0, cus = 0, per_cu = 0;
        hipGetDevice(&dev); hipDeviceGetAttribute(&cus, hipDeviceAttributeMultiprocessorCount, dev);
        hipFuncSetAttribute((const void*)mega_fwd, hipFuncAttributeMaxDynamicSharedMemorySize, LDS_BYTES);
        hipOccupancyMaxActiveBlocksPerMultiprocessor(&per_cu, (const void*)mega_fwd, NTHREADS, LDS_BYTES);
        if (per_cu < 1) { fprintf(stderr, "kernel_launch: occupancy query returned %d\n", per_cu); per_cu = 1; }
        (void)hipGetLastError();
        grid = cus * per_cu;
    }
    if (grid < 0) return;
    Args a{};
    for (int i = 0; i < 23; ++i) a.in[i] = (const float*)d_in[i];
    a.out = (float*)d_out; a.ws = (unsigned char*)d_ws;
    void* args[] = {&a};
    hipError_t e = hipLaunchCooperativeKernel((const void*)mega_fwd, dim3(grid), dim3(NTHREADS), args, LDS_BYTES, stream);
    if (e != hipSuccess) fprintf(stderr, "cooperative launch failed: %s (grid %d)\n", hipGetErrorString(e), grid);
}
```

```cpp
#include <hip/hip_runtime.h>
#include <hip/hip_cooperative_groups.h>
#include <cstdio>
#include <cstdint>
namespace cg = cooperative_groups;
namespace pg8 {
#define PG8_LAS __attribute__((address_space(3)))
typedef unsigned short bf16_t;
typedef short bf16x8 __attribute__((ext_vector_type(8)));
typedef float f32x4 __attribute__((ext_vector_type(4)));
typedef unsigned u32x4 __attribute__((ext_vector_type(4)));
constexpr int BM = 256, BK = 64, HALF = 128, HTB = HALF * BK * 2  , STAGE_BYTES = 8 * HTB, NXCD = 8, WGM = 8;

__host__ __device__ __forceinline__ int lds_byte(int r, int c) { const int st = (r >> 4) * 2 + (c >> 5), rr = r & 15, cc = c & 31, ob = rr * 64 + cc * 2; return st * 1024 + (ob ^ (((ob >> 9) & 1) << 5)); }
__host__ __device__ __forceinline__ void stage_rc(int b, int& R, int& C) { const int st = b / 1024, sb = b % 1024, swz = sb ^ (((sb >> 9) & 1) << 5); R = (st >> 1) * 16 + swz / 64; C = (st & 1) * 32 + (swz % 64) / 2; }
__host__ __device__ __forceinline__ int perm32(int rho) { const int n = rho >> 4, i = rho & 15; return 8 * (i >> 2) + 4 * n + (i & 3); }

struct Unit { int pm, pn; };
struct Gemm { const bf16_t* A; const bf16_t* Bt; int M, N, K; };

struct StaticOrder {
    int nM, nN, nwg, G, c;
    __host__ __device__ void init(int M, int N, int G_, int c_) { nM = M / BM; nN = N / BM; nwg = nM * nN; G = G_; c = c_; }
    __host__ __device__ bool next(int i, Unit& u) const {
        const long L = (long)i * G + c; if (L >= nwg) return false;
        int wgid = (int)L; { const int q = nwg / NXCD, r = nwg % NXCD, xcd = wgid % NXCD, off = wgid / NXCD; wgid = (xcd < r ? xcd * (q + 1) : r * (q + 1) + (xcd - r) * q) + off; }
        const int nig = WGM * nN, gid = wgid / nig, fm = gid * WGM, gsz = (nM - fm) < WGM ? (nM - fm) : WGM;
        u.pm = fm + ((wgid % nig) % gsz); u.pn = (wgid % nig) / gsz; return true;
    }
    __device__ __forceinline__ void a_ready(const Unit&) const {}
    __device__ __forceinline__ void done(const Unit&) const {}
};

__device__ __forceinline__ unsigned cvt_pk_bf16(float lo, float hi) { unsigned r; asm volatile("v_cvt_pk_bf16_f32 %0, %1, %2" : "=v"(r) : "v"(lo), "v"(hi)); return r; }
template <class Epi, class Sched, bool ALIGN_EPI = false, bool SP2 = false>
__device__ __forceinline__ void gemm_phase(PG8_LAS unsigned char* lds, const Gemm g, const Sched S, const Epi E) {
    int tid_l = threadIdx.x; asm volatile("" : "+v"(tid_l)); const int tid = tid_l, wid = __builtin_amdgcn_readfirstlane(tid >> 6), lane = tid & 63, wr = wid >> 2, wc = wid & 3, fr = lane & 15, fq = lane >> 4;
    const int K = g.K, nt = K / BK;
    unsigned voffA[2], voffB[2];
#pragma unroll
    for (int i = 0; i < 2; ++i) { int R, C; stage_rc(tid * 16 + i * 8192, R, C); const int Rb = Epi::PERM ? ((R & ~31) + perm32(R & 31)) : R;
        voffA[i] = (unsigned)(R * K + C) * 2u; voffB[i] = (unsigned)(Rb * K + C) * 2u; }
    const size_t kstep = (size_t)(BK * 2);
    const size_t hstep = (size_t)HALF * K * 2;
    const size_t tstep = 2 * hstep;
    const unsigned ldsw = (unsigned)wid * 1024u;
    const int aoff = lds_byte(wr * 64 + fr, fq * 8), boff = lds_byte(wc * 32 + fr, fq * 8);
#define PG8_SA(b, h) (((b) * 2 + (h)) * HTB)
#define PG8_SB(b, h) ((4 + (b) * 2 + (h)) * HTB)
#define PG8_STAGE(bufoff, gbase, voff) do { _Pragma("unroll") for (int _i = 0; _i < 2; ++_i) \
        __builtin_amdgcn_global_load_lds((const unsigned*)((const char*)(gbase) + (voff)[_i]), (PG8_LAS unsigned*)(lds + (bufoff) + ldsw + _i * 8192), 16, 0, 0); } while (0)
#define PG8_LDA(dst, b, h) do { _Pragma("unroll") for (int m = 0; m < 4; ++m) _Pragma("unroll") for (int k = 0; k < 2; ++k) dst[m][k] = *(const PG8_LAS bf16x8*)(lds + PG8_SA(b, h) + aoff + m * 2048 + k * 1024); } while (0)
#define PG8_LDB(dst, b, h) do { _Pragma("unroll") for (int n = 0; n < 2; ++n) _Pragma("unroll") for (int k = 0; k < 2; ++k) dst[n][k] = *(const PG8_LAS bf16x8*)(lds + PG8_SB(b, h) + boff + n * 2048 + k * 1024); } while (0)
#define PG8_MMA(ai, bj, At, Bt) do { __builtin_amdgcn_s_setprio(1); _Pragma("unroll") for (int m = 0; m < 4; ++m) _Pragma("unroll") for (int n = 0; n < 2; ++n) _Pragma("unroll") for (int k = 0; k < 2; ++k) \
        acc[ai][bj][m][n] = __builtin_amdgcn_mfma_f32_16x16x32_bf16(Bt[n][k], At[m][k], acc[ai][bj][m][n], 0, 0, 0); __builtin_amdgcn_s_setprio(0); } while (0)
#define PG8_WAIT_V(n) asm volatile("s_waitcnt vmcnt(" #n ")" ::: "memory")
#define PG8_WAIT_L(n) asm volatile("s_waitcnt lgkmcnt(" #n ")" ::: "memory")
#define PG8_BAR __builtin_amdgcn_s_barrier()
#define PG8_SCHED __builtin_amdgcn_sched_barrier(0)
    Unit cur, nxt; int ui = 0;
    if (!S.next(0, cur)) return;
    f32x4 acc[2][2][4][2];
#pragma unroll
    for (int a = 0; a < 2; ++a)
#pragma unroll
        for (int b = 0; b < 2; ++b)
#pragma unroll
            for (int m = 0; m < 4; ++m)
#pragma unroll
                for (int n = 0; n < 2; ++n) acc[a][b][m][n] = (f32x4){0.f, 0.f, 0.f, 0.f};
    bf16x8 At[4][2], B0[2][2], B1[2][2];
    const char* cA = (const char*)g.A + (size_t)cur.pm * tstep; const char* cB = (const char*)g.Bt + (size_t)cur.pn * tstep;
    S.a_ready(cur);
    if constexpr (SP2) {
        PG8_STAGE(PG8_SB(0, 0), cB, voffB); PG8_STAGE(PG8_SB(0, 1), cB + hstep, voffB); PG8_STAGE(PG8_SA(0, 0), cA, voffA); PG8_STAGE(PG8_SA(0, 1), cA + hstep, voffA);
        if (wr == 1) PG8_BAR;
        PG8_WAIT_V(2); PG8_BAR;
        PG8_STAGE(PG8_SB(1, 0), cB + kstep, voffB); PG8_STAGE(PG8_SA(1, 0), cA + kstep, voffA); PG8_STAGE(PG8_SB(1, 1), cB + hstep + kstep, voffB);
        PG8_WAIT_V(6); PG8_BAR;
    } else {
        PG8_STAGE(PG8_SB(0, 0), cB, voffB); PG8_STAGE(PG8_SA(0, 0), cA, voffA); PG8_STAGE(PG8_SB(0, 1), cB + hstep, voffB); PG8_STAGE(PG8_SA(0, 1), cA + hstep, voffA);
        if (wr == 1) PG8_BAR;
        PG8_WAIT_V(4); PG8_BAR;
        PG8_STAGE(PG8_SB(1, 0), cB + kstep, voffB); PG8_STAGE(PG8_SA(1, 0), cA + kstep, voffA); PG8_STAGE(PG8_SB(1, 1), cB + hstep + kstep, voffB);
        PG8_WAIT_V(6); PG8_BAR;
    }
    for (;;) {
        const bool has_next = S.next(ui + 1, nxt);
        const char* nA = has_next ? (const char*)g.A + (size_t)nxt.pm * tstep : cA; const char* nB = has_next ? (const char*)g.Bt + (size_t)nxt.pn * tstep : cB;
        for (int t = 0; t < nt; t += 2) {
            const bool last = (t == nt - 2);
            const char* a1 = cA + (size_t)(t + 1) * kstep;
            const char* a2 = last ? nA : cA + (size_t)(t + 2) * kstep; const char* b2 = last ? nB : cB + (size_t)(t + 2) * kstep;
            const char* a3 = a2 + kstep; const char* b3 = b2 + kstep;
            if (last && has_next) S.a_ready(nxt);
            if constexpr (SP2) {
            PG8_LDB(B0, 0, 0); PG8_LDB(B1, 0, 1); PG8_SCHED; PG8_LDA(At, 0, 0); PG8_STAGE(PG8_SA(1, 1), a1 + hstep, voffA);
            PG8_WAIT_V(8); PG8_WAIT_L(0); PG8_BAR; PG8_MMA(0, 0, At, B0); PG8_MMA(0, 1, At, B1); PG8_BAR; PG8_SCHED;
            PG8_LDA(At, 0, 1); PG8_STAGE(PG8_SB(0, 0), b2, voffB); PG8_STAGE(PG8_SB(0, 1), b2 + hstep, voffB); PG8_STAGE(PG8_SA(0, 0), a2, voffA);
            PG8_WAIT_V(8); PG8_WAIT_L(0); PG8_BAR; PG8_MMA(1, 0, At, B0); PG8_MMA(1, 1, At, B1); PG8_BAR; PG8_SCHED;
            PG8_LDB(B0, 1, 0); PG8_LDB(B1, 1, 1); PG8_SCHED; PG8_LDA(At, 1, 0); PG8_STAGE(PG8_SA(0, 1), a2 + hstep, voffA);
            PG8_WAIT_V(8); PG8_WAIT_L(0); PG8_BAR; PG8_MMA(0, 0, At, B0); PG8_MMA(0, 1, At, B1); PG8_BAR; PG8_SCHED;
            PG8_LDA(At, 1, 1); PG8_STAGE(PG8_SB(1, 0), b3, voffB); PG8_STAGE(PG8_SB(1, 1), b3 + hstep, voffB); PG8_STAGE(PG8_SA(1, 0), a3, voffA);
            PG8_WAIT_V(8); PG8_WAIT_L(0); PG8_BAR; PG8_MMA(1, 0, At, B0); PG8_MMA(1, 1, At, B1); PG8_BAR; PG8_SCHED;
            } else {
            PG8_LDB(B0, 0, 0); PG8_SCHED; PG8_LDA(At, 0, 0); PG8_STAGE(PG8_SA(1, 1), a1 + hstep, voffA);
            PG8_WAIT_L(8); PG8_BAR; PG8_WAIT_L(0); PG8_MMA(0, 0, At, B0); PG8_BAR; PG8_SCHED;
            PG8_LDB(B1, 0, 1); PG8_STAGE(PG8_SB(0, 0), b2, voffB);
            PG8_BAR; PG8_WAIT_L(0); PG8_MMA(0, 1, At, B1); PG8_BAR;
            PG8_LDA(At, 0, 1); PG8_STAGE(PG8_SA(0, 0), a2, voffA);
            PG8_BAR; PG8_WAIT_L(0); PG8_MMA(1, 0, At, B0); PG8_BAR; PG8_SCHED;
            PG8_STAGE(PG8_SB(0, 1), b2 + hstep, voffB);
            PG8_WAIT_V(6); PG8_BAR; PG8_MMA(1, 1, At, B1); PG8_BAR;
            PG8_LDB(B0, 1, 0); PG8_SCHED; PG8_LDA(At, 1, 0); PG8_STAGE(PG8_SA(0, 1), a2 + hstep, voffA);
            PG8_WAIT_L(8); PG8_BAR; PG8_WAIT_L(0); PG8_MMA(0, 0, At, B0); PG8_BAR; PG8_SCHED;
            PG8_LDB(B1, 1, 1); PG8_STAGE(PG8_SB(1, 0), b3, voffB);
            PG8_BAR; PG8_WAIT_L(0); PG8_MMA(0, 1, At, B1); PG8_BAR;
            PG8_LDA(At, 1, 1); PG8_STAGE(PG8_SA(1, 0), a3, voffA);
            PG8_BAR; PG8_WAIT_L(0); PG8_MMA(1, 0, At, B0); PG8_BAR; PG8_SCHED;
            PG8_STAGE(PG8_SB(1, 1), b3 + hstep, voffB);
            PG8_WAIT_V(6); PG8_BAR; PG8_MMA(1, 1, At, B1); PG8_BAR;
            }
        }
        if constexpr (ALIGN_EPI) { if (wr == 0) PG8_BAR; }
        if constexpr (!Epi::AFTER_DRAIN) { E(acc, cur, wr, wc, fr, fq); S.done(cur); }
        if (!has_next) break;
#pragma unroll
        for (int a = 0; a < 2; ++a)
#pragma unroll
            for (int b = 0; b < 2; ++b)
#pragma unroll
                for (int m = 0; m < 4; ++m)
#pragma unroll
                    for (int n = 0; n < 2; ++n) acc[a][b][m][n] = (f32x4){0.f, 0.f, 0.f, 0.f};
        cur = nxt; cA = nA; cB = nB; ++ui;
        if constexpr (ALIGN_EPI) { if (wr == 1) PG8_BAR; }
    }
    PG8_WAIT_V(0);
    if constexpr (!ALIGN_EPI) { if (wr == 0) PG8_BAR; }
    PG8_BAR;
    if constexpr (Epi::AFTER_DRAIN) { E.fused(acc, cur, wr, wc, fr, fq, lds, wid, lane); S.done(cur); }
#undef PG8_SA
#undef PG8_SB
#undef PG8_STAGE
#undef PG8_LDA
#undef PG8_LDB
#undef PG8_MMA
#undef PG8_WAIT_V
#undef PG8_WAIT_L
#undef PG8_BAR
#undef PG8_SCHED
}
}

#define LAS __attribute__((address_space(3)))
typedef unsigned short bf16;
typedef float f32x4 __attribute__((ext_vector_type(4)));
typedef float f32x16 __attribute__((ext_vector_type(16)));
typedef short bf16x8 __attribute__((ext_vector_type(8)));
typedef unsigned u32x4 __attribute__((ext_vector_type(4)));
typedef unsigned u32x2 __attribute__((ext_vector_type(2)));
typedef float f32x2 __attribute__((ext_vector_type(2)));
using pg8::cvt_pk_bf16;

constexpr int NWAVES = 8, NTHREADS = 512;
constexpr int D = 1024, FF = 2816, NIN = 5632;
constexpr int MP = 16384;
constexpr int MS = 256;
constexpr int MO = MP + MS;
constexpr int MX = MO + 16;
constexpr int MPAD = 16896;
constexpr int LP = 4112;
constexpr int LC = 2064;
constexpr float EPS = 1e-6f;
constexpr float LOG2E = 1.4426950408889634f;
constexpr float QSCALE = 0.125f * LOG2E;
constexpr float SB_EXIT = 152.0f;

constexpr size_t O_YP = 0, O_YS = 16777216, O_PK = 17039360, O_PV = 25460736, O_PH = 33882112, O_SK = 34144256, O_SV = 34275328, O_SH = 34406400;
constexpr size_t WS_WGU1 = 0, WS_WD1 = 11534336, WS_WIN = 17301504, WS_WA = 28835840, WS_WB = 29884416, WS_WOUT = 30932992, WS_WGU2 = 33030144, WS_WD2 = 44564480;
constexpr size_t WS_SS = 50331648, SS_BYTES = (size_t)MPAD * 16 * 4;
constexpr size_t WS_XN = 54657024, WS_ACT = 89260032;
constexpr size_t WS_KKH = 184418304, WS_QB = 201719808, WS_QH = 219021312, WS_IVTP = 236322816, WS_IVTS = 253165568, WS_END = 253689856;
constexpr size_t WS_GA = WS_ACT, WS_GB = WS_ACT + 34603008, WS_SG = WS_ACT + 69206016;
constexpr int LDS_BYTES = 147456;
constexpr size_t WS_CTL = 253689856, CTL_BYTES = 16384;
constexpr int LDS_BARST = 131072 + 64;

struct Args { const float* in[23]; float* out; unsigned char* ws; };
typedef const Args __attribute__((address_space(4)))* ArgsP;
__device__ __forceinline__ ArgsP argsp() { ArgsP p = (ArgsP)__builtin_amdgcn_kernarg_segment_ptr(); asm volatile("" : "+s"(p)); return p; }
enum { I_XP = 0, I_XS, I_CK, I_CV, I_ST, I_META, I_N1, I_WG1, I_WU1, I_WD1, I_NMIX, I_WIN, I_BG, I_LB, I_HGN, I_WA, I_WB, I_WOUT, I_N2, I_WG2, I_WU2, I_WD2, I_NF };

__device__ __forceinline__ float wave_sum(float v) {
#pragma unroll
    for (int o = 1; o < 64; o <<= 1) v += __shfl_xor(v, o);
    return v;
}
__device__ __forceinline__ float ex2(float x) { return __builtin_amdgcn_exp2f(x); }
__device__ __forceinline__ float lg2(float x) { return __builtin_amdgcn_logf(x); }
__device__ __forceinline__ float sigmoidf_(float x) { return 1.0f / (1.0f + ex2(-x * LOG2E)); }
__device__ __forceinline__ float rstd_from_ss(const float* ss, int r) {
    const f32x4* p = (const f32x4*)(ss + (size_t)r * 16);
    f32x4 a = p[0], b = p[1], c = p[2], d = p[3];
    float s = ((a.x + a.y) + (a.z + a.w)) + ((b.x + b.y) + (b.z + b.w)) + ((c.x + c.y) + (c.z + c.w)) + ((d.x + d.y) + (d.z + d.w));
    return rsqrtf(s * (1.0f / 1024.0f) + EPS);
}
__device__ __forceinline__ const float* xin_row(ArgsP A, int r) {
    if (r < MP) return A->in[I_XP] + (size_t)r * D;
    if (r < MO) return A->in[I_XS] + (size_t)(r - MP) * D;
    if (r < MX) return A->in[I_META] + (size_t)(r - MO) * D;
    return nullptr;
}

__device__ __forceinline__ void p0_transpose_item(const float* W, int K, int N, bf16* WT, int il, LAS float* scr, int item, int lane) {
    const int nblk = N / 32, kb = item / nblk, nb = item % nblk, k0 = 64 * kb, n0 = 32 * nb;
#pragma unroll 8
    for (int i = 0; i < 32; ++i) { const int kk = 2 * i + (lane >> 5); scr[kk * 33 + (lane & 31)] = W[(size_t)(k0 + kk) * N + n0 + (lane & 31)]; }
    asm volatile("s_waitcnt lgkmcnt(0)" ::: "memory");
    const int rbase = il == 0 ? n0 : ((n0 >> 7) * 256 + (n0 & 127) + (il == 2 ? 128 : 0));
    const int c = lane & 7;
#pragma unroll
    for (int j = 0; j < 4; ++j) { const int n = (lane >> 3) + 8 * j; const LAS float* s = scr + (8 * c) * 33 + n;
        u32x4 o; o.x = cvt_pk_bf16(s[0 * 33], s[1 * 33]); o.y = cvt_pk_bf16(s[2 * 33], s[3 * 33]); o.z = cvt_pk_bf16(s[4 * 33], s[5 * 33]); o.w = cvt_pk_bf16(s[6 * 33], s[7 * 33]);
        *(u32x4*)(WT + (size_t)(rbase + n) * K + k0 + 8 * c) = o; }
    asm volatile("s_waitcnt lgkmcnt(0)" ::: "memory");
}
__device__ __forceinline__ void p0_phase(ArgsP A, LAS unsigned char* lds, int wave, int lane) {
    LAS float* scr = (LAS float*)(lds + wave * 16384);
    const int G = gridDim.x, gw = blockIdx.x * NWAVES + wave, NGW = G * NWAVES;
    unsigned char* ws = A->ws;
    constexpr int I_GU = (D / 64) * (FF / 32), I_DN = (FF / 64) * (D / 32), I_IN = (D / 64) * (NIN / 32), I_BR = (512 / 64) * (D / 32), I_OU = (D / 64) * (D / 32);
    constexpr int NITEMS = 4 * I_GU + 2 * I_DN + I_IN + 2 * I_BR + I_OU;
    for (int it = gw; it < NITEMS; it += NGW) {
        int r = it;
        if (r < I_GU) { p0_transpose_item(A->in[I_WG1], D, FF, (bf16*)(ws + WS_WGU1), 1, scr, r, lane); continue; } r -= I_GU;
        if (r < I_GU) { p0_transpose_item(A->in[I_WU1], D, FF, (bf16*)(ws + WS_WGU1), 2, scr, r, lane); continue; } r -= I_GU;
        if (r < I_DN) { p0_transpose_item(A->in[I_WD1], FF, D, (bf16*)(ws + WS_WD1), 0, scr, r, lane); continue; } r -= I_DN;
        if (r < I_IN) { p0_transpose_item(A->in[I_WIN], D, NIN, (bf16*)(ws + WS_WIN), 0, scr, r, lane); continue; } r -= I_IN;
        if (r < I_BR) { p0_transpose_item(A->in[I_WA], 512, D, (bf16*)(ws + WS_WA), 0, scr, r, lane); continue; } r -= I_BR;
        if (r < I_BR) { p0_transpose_item(A->in[I_WB], 512, D, (bf16*)(ws + WS_WB), 0, scr, r, lane); continue; } r -= I_BR;
        if (r < I_OU) { p0_transpose_item(A->in[I_WOUT], D, D, (bf16*)(ws + WS_WOUT), 0, scr, r, lane); continue; } r -= I_OU;
        if (r < I_GU) { p0_transpose_item(A->in[I_WG2], D, FF, (bf16*)(ws + WS_WGU2), 1, scr, r, lane); continue; } r -= I_GU;
        if (r < I_GU) { p0_transpose_item(A->in[I_WU2], D, FF, (bf16*)(ws + WS_WGU2), 2, scr, r, lane); continue; } r -= I_GU;
        p0_transpose_item(A->in[I_WD2], FF, D, (bf16*)(ws + WS_WD2), 0, scr, r, lane);
    }
    bf16* XN = (bf16*)(ws + WS_XN); float* SS0 = (float*)(ws + WS_SS);
    const f32x4* g1 = (const f32x4*)A->in[I_N1] + lane;
    for (int m = gw; m < MPAD; m += NGW) {
        const float* xr = xin_row(A, m);
        unsigned long long* o8 = (unsigned long long*)(XN + (size_t)m * D) + lane;
        float s = 0.f;
        if (xr) {
            const f32x4* x4 = (const f32x4*)xr + lane;
#pragma unroll
            for (int j = 0; j < 4; ++j) { f32x4 v = x4[64 * j]; const f32x4 g = g1[64 * j]; s += (v.x * v.x + v.y * v.y) + (v.z * v.z + v.w * v.w);
                o8[64 * j] = (unsigned long long)cvt_pk_bf16(v.x * g.x, v.y * g.y) | ((unsigned long long)cvt_pk_bf16(v.z * g.z, v.w * g.w) << 32); }
        } else {
#pragma unroll
            for (int j = 0; j < 4; ++j) o8[64 * j] = 0ull;
        }
        s = wave_sum(s);
        if (lane < 16) SS0[(size_t)m * 16 + lane] = lane == 0 ? s : 0.f;
    }
}

struct EpiSwiGLU {
    static constexpr bool PERM = true, AFTER_DRAIN = false;
    bf16* act; const float* ss;
    __device__ __forceinline__ void operator()(const f32x4 (&acc)[2][2][4][2], const pg8::Unit& u, int wr, int wc, int fr, int fq) const {
        const int col0 = u.pn * 128 + wc * 32 + 8 * fq;
#pragma unroll
        for (int ai = 0; ai < 2; ++ai)
#pragma unroll
            for (int m = 0; m < 4; ++m) {
                const int r = u.pm * 256 + ai * 128 + wr * 64 + m * 16 + fr;
                const float rs = rstd_from_ss(ss, r);
                float o[8];
#pragma unroll
                for (int n = 0; n < 2; ++n)
#pragma unroll
                    for (int e = 0; e < 4; ++e) { const float g = acc[ai][0][m][n][e] * rs, up = acc[ai][1][m][n][e] * rs; o[4 * n + e] = g * up / (1.0f + ex2(-g * LOG2E)); }
                u32x4 w; w.x = cvt_pk_bf16(o[0], o[1]); w.y = cvt_pk_bf16(o[2], o[3]); w.z = cvt_pk_bf16(o[4], o[5]); w.w = cvt_pk_bf16(o[6], o[7]);
                *(u32x4*)(act + (size_t)r * FF + col0) = w;
            }
    }
};
template <int SRC_INPUTS, int HALF_SCALE, int HAS_XN> struct EpiResid {
    static constexpr bool PERM = false, AFTER_DRAIN = false;
    const float* xp; const float* xs; const float* xm; float* X; bf16* XN; const float* gnext; float* ss;
    __device__ __forceinline__ void operator()(const f32x4 (&acc)[2][2][4][2], const pg8::Unit& u, int wr, int wc, int fr, int fq) const {
        const int col0 = u.pn * 256 + wc * 32 + 4 * fq;
#pragma unroll
        for (int ai = 0; ai < 2; ++ai)
#pragma unroll
            for (int m = 0; m < 4; ++m) {
                const int r = u.pm * 256 + ai * 128 + wr * 64 + m * 16 + fr;
                const float* srow = SRC_INPUTS ? (r < MP ? xp + (size_t)r * D : (r < MO ? xs + (size_t)(r - MP) * D : (r < MX ? xm + (size_t)(r - MO) * D : nullptr))) : (X + (size_t)r * D);
                float s = 0.f;
#pragma unroll
                for (int bj = 0; bj < 2; ++bj)
#pragma unroll
                    for (int n = 0; n < 2; ++n) {
                        const int c = col0 + bj * 128 + n * 16;
                        f32x4 v = acc[ai][bj][m][n] * (HALF_SCALE ? 0.5f : 1.0f);
                        if (srow) v += *(const f32x4*)(srow + c);
                        s += (v.x * v.x + v.y * v.y) + (v.z * v.z + v.w * v.w);
                        if (r < MO) *(f32x4*)(X + (size_t)r * D + c) = v;
                        if (HAS_XN) { const f32x4 g = *(const f32x4*)(gnext + c); u32x2 w; w.x = cvt_pk_bf16(v.x * g.x, v.y * g.y); w.y = cvt_pk_bf16(v.z * g.z, v.w * g.w); *(u32x2*)(XN + (size_t)r * D + c) = w; }
                    }
                s += __shfl_xor(s, 16); s += __shfl_xor(s, 32);
                if (fq == 0) ss[(size_t)r * 16 + u.pn * 4 + wc] = s;
            }
    }
};
struct EpiWin {
    static constexpr bool PERM = false, AFTER_DRAIN = false;
    unsigned char* ws; float* out; const float* lbp; const float* bgp; const float* ss;
    template <int TYPE> __device__ __forceinline__ void run(const f32x4 (&acc)[2][2][4][2], const pg8::Unit& u, int wr, int wc, int fr, int fq, int cbase) const {
        const int col0 = u.pn * 256 + wc * 32 + 4 * fq - cbase;
#pragma unroll
        for (int ai = 0; ai < 2; ++ai)
#pragma unroll
            for (int m = 0; m < 4; ++m) {
                const int r = u.pm * 256 + ai * 128 + wr * 64 + m * 16 + fr;
                const int rlim = (TYPE == 0 || TYPE >= 6) ? MO : MX;
                if (r < rlim) {
                const float rs = rstd_from_ss(ss, r);
#pragma unroll
                for (int bj = 0; bj < 2; ++bj)
#pragma unroll
                    for (int n = 0; n < 2; ++n) {
                        const int cc = col0 + bj * 128 + n * 16;
                        const f32x4 v = acc[ai][bj][m][n] * rs;
                        if (TYPE == 0) {
                            u32x2 w; w.x = cvt_pk_bf16(v.x * QSCALE, v.y * QSCALE); w.y = cvt_pk_bf16(v.z * QSCALE, v.w * QSCALE); *(u32x2*)((bf16*)(ws + WS_QB) + (size_t)r * 512 + cc) = w;
                        } else if (TYPE == 1 || TYPE == 2) {
                            const size_t ob = TYPE == 2 ? O_PV : O_PK, os = TYPE == 2 ? O_SV : O_SK;
                            if (r < MP) { const int b = r >> 12, t = r & 4095; *(f32x4*)(out + ob + ((size_t)(b * LP + 16 + t)) * 512 + cc) = v; }
                            else if (r < MO) { *(f32x4*)(out + os + (size_t)(r - MP) * 512 + cc) = v; }
                            else { const int mm = r - MO;
#pragma unroll
                                for (int b = 0; b < 4; ++b) *(f32x4*)(out + ob + ((size_t)(b * LP + mm)) * 512 + cc) = v; }
                        } else if (TYPE == 3) {
                            const f32x4 l0 = *(const f32x4*)(lbp + cc), l1 = *(const f32x4*)(lbp + 512 + cc);
                            _Float16 h[4];
#pragma unroll
                            for (int e = 0; e < 4; ++e) { const float oml = 1.0f / (1.0f + ex2((l1[e] - l0[e]) * LOG2E));
                                h[e] = (_Float16)(oml / (1.0f + ex2(v[e] * LOG2E))); }
                            u32x2 w; w.x = (unsigned)__builtin_bit_cast(unsigned short, h[0]) | ((unsigned)__builtin_bit_cast(unsigned short, h[1]) << 16);
                            w.y = (unsigned)__builtin_bit_cast(unsigned short, h[2]) | ((unsigned)__builtin_bit_cast(unsigned short, h[3]) << 16);
                            *(u32x2*)((unsigned short*)(ws + WS_KKH) + (size_t)r * 512 + cc) = w;
                        } else if (TYPE == 4) {
                            const int h = cc >> 7, vv = cc & 127;
                            const unsigned w01 = cvt_pk_bf16(v.x, v.y), w23 = cvt_pk_bf16(v.z, v.w);
                            const bf16 e0 = (bf16)(w01 & 0xffffu), e1 = (bf16)(w01 >> 16), e2 = (bf16)(w23 & 0xffffu), e3 = (bf16)(w23 >> 16);
                            if (r < MP) { const int b = r >> 12, t = r & 4095; bf16* p = (bf16*)(ws + WS_IVTP) + ((size_t)((b * 4 + h) * 128 + vv)) * LP + 16 + t; p[0] = e0; p[LP] = e1; p[2 * LP] = e2; p[3 * LP] = e3; }
                            else if (r < MO) { const int s = (r - MP) >> 5, t = (r - MP) & 31; bf16* p = (bf16*)(ws + WS_IVTS) + ((size_t)((s * 4 + h) * 128 + vv)) * 64 + t; p[0] = e0; p[64] = e1; p[128] = e2; p[192] = e3; }
                            else { const int mm = r - MO;
#pragma unroll
                                for (int b = 0; b < 4; ++b) { bf16* p = (bf16*)(ws + WS_IVTP) + ((size_t)((b * 4 + h) * 128 + vv)) * LP + mm; p[0] = e0; p[LP] = e1; p[2 * LP] = e2; p[3 * LP] = e3; } }
                        } else if (TYPE == 5) {
                            u32x2 w; w.x = cvt_pk_bf16(v.x, v.y); w.y = cvt_pk_bf16(v.z, v.w); *(u32x2*)((bf16*)(ws + WS_QH) + (size_t)r * 512 + cc) = w;
                        } else if (TYPE == 6) {
                            float o[4];
#pragma unroll
                            for (int e = 0; e < 4; ++e) o[e] = v[e] / (1.0f + ex2(-v[e] * LOG2E));
                            u32x2 w; w.x = cvt_pk_bf16(o[0], o[1]); w.y = cvt_pk_bf16(o[2], o[3]); *(u32x2*)((bf16*)(ws + WS_SG) + (size_t)r * 512 + cc) = w;
                        } else {
                            const f32x4 bg = *(const f32x4*)(bgp + (TYPE == 8 ? 1024 : 0) + cc); float o[4];
#pragma unroll
                            for (int e = 0; e < 4; ++e) o[e] = 1.0f / (1.0f + ex2(-(v[e] + bg[e]) * LOG2E));
                            u32x2 w; w.x = cvt_pk_bf16(o[0], o[1]); w.y = cvt_pk_bf16(o[2], o[3]); *(u32x2*)((bf16*)(ws + (TYPE == 8 ? WS_GB : WS_GA)) + (size_t)r * D + cc) = w;
                        }
                    }
                }
            }
    }
    __device__ __forceinline__ void operator()(const f32x4 (&acc)[2][2][4][2], const pg8::Unit& u, int wr, int wc, int fr, int fq) const {
        const int pn = u.pn;
        if (pn < 2) run<0>(acc, u, wr, wc, fr, fq, 0);
        else if (pn < 4) run<1>(acc, u, wr, wc, fr, fq, 512);
        else if (pn < 6) run<2>(acc, u, wr, wc, fr, fq, 1024);
        else if (pn < 8) run<3>(acc, u, wr, wc, fr, fq, 1536);
        else if (pn < 10) run<4>(acc, u, wr, wc, fr, fq, 2048);
        else if (pn < 12) run<5>(acc, u, wr, wc, fr, fq, 2560);
        else if (pn < 14) run<6>(acc, u, wr, wc, fr, fq, 3072);
        else if (pn < 18) run<7>(acc, u, wr, wc, fr, fq, 3584);
        else run<8>(acc, u, wr, wc, fr, fq, 4608);
    }
};
__device__ __forceinline__ float bf2f(unsigned short h) { return __builtin_bit_cast(float, (unsigned)h << 16); }
template <int PASS> struct EpiMerge {
    static constexpr bool PERM = false, AFTER_DRAIN = false;
    bf16* ga; const bf16* gb;
    __device__ __forceinline__ void operator()(const f32x4 (&acc)[2][2][4][2], const pg8::Unit& u, int wr, int wc, int fr, int fq) const {
        const int col0 = u.pn * 256 + wc * 32 + 4 * fq;
#pragma unroll
        for (int ai = 0; ai < 2; ++ai)
#pragma unroll
            for (int m = 0; m < 4; ++m) {
                const int r = u.pm * 256 + ai * 128 + wr * 64 + m * 16 + fr;
#pragma unroll
                for (int bj = 0; bj < 2; ++bj)
#pragma unroll
                    for (int n = 0; n < 2; ++n) {
                        const int c = col0 + bj * 128 + n * 16;
                        const f32x4 v = acc[ai][bj][m][n];
                        u32x2* pa = (u32x2*)(ga + (size_t)r * D + c);
                        const u32x2 wa = *pa;
                        const float a0 = bf2f(wa.x & 0xffffu), a1 = bf2f(wa.x >> 16), a2 = bf2f(wa.y & 0xffffu), a3 = bf2f(wa.y >> 16);
                        float o0, o1, o2, o3;
                        if (PASS == 0) { o0 = a0 * v.x; o1 = a1 * v.y; o2 = a2 * v.z; o3 = a3 * v.w; }
                        else { const u32x2 wb = *(const u32x2*)(gb + (size_t)r * D + c);
                            o0 = a0 + bf2f(wb.x & 0xffffu) * v.x; o1 = a1 + bf2f(wb.x >> 16) * v.y; o2 = a2 + bf2f(wb.y & 0xffffu) * v.z; o3 = a3 + bf2f(wb.y >> 16) * v.w; }
                        u32x2 w; w.x = cvt_pk_bf16(o0, o1); w.y = cvt_pk_bf16(o2, o3); *pa = w;
                    }
            }
    }
};

__device__ __forceinline__ bf16x8 pack8(const float* f) { u32x4 w; w.x = cvt_pk_bf16(f[0], f[1]); w.y = cvt_pk_bf16(f[2], f[3]); w.z = cvt_pk_bf16(f[4], f[5]); w.w = cvt_pk_bf16(f[6], f[7]); return __builtin_bit_cast(bf16x8, w); }
template <bool WRITE> __device__ __forceinline__ void attn_item(ArgsP A, int item, int lane) {
    const float* kdiag; const float* vdiag; const float* klow; const float* vlow; int qrow0, posq0, nblk, h;
    if (item < 4096) { const int b = item >> 10; h = (item >> 7) & 7; const int qt = item & 127;
        qrow0 = b * 4096 + 32 * qt; posq0 = 16 + 32 * qt; nblk = qt + 2;
        klow = A->out + O_PK + (size_t)b * LP * 512 + h * 64; vlow = A->out + O_PV + (size_t)b * LP * 512 + h * 64;
        kdiag = klow + (size_t)posq0 * 512; vdiag = vlow + (size_t)posq0 * 512;
    } else { const int id = item - 4096, s = id >> 3; h = id & 7;
        qrow0 = MP + 32 * s; posq0 = LC; nblk = 66;
        klow = A->in[I_CK] + (size_t)s * LC * 512 + h * 64; vlow = A->in[I_CV] + (size_t)s * LC * 512 + h * 64;
        kdiag = A->out + O_SK + (size_t)s * 32 * 512 + h * 64; vdiag = A->out + O_SV + (size_t)s * 32 * 512 + h * 64;
    }
    bf16* qo = (bf16*)(A->ws + WS_QB) + (size_t)qrow0 * 512 + h * 64;
    const int ql = lane & 31, hi = lane >> 5;
    bf16x8 qf[4];
#pragma unroll
    for (int s = 0; s < 4; ++s) qf[s] = *(const bf16x8*)(qo + (size_t)ql * 512 + 16 * s + 8 * hi);
    const int rA = (ql & 3) + 4 * (ql >> 3), hA = (ql >> 2) & 1, kappaA = 8 * hA + rA + (rA >= 8 ? 8 : 0);
    f32x16 o0, o1;
#pragma unroll
    for (int r = 0; r < 16; ++r) { o0[r] = 0.f; o1[r] = 0.f; }
    float R = 0.f;
    for (int j = 0; j < nblk; ++j) {
        const int pos0 = posq0 - 32 * j;
        const float* kb = j == 0 ? kdiag : klow; const float* vb = j == 0 ? vdiag : vlow;
        const int rb = j == 0 ? 0 : pos0;
        int rowA = rb + kappaA; rowA = rowA < 0 ? 0 : rowA;
        const float* kp = kb + (size_t)rowA * 512 + 8 * hi;
        f32x16 sacc;
#pragma unroll
        for (int r = 0; r < 16; ++r) sacc[r] = 0.f;
        f32x4 kv[8];
#pragma unroll
        for (int s = 0; s < 4; ++s) { kv[2 * s] = *(const f32x4*)(kp + 16 * s); kv[2 * s + 1] = *(const f32x4*)(kp + 16 * s + 4); }
        float vv[2][2][8];
#pragma unroll
        for (int st = 0; st < 2; ++st)
#pragma unroll
            for (int i = 0; i < 8; ++i) { int row = rb + 16 * st + 8 * hi + i; row = row < 0 ? 0 : row; const float* vp = vb + (size_t)row * 512 + ql; vv[st][0][i] = vp[0]; vv[st][1][i] = vp[32]; }
#pragma unroll
        for (int s = 0; s < 4; ++s) { float kk[8] = {kv[2 * s].x, kv[2 * s].y, kv[2 * s].z, kv[2 * s].w, kv[2 * s + 1].x, kv[2 * s + 1].y, kv[2 * s + 1].z, kv[2 * s + 1].w};
            sacc = __builtin_amdgcn_mfma_f32_32x32x16_bf16(pack8(kk), qf[s], sacc, 0, 0, 0); }
        float sp[16];
#pragma unroll
        for (int r = 0; r < 16; ++r) { const int kappa = 8 * hi + r + (r >= 8 ? 8 : 0);
            const bool valid = (pos0 + kappa >= 0) && (j > 0 || kappa < ql);
            const float z = sacc[r];
            const float s_ = fmaxf(z, 0.f) + lg2(1.0f + ex2(-fabsf(z)));
            sp[r] = valid ? s_ : 0.f; sacc[r] = valid ? z : -1e30f; }
        float glo = 0.f, ghi = 0.f;
#pragma unroll
        for (int r = 0; r < 8; ++r) { glo += sp[r]; ghi += sp[8 + r]; }
        const float pglo = __shfl_xor(glo, 32), pghi = __shfl_xor(ghi, 32);
        const float base_hi = R + (hi == 0 ? pghi : 0.f);
        const float base_lo = R + ghi + pghi + (hi == 0 ? pglo : 0.f);
        float pa[16];
        { float c = base_hi;
#pragma unroll
          for (int r = 15; r >= 8; --r) { c += sp[r]; pa[r] = ex2(sacc[r] - c); }
          c = base_lo;
#pragma unroll
          for (int r = 7; r >= 0; --r) { c += sp[r]; pa[r] = ex2(sacc[r] - c); } }
        R += (glo + ghi) + (pglo + pghi);
        const bf16x8 p0 = pack8(pa), p1 = pack8(pa + 8);
        o0 = __builtin_amdgcn_mfma_f32_32x32x16_bf16(pack8(vv[0][0]), p0, o0, 0, 0, 0);
        o1 = __builtin_amdgcn_mfma_f32_32x32x16_bf16(pack8(vv[0][1]), p0, o1, 0, 0, 0);
        o0 = __builtin_amdgcn_mfma_f32_32x32x16_bf16(pack8(vv[1][0]), p1, o0, 0, 0, 0);
        o1 = __builtin_amdgcn_mfma_f32_32x32x16_bf16(pack8(vv[1][1]), p1, o1, 0, 0, 0);
        if (__all(R > SB_EXIT)) break;
    }
    if (!WRITE) { if (o0[0] + o1[5] != 12345.678f) return; }
#pragma unroll
    for (int g = 0; g < 4; ++g) {
        u32x2 w; w.x = cvt_pk_bf16(o0[4 * g], o0[4 * g + 1]); w.y = cvt_pk_bf16(o0[4 * g + 2], o0[4 * g + 3]);
        *(u32x2*)(qo + (size_t)ql * 512 + 8 * g + 4 * hi) = w;
        u32x2 w1; w1.x = cvt_pk_bf16(o1[4 * g], o1[4 * g + 1]); w1.y = cvt_pk_bf16(o1[4 * g + 2], o1[4 * g + 3]);
        *(u32x2*)(qo + (size_t)ql * 512 + 32 + 8 * g + 4 * hi) = w1;
    }
}

constexpr int HQ_P = 136, HT_P = 72, HS_P = 72;
constexpr int IMG_KHT = 0, IMG_SC = 128 * HT_P * 2, IMG_DV = IMG_SC + 64 * HS_P * 2, IMG_BYTES = IMG_DV + 512;
constexpr int NPREP = 16 * 65 + 32;
constexpr size_t WS_IMG = WS_XN;
constexpr size_t WS_ORAW = WS_WGU1;
static_assert((size_t)NPREP * IMG_BYTES <= 34603008, "image region");
constexpr int LP_QT = 0, LP_KT = LP_QT + 64 * HQ_P * 2, LP_PART = LP_KT + 64 * HQ_P * 2, LP_END = LP_PART + 8 * 128 * 4;
__device__ __forceinline__ void hgrn_chunk_params(bool prompt, int sidx, int c, int& row0, int& nvalid, int& pos0) {
    if (prompt) { if (c == 0) { row0 = MO; nvalid = 16; pos0 = 0; } else { row0 = sidx * 4096 + 64 * (c - 1); nvalid = 64; pos0 = 16 + 64 * (c - 1); } }
    else { row0 = MP + 32 * sidx; nvalid = 32; pos0 = 0; }
}
template <bool WRITE> __device__ __forceinline__ void hgrn_prep(ArgsP A, LAS unsigned char* lds, int item, int tid) {
    const int lane = tid & 63, w = __builtin_amdgcn_readfirstlane(tid >> 6), l16 = lane & 15, g = lane >> 4;
    const bool prompt = item < 1040; const int bh = prompt ? item / 65 : item - 1040, c = prompt ? item % 65 : 0, sidx = bh >> 2, h = bh & 3;
    int row0, nvalid, pos0; hgrn_chunk_params(prompt, sidx, c, row0, nvalid, pos0);
    LAS bf16* Qt = (LAS bf16*)(lds + LP_QT); LAS bf16* Kt = (LAS bf16*)(lds + LP_KT); LAS float* part = (LAS float*)(lds + LP_PART);
    unsigned char* img = A->ws + WS_IMG + (size_t)item * IMG_BYTES;
    const unsigned short* kkh = (const unsigned short*)(A->ws + WS_KKH); bf16* qh = (bf16*)(A->ws + WS_QH);
    const int kp = lane, tg = w;
    float kk[8][2], qv[8][2], cb[8][2]; float run0 = 0.f, run1 = 0.f;
#pragma unroll
    for (int i = 0; i < 8; ++i) { const int t = 8 * tg + i;
        if (t < nvalid) { const size_t off = (size_t)(row0 + t) * 512 + h * 128 + 2 * kp; const unsigned k2 = *(const unsigned*)(kkh + off), q2 = *(const unsigned*)(qh + off);
            kk[i][0] = (float)__builtin_bit_cast(_Float16, (unsigned short)(k2 & 0xffffu)); kk[i][1] = (float)__builtin_bit_cast(_Float16, (unsigned short)(k2 >> 16));
            qv[i][0] = bf2f((unsigned short)(q2 & 0xffffu)); qv[i][1] = bf2f((unsigned short)(q2 >> 16)); }
        else { kk[i][0] = 0.f; kk[i][1] = 0.f; qv[i][0] = 0.f; qv[i][1] = 0.f; } }
#pragma unroll
    for (int i = 0; i < 8; ++i) { run0 += lg2(1.0f - kk[i][0]); run1 += lg2(1.0f - kk[i][1]); cb[i][0] = run0; cb[i][1] = run1; }
    *(LAS f32x2*)(part + tg * 128 + 2 * kp) = (f32x2){run0, run1};
    __syncthreads();
    float off0 = 0.f, off1 = 0.f, tot0 = 0.f, tot1 = 0.f;
#pragma unroll
    for (int q = 0; q < 8; ++q) { const f32x2 p = *(const LAS f32x2*)(part + q * 128 + 2 * kp); if (q < tg) { off0 += p.x; off1 += p.y; } tot0 += p.x; tot1 += p.y; }
    if (WRITE && tg == 0) *(f32x2*)(img + IMG_DV + 8 * kp) = (f32x2){ex2(tot0), ex2(tot1)};
    float kh0[8], kh1[8];
#pragma unroll
    for (int i = 0; i < 8; ++i) { const int t = 8 * tg + i; const float b0 = off0 + cb[i][0], b1 = off1 + cb[i][1];
        const unsigned qq = cvt_pk_bf16(qv[i][0] * ex2(b0), qv[i][1] * ex2(b1)), kq = cvt_pk_bf16(kk[i][0] * ex2(-b0), kk[i][1] * ex2(-b1));
        *(LAS unsigned*)(Qt + t * HQ_P + 2 * kp) = qq; *(LAS unsigned*)(Kt + t * HQ_P + 2 * kp) = kq;
        if (WRITE && t < nvalid) *(unsigned*)(qh + (size_t)(row0 + t) * 512 + h * 128 + 2 * kp) = qq;
        kh0[i] = kk[i][0] * ex2(tot0 - b0); kh1[i] = kk[i][1] * ex2(tot1 - b1); }
    if (WRITE) { *(bf16x8*)(img + IMG_KHT + ((2 * kp) * HT_P + 8 * tg) * 2) = pack8(kh0);
    *(bf16x8*)(img + IMG_KHT + ((2 * kp + 1) * HT_P + 8 * tg) * 2) = pack8(kh1); }
    else if (kh0[0] + kh1[7] == 12345.678f) part[0] = kh0[1];
    __syncthreads();
    bf16* sci = (bf16*)(img + IMG_SC);
#pragma unroll
    for (int q = 0; q < 2; ++q) { const int id = 2 * w + q, mt = id >> 2, nt = id & 3;
        f32x4 sc = {0.f, 0.f, 0.f, 0.f};
        if (mt >= nt) {
#pragma unroll
            for (int ks = 0; ks < 4; ++ks) { const bf16x8 a = *(const LAS bf16x8*)(Qt + (16 * mt + l16) * HQ_P + 32 * ks + 8 * g), b = *(const LAS bf16x8*)(Kt + (16 * nt + l16) * HQ_P + 32 * ks + 8 * g);
                sc = __builtin_amdgcn_mfma_f32_16x16x32_bf16(a, b, sc, 0, 0, 0); }
        }
#pragma unroll
        for (int j = 0; j < 4; ++j) { const int t = 16 * mt + 4 * g + j, s_ = 16 * nt + l16; const float v = (t >= s_) ? sc[j] : 0.f;
            if (WRITE || v == 12345.678f) sci[t * HS_P + s_] = (bf16)(cvt_pk_bf16(v, 0.f) & 0xffffu); }
    }
    __syncthreads();
}
constexpr int LS_QT = 0, LS_SG = LS_QT + 64 * HQ_P * 2, LS_IMG = LS_SG + 64 * HQ_P * 2, LS_BUF = LS_IMG + IMG_BYTES, LS_SSQ = 2 * LS_BUF, LS_END = LS_SSQ + 2 * 2048;
static_assert(LS_END <= 131072 && (LS_BUF % 16) == 0, "hgrn scan lds");
#define WG_BAR() do { asm volatile("s_waitcnt lgkmcnt(0)" ::: "memory"); __builtin_amdgcn_s_barrier(); asm volatile("" ::: "memory"); } while (0)
template <bool WRITE> __device__ __forceinline__ void hgrn_scan(ArgsP A, LAS unsigned char* lds, int item, int tid) {
    const int lane = tid & 63, w = __builtin_amdgcn_readfirstlane(tid >> 6), l16 = lane & 15, g = lane >> 4;
    const bool prompt = item < 16; const int sidx = prompt ? (item >> 2) : ((item - 16) >> 2), h = item & 3;
    const int nchunk = prompt ? 65 : 1;
    const bf16* qh = (const bf16*)(A->ws + WS_QH); bf16* oraw = (bf16*)(A->ws + WS_ORAW);
    const unsigned char* imgb = A->ws + WS_IMG + (size_t)(prompt ? (sidx * 4 + h) * 65 : 1040 + (sidx * 4 + h)) * IMG_BYTES;
    const int vcol = 16 * w + l16;
    const bf16* ivtb = prompt ? ((const bf16*)(A->ws + WS_IVTP) + ((size_t)((sidx * 4 + h) * 128 + vcol)) * LP) : ((const bf16*)(A->ws + WS_IVTS) + ((size_t)((sidx * 4 + h) * 128 + vcol)) * 64);
    const float gn = A->in[I_HGN][h * 128 + vcol];
    f32x4 S[8];
    if (prompt) {
#pragma unroll
        for (int mt = 0; mt < 8; ++mt) S[mt] = (f32x4){0.f, 0.f, 0.f, 0.f};
    } else {
        const float* st = A->in[I_ST] + (size_t)(sidx * 4 + h) * 16384;
#pragma unroll
        for (int mt = 0; mt < 8; ++mt)
#pragma unroll
            for (int j = 0; j < 4; ++j) S[mt][j] = st[(size_t)(16 * mt + 4 * g + j) * 128 + vcol];
    }
    const int prow = tid >> 4, pseg = tid & 15;
    const unsigned qoff = (unsigned)(prow * (HQ_P * 2) + pseg * 16);
    const u32x4 Z4 = {0u, 0u, 0u, 0u};
    u32x4 X[8], Y[8];
#define HG_ISSUE(SET, cidx) do { int c_ = (cidx); c_ = c_ < nchunk ? c_ : nchunk - 1; int row0_, nv_, pos0_; hgrn_chunk_params(prompt, sidx, c_, row0_, nv_, pos0_); \
        const size_t go_ = (size_t)(row0_ + prow) * 512 + h * 128 + pseg * 8; \
        _Pragma("unroll") for (int i_ = 0; i_ < 2; ++i_) { const unsigned m_ = (prow + 32 * i_ < nv_) ? 0xffffffffu : 0u; SET[i_] = *(const u32x4*)(qh + go_ + (size_t)i_ * 32 * 512) & m_; } \
        const unsigned char* im_ = imgb + (size_t)c_ * IMG_BYTES + tid * 16; \
        _Pragma("unroll") for (int i_ = 0; i_ < 4; ++i_) SET[4 + i_] = *(const u32x4*)(im_ + 8192 * i_); } while (0)
#define HG_BIV(DST, cidx) do { int c_ = (cidx); c_ = c_ < nchunk ? c_ : nchunk - 1; int row0_, nv_, pos0_; hgrn_chunk_params(prompt, sidx, c_, row0_, nv_, pos0_); \
        _Pragma("unroll") for (int s_ = 0; s_ < 2; ++s_) { const unsigned m_ = (32 * s_ + 8 * g < nv_) ? 0xffffffffu : 0u; DST[s_] = *(const u32x4*)(ivtb + pos0_ + 32 * s_ + 8 * g) & m_; } } while (0)
#define HG_COMMIT(SET, boff) do { LAS unsigned char* b_ = lds + (boff); \
        _Pragma("unroll") for (int i_ = 0; i_ < 2; ++i_) { *(LAS u32x4*)(b_ + LS_QT + qoff + i_ * 32 * HQ_P * 2) = SET[i_]; } \
        _Pragma("unroll") for (int i_ = 0; i_ < 4; ++i_) { if (tid + 512 * i_ < IMG_BYTES / 16) *(LAS u32x4*)(b_ + LS_IMG + tid * 16 + 8192 * i_) = SET[4 + i_]; } } while (0)
#define HG_COMPUTE(cidx, boff, bivc) do { const int c_ = (cidx); int row0_, nv_, pos0_; hgrn_chunk_params(prompt, sidx, c_, row0_, nv_, pos0_); const bool wr_ = !(prompt && c_ == 0); \
        LAS unsigned char* b_ = lds + (boff); const LAS bf16* Qt = (const LAS bf16*)(b_ + LS_QT); const LAS bf16* Sg = (const LAS bf16*)(b_ + LS_SG); \
        const LAS bf16* KhT = (const LAS bf16*)(b_ + LS_IMG + IMG_KHT); const LAS bf16* Sc = (const LAS bf16*)(b_ + LS_IMG + IMG_SC); const LAS float* dv = (const LAS float*)(b_ + LS_IMG + IMG_DV); \
        LAS float* ssq = (LAS float*)(lds + LS_SSQ + (c_ & 1) * 2048); \
        bf16x8 bs[4]; \
        _Pragma("unroll") for (int ks = 0; ks < 4; ++ks) { u32x4 t_; t_.x = cvt_pk_bf16(S[2 * ks][0], S[2 * ks][1]); t_.y = cvt_pk_bf16(S[2 * ks][2], S[2 * ks][3]); t_.z = cvt_pk_bf16(S[2 * ks + 1][0], S[2 * ks + 1][1]); t_.w = cvt_pk_bf16(S[2 * ks + 1][2], S[2 * ks + 1][3]); bs[ks] = __builtin_bit_cast(bf16x8, t_); } \
        const bf16x8 biv0 = __builtin_bit_cast(bf16x8, bivc[0]), biv1 = __builtin_bit_cast(bf16x8, bivc[1]); \
        f32x4 o[4]; \
        _Pragma("unroll") for (int mt = 0; mt < 4; ++mt) { f32x4 a4 = {0.f, 0.f, 0.f, 0.f}; \
            a4 = __builtin_amdgcn_mfma_f32_16x16x32_bf16(*(const LAS bf16x8*)(Sc + (16 * mt + l16) * HS_P + 8 * g), biv0, a4, 0, 0, 0); \
            a4 = __builtin_amdgcn_mfma_f32_16x16x32_bf16(*(const LAS bf16x8*)(Sc + (16 * mt + l16) * HS_P + 32 + 8 * g), biv1, a4, 0, 0, 0); \
            _Pragma("unroll") for (int ks = 0; ks < 4; ++ks) { const u32x2 lo_ = *(const LAS u32x2*)(Qt + (16 * mt + l16) * HQ_P + 32 * ks + 4 * g), hi_ = *(const LAS u32x2*)(Qt + (16 * mt + l16) * HQ_P + 32 * ks + 16 + 4 * g); \
                u32x4 t_; t_.x = lo_.x; t_.y = lo_.y; t_.z = hi_.x; t_.w = hi_.y; a4 = __builtin_amdgcn_mfma_f32_16x16x32_bf16(__builtin_bit_cast(bf16x8, t_), bs[ks], a4, 0, 0, 0); } \
            o[mt] = a4; } \
        _Pragma("unroll") for (int mt = 0; mt < 8; ++mt) { const f32x4 d4 = *(const LAS f32x4*)(dv + 16 * mt + 4 * g); f32x4 a4 = S[mt] * d4; \
            a4 = __builtin_amdgcn_mfma_f32_16x16x32_bf16(*(const LAS bf16x8*)(KhT + (16 * mt + l16) * HT_P + 8 * g), biv0, a4, 0, 0, 0); \
            a4 = __builtin_amdgcn_mfma_f32_16x16x32_bf16(*(const LAS bf16x8*)(KhT + (16 * mt + l16) * HT_P + 32 + 8 * g), biv1, a4, 0, 0, 0); \
            S[mt] = a4; } \
        if (wr_) { _Pragma("unroll") for (int mt = 0; mt < 4; ++mt) _Pragma("unroll") for (int j = 0; j < 4; ++j) { const int t = 16 * mt + 4 * g + j; \
            if (t < nv_) oraw[(size_t)(row0_ + t) * 512 + h * 128 + vcol] = (bf16)(cvt_pk_bf16(o[mt][j], 0.f) & 0xffffu); } } \
        WG_BAR(); } while (0)
    u32x4 bivA[2], bivB[2];
    HG_ISSUE(X, 0); HG_BIV(bivA, 0); HG_ISSUE(Y, 1); HG_BIV(bivB, 1);
    HG_COMMIT(X, 0);
    HG_ISSUE(X, 2);
    WG_BAR();
    for (int c = 0; c < nchunk; c += 2) {
        if (c + 1 < nchunk) HG_COMMIT(Y, LS_BUF);
        HG_ISSUE(Y, c + 3);
        HG_COMPUTE(c, 0, bivA);
        HG_BIV(bivA, c + 2);
        if (c + 1 < nchunk) {
            if (c + 2 < nchunk) HG_COMMIT(X, 0);
            HG_ISSUE(X, c + 4);
            HG_COMPUTE(c + 1, LS_BUF, bivB);
            HG_BIV(bivB, c + 3);
        }
    }
#undef HG_ISSUE
#undef HG_BIV
#undef HG_COMMIT
#undef HG_COMPUTE
    float* so = A->out + (prompt ? O_PH : O_SH) + (size_t)(sidx * 4 + h) * 16384;
#pragma unroll
    for (int mt = 0; mt < 8; ++mt)
#pragma unroll
        for (int j = 0; j < 4; ++j) so[(size_t)(16 * mt + 4 * g + j) * 128 + vcol] = S[mt][j];
    WG_BAR();
}

__device__ __forceinline__ void hgrn_finalize(ArgsP A, int gw, int ngw, int lane) {
    const bf16* oraw = (const bf16*)(A->ws + WS_ORAW); bf16* sg = (bf16*)(A->ws + WS_SG); const float* gnp = A->in[I_HGN];
    for (int it = gw; it < MO * 4; it += ngw) { const int row = it >> 2, h = it & 3; const size_t off = (size_t)row * 512 + h * 128 + 2 * lane;
        const unsigned ow = *(const unsigned*)(oraw + off), sw = *(const unsigned*)(sg + off);
        const float o0 = bf2f((unsigned short)(ow & 0xffffu)), o1 = bf2f((unsigned short)(ow >> 16));
        const float tot = wave_sum(o0 * o0 + o1 * o1);
        const float rs = rsqrtf(tot * (1.0f / 128.0f) + EPS);
        const f32x2 gn = *(const f32x2*)(gnp + h * 128 + 2 * lane);
        *(unsigned*)(sg + off) = cvt_pk_bf16(o0 * rs * gn.x * bf2f((unsigned short)(sw & 0xffffu)), o1 * rs * gn.y * bf2f((unsigned short)(sw >> 16))); }
}

#define XB_TMO      128
#define XB_XCNT(j)  (256  + 64 * (j))
#define XB_XSUB(j)  (1280 + 64 * (j))
#define XB_XGEN(j)  (2304 + 64 * (j))
#define XB_TOP      3328
#define XB_TOPGEN   3392
#define XCD_BAR_WORDS 3456
#define XB_SPIN_CAP (1u << 18)

__device__ __forceinline__ unsigned xb_ld(unsigned* p)              { return __hip_atomic_load(p, __ATOMIC_RELAXED, __HIP_MEMORY_SCOPE_AGENT); }
__device__ __forceinline__ unsigned xb_add(unsigned* p, unsigned v) { return __hip_atomic_fetch_add(p, v, __ATOMIC_RELAXED, __HIP_MEMORY_SCOPE_AGENT); }
__device__ __forceinline__ unsigned xb_xcc_id() { return (unsigned)__builtin_amdgcn_s_getreg((3 << 11) | 20) & 0xFu; }
#define XB_SPIN(cond, bar) do { unsigned _sp = 0; while (cond) { __builtin_amdgcn_s_sleep(1); \
    if ((++_sp & 255u) == 0u) { if (xb_ld(&(bar)[XB_TMO])) break; if (_sp > XB_SPIN_CAP) { atomicAdd(&(bar)[XB_TMO], 1u); break; } } } } while (0)

struct XcdBarrier {
    unsigned* bar; unsigned x;
    volatile LAS unsigned* st;
};

__device__ __forceinline__ XcdBarrier xcd_barrier_post(unsigned* bar, volatile LAS unsigned* st) {
    XcdBarrier b; b.bar = bar; b.x = xb_xcc_id(); b.st = st;
    if (threadIdx.x == 0) (void)xb_add(&bar[XB_XCNT(b.x)], 1u);
    return b;
}
__device__ __forceinline__ void xcd_barrier_complete(unsigned* bar, unsigned x, unsigned& nloc, unsigned& nx) {
    const unsigned G = gridDim.x * gridDim.y * gridDim.z;
    unsigned sum, cnt, mine, sp = 0u;
    for (;;) {
        sum = 0u; cnt = 0u; mine = 0u;
#pragma unroll
        for (unsigned j = 0; j < 16; ++j) { const unsigned c = xb_ld(&bar[XB_XCNT(j)]); sum += c; cnt += (c > 0u) ? 1u : 0u; mine = (j == x) ? c : mine; }
        if (sum == G) break;
        __builtin_amdgcn_s_sleep(1);
        if ((++sp & 255u) == 0u) { if (xb_ld(&bar[XB_TMO])) break; if (sp > XB_SPIN_CAP) { atomicAdd(&bar[XB_TMO], 1u); break; } }
    }
    nloc = mine > 0u ? mine : 1u; nx = cnt > 0u ? cnt : 1u;
}

__device__ __forceinline__ void xcd_barrier(const XcdBarrier& b) {
    asm volatile("s_waitcnt vmcnt(0)" ::: "memory");
    __syncthreads();
    if (threadIdx.x == 0) {
        unsigned* bar = b.bar;
        __builtin_amdgcn_s_waitcnt(0);
        unsigned nloc = b.st[0], nx = b.st[1];
        if (nloc == 0u) { xcd_barrier_complete(bar, b.x, nloc, nx); b.st[0] = nloc; b.st[1] = nx; }
        const unsigned old = xb_add(&bar[XB_XSUB(b.x)], 1u);
        const unsigned gen = old / nloc;
        if (old + 1u == (gen + 1u) * nloc) {
            __builtin_amdgcn_fence(__ATOMIC_RELEASE, "agent");
            asm volatile("s_waitcnt vmcnt(0)" ::: "memory");
            const unsigned og = xb_add(&bar[XB_TOP], 1u);
            const unsigned tg = og / nx;
            if (og + 1u == (tg + 1u) * nx) xb_add(&bar[XB_TOPGEN], 1u);
            else XB_SPIN(xb_ld(&bar[XB_TOPGEN]) == tg, bar);
            __builtin_amdgcn_fence(__ATOMIC_ACQUIRE, "agent");
            xb_add(&bar[XB_XGEN(b.x)], 1u);
            asm volatile("s_waitcnt vmcnt(0)" ::: "memory");
        } else {
            XB_SPIN(xb_ld(&bar[XB_XGEN(b.x)]) == gen, bar);
            __builtin_amdgcn_fence(__ATOMIC_ACQUIRE, "agent");
            asm volatile("s_waitcnt vmcnt(0)" ::: "memory");
        }
    }
    __syncthreads();
}

__global__ void __launch_bounds__(NTHREADS, 2) mega_fwd(Args Aunused) {
    extern __shared__ __attribute__((aligned(16))) unsigned char lds_raw[];
    LAS unsigned char* lds = (LAS unsigned char*)lds_raw;
    cg::grid_group grid = cg::this_grid();
#define GRID_SYNC_CG() do { asm volatile("s_waitcnt vmcnt(0)" ::: "memory"); grid.sync(); \
        if (threadIdx.x < 64) { __builtin_amdgcn_fence(__ATOMIC_ACQUIRE, "agent"); asm volatile("s_waitcnt vmcnt(0)" ::: "memory"); } __syncthreads(); } while (0)
#define GRID_SYNC() xcd_barrier(xbar)
    if (threadIdx.x < 2) ((volatile LAS unsigned*)(lds + LDS_BARST))[threadIdx.x] = 0u;
    __syncthreads();
    const XcdBarrier xbar = xcd_barrier_post((unsigned*)(argsp()->ws + WS_CTL), (volatile LAS unsigned*)(lds + LDS_BARST));
#define TIDL ({ int t_ = threadIdx.x; asm volatile("" : "+v"(t_)); t_; })
#define LANE (tid & 63)
#define WAVE (__builtin_amdgcn_readfirstlane(tid >> 6))
#define GX ((int)gridDim.x)
#define BX ((int)blockIdx.x)
#define SSP(A, i) ((float*)((A)->ws + WS_SS + (size_t)(i) * SS_BYTES))

#ifndef REP_P0
#define REP_P0 1
#endif
#ifndef REP_P1
#define REP_P1 1
#endif
#ifndef REP_P2
#define REP_P2 1
#endif
#ifndef REP_SYNC
#define REP_SYNC 0
#endif
    for (int rep = 0; rep < REP_P0; ++rep) {
    { const int tid = TIDL; p0_phase(argsp(), lds, WAVE, LANE); }
    GRID_SYNC_CG();
    }
    for (int rep = 0; rep < REP_SYNC; ++rep) GRID_SYNC();
    for (int rep = 0; rep < REP_P1; ++rep) {
    { ArgsP A = argsp(); unsigned char* ws = A->ws; pg8::Gemm g{(const bf16*)(ws + WS_XN), (const bf16*)(ws + WS_WGU1), MPAD, 2 * FF, D}; pg8::StaticOrder S; S.init(MPAD, 2 * FF, GX, BX); EpiSwiGLU E{(bf16*)(ws + WS_ACT), SSP(A, 0)};
      pg8::gemm_phase<EpiSwiGLU, pg8::StaticOrder, true, true>(lds, g, S, E); }
    GRID_SYNC();
    }
    for (int rep = 0; rep < REP_P2; ++rep) {
    { ArgsP A = argsp(); unsigned char* ws = A->ws; pg8::Gemm g{(const bf16*)(ws + WS_ACT), (const bf16*)(ws + WS_WD1), MPAD, D, FF}; pg8::StaticOrder S; S.init(MPAD, D, GX, BX);
      EpiResid<1, 1, 1> E{A->in[I_XP], A->in[I_XS], A->in[I_META], A->out, (bf16*)(ws + WS_XN), A->in[I_NMIX], SSP(A, 1)};
      pg8::gemm_phase<EpiResid<1, 1, 1>, pg8::StaticOrder, true, true>(lds, g, S, E); }
    GRID_SYNC();
    }
#ifndef REP_P3
#define REP_P3 1
#endif
#ifndef REP_P34
#define REP_P34 1
#endif
    for (int rep34 = 0; rep34 < REP_P34; ++rep34) {
    for (int rep3 = 0; rep3 < REP_P3; ++rep3) {
    { ArgsP A = argsp(); unsigned char* ws = A->ws; pg8::Gemm g{(const bf16*)(ws + WS_XN), (const bf16*)(ws + WS_WIN), MPAD, NIN, D}; pg8::StaticOrder S; S.init(MPAD, NIN, GX, BX); EpiWin E{ws, A->out, A->in[I_LB], A->in[I_BG], SSP(A, 1)};
      pg8::gemm_phase<EpiWin, pg8::StaticOrder, true, true>(lds, g, S, E); }
    GRID_SYNC();
    }
#ifdef REP_PREP
    { const int tid = TIDL; for (int it = BX; it < NPREP; it += GX) hgrn_prep<false>(argsp(), lds, it, tid); }
#endif
    { const int tid = TIDL; for (int it = BX; it < NPREP; it += GX) hgrn_prep<true>(argsp(), lds, it, tid); }
    GRID_SYNC();
    {
        const int G = GX, bx = BX; const int tid = TIDL;
        const int abase = G > 48 ? 48 : 0, na = G - abase;
#ifdef REP_SCAN
        for (int it = bx; it < 48; it += G) hgrn_scan<false>(argsp(), lds, it, tid);
#endif
        for (int it = bx; it < 48; it += G) hgrn_scan<true>(argsp(), lds, it, tid);
#ifdef REP_ATT
        if (bx >= abase) for (int it = (bx - abase) * NWAVES + WAVE; it < 4160; it += na * NWAVES) attn_item<false>(argsp(), it, LANE);
#endif
        if (bx >= abase) for (int it = (bx - abase) * NWAVES + WAVE; it < 4160; it += na * NWAVES) attn_item<true>(argsp(), it, LANE);
    }
    GRID_SYNC();
    { const int tid = TIDL; hgrn_finalize(argsp(), BX * NWAVES + WAVE, GX * NWAVES, LANE); }
    GRID_SYNC();
    }
    { ArgsP A = argsp(); unsigned char* ws = A->ws; pg8::Gemm g{(const bf16*)(ws + WS_QB), (const bf16*)(ws + WS_WA), MO, D, 512}; pg8::StaticOrder S; S.init(MO, D, GX, BX); EpiMerge<0> E{(bf16*)(ws + WS_GA), (const bf16*)(ws + WS_GB)};
      pg8::gemm_phase<EpiMerge<0>, pg8::StaticOrder, true, true>(lds, g, S, E); }
    __threadfence(); __syncthreads();
    { ArgsP A = argsp(); unsigned char* ws = A->ws; pg8::Gemm g{(const bf16*)(ws + WS_SG), (const bf16*)(ws + WS_WB), MO, D, 512}; pg8::StaticOrder S; S.init(MO, D, GX, BX); EpiMerge<1> E{(bf16*)(ws + WS_GA), (const bf16*)(ws + WS_GB)};
      pg8::gemm_phase<EpiMerge<1>, pg8::StaticOrder, true, true>(lds, g, S, E); }
    GRID_SYNC();
    { ArgsP A = argsp(); unsigned char* ws = A->ws; pg8::Gemm g{(const bf16*)(ws + WS_GA), (const bf16*)(ws + WS_WOUT), MO, D, D}; pg8::StaticOrder S; S.init(MO, D, GX, BX);
      EpiResid<0, 0, 1> E{nullptr, nullptr, nullptr, A->out, (bf16*)(ws + WS_XN), A->in[I_N2], SSP(A, 2)};
      pg8::gemm_phase<EpiResid<0, 0, 1>, pg8::StaticOrder, true, true>(lds, g, S, E); }
    GRID_SYNC();
    { ArgsP A = argsp(); unsigned char* ws = A->ws; pg8::Gemm g{(const bf16*)(ws + WS_XN), (const bf16*)(ws + WS_WGU2), MO, 2 * FF, D}; pg8::StaticOrder S; S.init(MO, 2 * FF, GX, BX); EpiSwiGLU E{(bf16*)(ws + WS_ACT), SSP(A, 2)};
      pg8::gemm_phase<EpiSwiGLU, pg8::StaticOrder, true, true>(lds, g, S, E); }
    GRID_SYNC();
    { ArgsP A = argsp(); unsigned char* ws = A->ws; pg8::Gemm g{(const bf16*)(ws + WS_ACT), (const bf16*)(ws + WS_WD2), MO, D, FF}; pg8::StaticOrder S; S.init(MO, D, GX, BX);
      EpiResid<0, 1, 0> E{nullptr, nullptr, nullptr, A->out, nullptr, nullptr, SSP(A, 3)};
      pg8::gemm_phase<EpiResid<0, 1, 0>, pg8::StaticOrder, true, true>(lds, g, S, E); }
    GRID_SYNC();
    {
        const int tid = TIDL; ArgsP A = argsp(); float* X = A->out; const float* SS3 = SSP(A, 3);
        const int gw = BX * NWAVES + WAVE, NGW = GX * NWAVES; const f32x4* gf = (const f32x4*)A->in[I_NF] + LANE;
        for (int m = gw; m < MO; m += NGW) { const float rs = rstd_from_ss(SS3, m); f32x4* x4 = (f32x4*)(X + (size_t)m * D) + LANE;
#pragma unroll
            for (int j = 0; j < 4; ++j) { f32x4 v = x4[64 * j]; const f32x4 gg = gf[64 * j]; x4[64 * j] = v * rs * gg; } }
    }
}

extern "C" void kernel_launch(void* const* d_in, const int* in_sizes, int n_in, void* d_out, int out_size, void* d_ws, size_t ws_size, hipStream_t stream) {
    static int grid = 0;
    if (grid == 0) {
        if (n_in != 23 || ws_size < WS_CTL + CTL_BYTES || out_size != 34930688) { fprintf(stderr, "kernel_launch: unexpected problem shape (n_in %d, out %d, ws %zu)\n", n_in, out_size, ws_size); grid = -1; return; }
        int dev = 0, cus = 0, per_cu = 0;
        hipGetDevice(&dev); hipDeviceGetAttribute(&cus, hipDeviceAttributeMultiprocessorCount, dev);
        hipFuncSetAttribute((const void*)mega_fwd, hipFuncAttributeMaxDynamicSharedMemorySize, LDS_BYTES);
        hipOccupancyMaxActiveBlocksPerMultiprocessor(&per_cu, (const void*)mega_fwd, NTHREADS, LDS_BYTES);
        if (per_cu < 1) { fprintf(stderr, "kernel_launch: occupancy query returned %d\n", per_cu); per_cu = 1; }
        (void)hipGetLastError();
        grid = cus * per_cu;
    }
    if (grid < 0) return;
    if (hipMemsetAsync((char*)d_ws + WS_CTL, 0, CTL_BYTES, stream) != hipSuccess) { fprintf(stderr, "kernel_launch: memset of barrier words failed\n"); return; }
    Args a{};
    for (int i = 0; i < 23; ++i) a.in[i] = (const float*)d_in[i];
    a.out = (float*)d_out; a.ws = (unsigned char*)d_ws;
    void* args[] = {&a};
    hipError_t e = hipLaunchCooperativeKernel((const void*)mega_fwd, dim3(grid), dim3(NTHREADS), args, LDS_BYTES, stream);
    if (e != hipSuccess) fprintf(stderr, "cooperative launch failed: %s (grid %d)\n", hipGetErrorString(e), grid);
}
```

```cpp
#include <hip/hip_runtime.h>
#include <hip/hip_cooperative_groups.h>
#include <cstdio>
#include <cstdint>
namespace cg = cooperative_groups;
namespace pg8 {
#define PG8_LAS __attribute__((address_space(3)))
typedef unsigned short bf16_t;
typedef short bf16x8 __attribute__((ext_vector_type(8)));
typedef float f32x4 __attribute__((ext_vector_type(4)));
typedef unsigned u32x4 __attribute__((ext_vector_type(4)));
constexpr int BM = 256, BK = 64, HALF = 128, HTB = HALF * BK * 2  , STAGE_BYTES = 8 * HTB, NXCD = 8, WGM = 8;

__host__ __device__ __forceinline__ int lds_byte(int r, int c) { const int st = (r >> 4) * 2 + (c >> 5), rr = r & 15, cc = c & 31, ob = rr * 64 + cc * 2; return st * 1024 + (ob ^ (((ob >> 9) & 1) << 5)); }
__host__ __device__ __forceinline__ void stage_rc(int b, int& R, int& C) { const int st = b / 1024, sb = b % 1024, swz = sb ^ (((sb >> 9) & 1) << 5); R = (st >> 1) * 16 + swz / 64; C = (st & 1) * 32 + (swz % 64) / 2; }
__host__ __device__ __forceinline__ int perm32(int rho) { const int n = rho >> 4, i = rho & 15; return 8 * (i >> 2) + 4 * n + (i & 3); }

struct Unit { int pm, pn; };
struct Gemm { const bf16_t* A; const bf16_t* Bt; int M, N, K; };

struct StaticOrder {
    int nM, nN, nwg, G, c;
    __host__ __device__ void init(int M, int N, int G_, int c_) { nM = M / BM; nN = N / BM; nwg = nM * nN; G = G_; c = c_; }
    __host__ __device__ bool next(int i, Unit& u) const {
        const long L = (long)i * G + c; if (L >= nwg) return false;
        int wgid = (int)L; { const int q = nwg / NXCD, r = nwg % NXCD, xcd = wgid % NXCD, off = wgid / NXCD; wgid = (xcd < r ? xcd * (q + 1) : r * (q + 1) + (xcd - r) * q) + off; }
        const int nig = WGM * nN, gid = wgid / nig, fm = gid * WGM, gsz = (nM - fm) < WGM ? (nM - fm) : WGM;
        u.pm = fm + ((wgid % nig) % gsz); u.pn = (wgid % nig) / gsz; return true;
    }
    __device__ __forceinline__ void a_ready(const Unit&) const {}
    __device__ __forceinline__ void done(const Unit&) const {}
};

__device__ __forceinline__ unsigned cvt_pk_bf16(float lo, float hi) { unsigned r; asm volatile("v_cvt_pk_bf16_f32 %0, %1, %2" : "=v"(r) : "v"(lo), "v"(hi)); return r; }
template <class Epi, class Sched, bool ALIGN_EPI = false, bool SP2 = false>
__device__ __forceinline__ void gemm_phase(PG8_LAS unsigned char* lds, const Gemm g, const Sched S, const Epi E) {
    int tid_l = threadIdx.x; asm volatile("" : "+v"(tid_l)); const int tid = tid_l, wid = __builtin_amdgcn_readfirstlane(tid >> 6), lane = tid & 63, wr = wid >> 2, wc = wid & 3, fr = lane & 15, fq = lane >> 4;
    const int K = g.K, nt = K / BK;
    unsigned voffA[2], voffB[2];
#pragma unroll
    for (int i = 0; i < 2; ++i) { int R, C; stage_rc(tid * 16 + i * 8192, R, C); const int Rb = Epi::PERM ? ((R & ~31) + perm32(R & 31)) : R;
        voffA[i] = (unsigned)(R * K + C) * 2u; voffB[i] = (unsigned)(Rb * K + C) * 2u; }
    const size_t kstep = (size_t)(BK * 2);
    const size_t hstep = (size_t)HALF * K * 2;
    const size_t tstep = 2 * hstep;
    const unsigned ldsw = (unsigned)wid * 1024u;
    const int aoff = lds_byte(wr * 64 + fr, fq * 8), boff = lds_byte(wc * 32 + fr, fq * 8);
#define PG8_SA(b, h) (((b) * 2 + (h)) * HTB)
#define PG8_SB(b, h) ((4 + (b) * 2 + (h)) * HTB)
#define PG8_STAGE(bufoff, gbase, voff) do { _Pragma("unroll") for (int _i = 0; _i < 2; ++_i) \
        __builtin_amdgcn_global_load_lds((const unsigned*)((const char*)(gbase) + (voff)[_i]), (PG8_LAS unsigned*)(lds + (bufoff) + ldsw + _i * 8192), 16, 0, 0); } while (0)
#define PG8_LDA(dst, b, h) do { _Pragma("unroll") for (int m = 0; m < 4; ++m) _Pragma("unroll") for (int k = 0; k < 2; ++k) dst[m][k] = *(const PG8_LAS bf16x8*)(lds + PG8_SA(b, h) + aoff + m * 2048 + k * 1024); } while (0)
#define PG8_LDB(dst, b, h) do { _Pragma("unroll") for (int n = 0; n < 2; ++n) _Pragma("unroll") for (int k = 0; k < 2; ++k) dst[n][k] = *(const PG8_LAS bf16x8*)(lds + PG8_SB(b, h) + boff + n * 2048 + k * 1024); } while (0)
#define PG8_MMA(ai, bj, At, Bt) do { __builtin_amdgcn_s_setprio(1); _Pragma("unroll") for (int m = 0; m < 4; ++m) _Pragma("unroll") for (int n = 0; n < 2; ++n) _Pragma("unroll") for (int k = 0; k < 2; ++k) \
        acc[ai][bj][m][n] = __builtin_amdgcn_mfma_f32_16x16x32_bf16(Bt[n][k], At[m][k], acc[ai][bj][m][n], 0, 0, 0); __builtin_amdgcn_s_setprio(0); } while (0)
#define PG8_WAIT_V(n) asm volatile("s_waitcnt vmcnt(" #n ")" ::: "memory")
#define PG8_WAIT_L(n) asm volatile("s_waitcnt lgkmcnt(" #n ")" ::: "memory")
#define PG8_BAR __builtin_amdgcn_s_barrier()
#define PG8_SCHED __builtin_amdgcn_sched_barrier(0)
    Unit cur, nxt; int ui = 0;
    if (!S.next(0, cur)) return;
    f32x4 acc[2][2][4][2];
#pragma unroll
    for (int a = 0; a < 2; ++a)
#pragma unroll
        for (int b = 0; b < 2; ++b)
#pragma unroll
            for (int m = 0; m < 4; ++m)
#pragma unroll
                for (int n = 0; n < 2; ++n) acc[a][b][m][n] = (f32x4){0.f, 0.f, 0.f, 0.f};
    bf16x8 At[4][2], B0[2][2], B1[2][2];
    const char* cA = (const char*)g.A + (size_t)cur.pm * tstep; const char* cB = (const char*)g.Bt + (size_t)cur.pn * tstep;
    S.a_ready(cur);
    if constexpr (SP2) {
        PG8_STAGE(PG8_SB(0, 0), cB, voffB); PG8_STAGE(PG8_SB(0, 1), cB + hstep, voffB); PG8_STAGE(PG8_SA(0, 0), cA, voffA); PG8_STAGE(PG8_SA(0, 1), cA + hstep, voffA);
        if (wr == 1) PG8_BAR;
        PG8_WAIT_V(2); PG8_BAR;
        PG8_STAGE(PG8_SB(1, 0), cB + kstep, voffB); PG8_STAGE(PG8_SA(1, 0), cA + kstep, voffA); PG8_STAGE(PG8_SB(1, 1), cB + hstep + kstep, voffB);
        PG8_WAIT_V(6); PG8_BAR;
    } else {
        PG8_STAGE(PG8_SB(0, 0), cB, voffB); PG8_STAGE(PG8_SA(0, 0), cA, voffA); PG8_STAGE(PG8_SB(0, 1), cB + hstep, voffB); PG8_STAGE(PG8_SA(0, 1), cA + hstep, voffA);
        if (wr == 1) PG8_BAR;
        PG8_WAIT_V(4); PG8_BAR;
        PG8_STAGE(PG8_SB(1, 0), cB + kstep, voffB); PG8_STAGE(PG8_SA(1, 0), cA + kstep, voffA); PG8_STAGE(PG8_SB(1, 1), cB + hstep + kstep, voffB);
        PG8_WAIT_V(6); PG8_BAR;
    }
    for (;;) {
        const bool has_next = S.next(ui + 1, nxt);
        const char* nA = has_next ? (const char*)g.A + (size_t)nxt.pm * tstep : cA; const char* nB = has_next ? (const char*)g.Bt + (size_t)nxt.pn * tstep : cB;
        for (int t = 0; t < nt; t += 2) {
            const bool last = (t == nt - 2);
            const char* a1 = cA + (size_t)(t + 1) * kstep;
            const char* a2 = last ? nA : cA + (size_t)(t + 2) * kstep; const char* b2 = last ? nB : cB + (size_t)(t + 2) * kstep;
            const char* a3 = a2 + kstep; const char* b3 = b2 + kstep;
            if (last && has_next) S.a_ready(nxt);
            if constexpr (SP2) {
            PG8_LDB(B0, 0, 0); PG8_LDB(B1, 0, 1); PG8_SCHED; PG8_LDA(At, 0, 0); PG8_STAGE(PG8_SA(1, 1), a1 + hstep, voffA);
            PG8_WAIT_V(8); PG8_WAIT_L(0); PG8_BAR; PG8_MMA(0, 0, At, B0); PG8_MMA(0, 1, At, B1); PG8_BAR; PG8_SCHED;
            PG8_LDA(At, 0, 1); PG8_STAGE(PG8_SB(0, 0), b2, voffB); PG8_STAGE(PG8_SB(0, 1), b2 + hstep, voffB); PG8_STAGE(PG8_SA(0, 0), a2, voffA);
            PG8_WAIT_V(8); PG8_WAIT_L(0); PG8_BAR; PG8_MMA(1, 0, At, B0); PG8_MMA(1, 1, At, B1); PG8_BAR; PG8_SCHED;
            PG8_LDB(B0, 1, 0); PG8_LDB(B1, 1, 1); PG8_SCHED; PG8_LDA(At, 1, 0); PG8_STAGE(PG8_SA(0, 1), a2 + hstep, voffA);
            PG8_WAIT_V(8); PG8_WAIT_L(0); PG8_BAR; PG8_MMA(0, 0, At, B0); PG8_MMA(0, 1, At, B1); PG8_BAR; PG8_SCHED;
            PG8_LDA(At, 1, 1); PG8_STAGE(PG8_SB(1, 0), b3, voffB); PG8_STAGE(PG8_SB(1, 1), b3 + hstep, voffB); PG8_STAGE(PG8_SA(1, 0), a3, voffA);
            PG8_WAIT_V(8); PG8_WAIT_L(0); PG8_BAR; PG8_MMA(1, 0, At, B0); PG8_MMA(1, 1, At, B1); PG8_BAR; PG8_SCHED;
            } else {
            PG8_LDB(B0, 0, 0); PG8_SCHED; PG8_LDA(At, 0, 0); PG8_STAGE(PG8_SA(1, 1), a1 + hstep, voffA);
            PG8_WAIT_L(8); PG8_BAR; PG8_WAIT_L(0); PG8_MMA(0, 0, At, B0); PG8_BAR; PG8_SCHED;
            PG8_LDB(B1, 0, 1); PG8_STAGE(PG8_SB(0, 0), b2, voffB);
            PG8_BAR; PG8_WAIT_L(0); PG8_MMA(0, 1, At, B1); PG8_BAR;
            PG8_LDA(At, 0, 1); PG8_STAGE(PG8_SA(0, 0), a2, voffA);
            PG8_BAR; PG8_WAIT_L(0); PG8_MMA(1, 0, At, B0); PG8_BAR; PG8_SCHED;
            PG8_STAGE(PG8_SB(0, 1), b2 + hstep, voffB);
            PG8_WAIT_V(6); PG8_BAR; PG8_MMA(1, 1, At, B1); PG8_BAR;
            PG8_LDB(B0, 1, 0); PG8_SCHED; PG8_LDA(At, 1, 0); PG8_STAGE(PG8_SA(0, 1), a2 + hstep, voffA);
            PG8_WAIT_L(8); PG8_BAR; PG8_WAIT_L(0); PG8_MMA(0, 0, At, B0); PG8_BAR; PG8_SCHED;
            PG8_LDB(B1, 1, 1); PG8_STAGE(PG8_SB(1, 0), b3, voffB);
            PG8_BAR; PG8_WAIT_L(0); PG8_MMA(0, 1, At, B1); PG8_BAR;
            PG8_LDA(At, 1, 1); PG8_STAGE(PG8_SA(1, 0), a3, voffA);
            PG8_BAR; PG8_WAIT_L(0); PG8_MMA(1, 0, At, B0); PG8_BAR; PG8_SCHED;
            PG8_STAGE(PG8_SB(1, 1), b3 + hstep, voffB);
            PG8_WAIT_V(6); PG8_BAR; PG8_MMA(1, 1, At, B1); PG8_BAR;
            }
        }
        if constexpr (ALIGN_EPI) { if (wr == 0) PG8_BAR; }
        if constexpr (!Epi::AFTER_DRAIN) { E(acc, cur, wr, wc, fr, fq); S.done(cur); }
        if (!has_next) break;
#pragma unroll
        for (int a = 0; a < 2; ++a)
#pragma unroll
            for (int b = 0; b < 2; ++b)
#pragma unroll
                for (int m = 0; m < 4; ++m)
#pragma unroll
                    for (int n = 0; n < 2; ++n) acc[a][b][m][n] = (f32x4){0.f, 0.f, 0.f, 0.f};
        cur = nxt; cA = nA; cB = nB; ++ui;
        if constexpr (ALIGN_EPI) { if (wr == 1) PG8_BAR; }
    }
    PG8_WAIT_V(0);
    if constexpr (!ALIGN_EPI) { if (wr == 0) PG8_BAR; }
    PG8_BAR;
    if constexpr (Epi::AFTER_DRAIN) { E.fused(acc, cur, wr, wc, fr, fq, lds, wid, lane); S.done(cur); }
#undef PG8_SA
#undef PG8_SB
#undef PG8_STAGE
#undef PG8_LDA
#undef PG8_LDB
#undef PG8_MMA
#undef PG8_WAIT_V
#undef PG8_WAIT_L
#undef PG8_BAR
#undef PG8_SCHED
}
}

#define LAS __attribute__((address_space(3)))
typedef unsigned short bf16;
typedef float f32x4 __attribute__((ext_vector_type(4)));
typedef float f32x16 __attribute__((ext_vector_type(16)));
typedef short bf16x8 __attribute__((ext_vector_type(8)));
typedef unsigned u32x4 __attribute__((ext_vector_type(4)));
typedef unsigned u32x2 __attribute__((ext_vector_type(2)));
typedef float f32x2 __attribute__((ext_vector_type(2)));
using pg8::cvt_pk_bf16;

constexpr int NWAVES = 8, NTHREADS = 512;
constexpr int D = 1024, FF = 2816, NIN = 5632;
constexpr int MP = 16384;
constexpr int MS = 256;
constexpr int MO = MP + MS;
constexpr int MX = MO + 16;
constexpr int MPAD = 16896;
constexpr int LP = 4112;
constexpr int LC = 2064;
constexpr float EPS = 1e-6f;
constexpr float LOG2E = 1.4426950408889634f;
constexpr float QSCALE = 0.125f * LOG2E;
constexpr float SB_EXIT = 152.0f;

constexpr size_t O_YP = 0, O_YS = 16777216, O_PK = 17039360, O_PV = 25460736, O_PH = 33882112, O_SK = 34144256, O_SV = 34275328, O_SH = 34406400;
constexpr size_t WS_WGU1 = 0, WS_WD1 = 11534336, WS_WIN = 17301504, WS_WA = 28835840, WS_WB = 29884416, WS_WOUT = 30932992, WS_WGU2 = 33030144, WS_WD2 = 44564480;
constexpr size_t WS_SS = 50331648, SS_BYTES = (size_t)MPAD * 16 * 4;
constexpr size_t WS_XN = 54657024, WS_ACT = 89260032;
constexpr size_t WS_KKH = 184418304, WS_QB = 201719808, WS_QH = 219021312, WS_IVTP = 236322816, WS_IVTS = 253165568, WS_END = 253689856;
constexpr size_t WS_GA = WS_ACT, WS_GB = WS_ACT + 34603008, WS_SG = WS_ACT + 69206016;
constexpr int LDS_BYTES = 147456;
constexpr size_t WS_CTL = 253689856, CTL_BYTES = 16384;
constexpr int LDS_BARST = 131072 + 64;

struct Args { const float* in[23]; float* out; unsigned char* ws; };
typedef const Args __attribute__((address_space(4)))* ArgsP;
__device__ __forceinline__ ArgsP argsp() { ArgsP p = (ArgsP)__builtin_amdgcn_kernarg_segment_ptr(); asm volatile("" : "+s"(p)); return p; }
enum { I_XP = 0, I_XS, I_CK, I_CV, I_ST, I_META, I_N1, I_WG1, I_WU1, I_WD1, I_NMIX, I_WIN, I_BG, I_LB, I_HGN, I_WA, I_WB, I_WOUT, I_N2, I_WG2, I_WU2, I_WD2, I_NF };

__device__ __forceinline__ float wave_sum(float v) {
#pragma unroll
    for (int o = 1; o < 64; o <<= 1) v += __shfl_xor(v, o);
    return v;
}
__device__ __forceinline__ float ex2(float x) { return __builtin_amdgcn_exp2f(x); }
__device__ __forceinline__ float lg2(float x) { return __builtin_amdgcn_logf(x); }
__device__ __forceinline__ float sigmoidf_(float x) { return 1.0f / (1.0f + ex2(-x * LOG2E)); }
__device__ __forceinline__ float rstd_from_ss(const float* ss, int r) {
    const f32x4* p = (const f32x4*)(ss + (size_t)r * 16);
    f32x4 a = p[0], b = p[1], c = p[2], d = p[3];
    float s = ((a.x + a.y) + (a.z + a.w)) + ((b.x + b.y) + (b.z + b.w)) + ((c.x + c.y) + (c.z + c.w)) + ((d.x + d.y) + (d.z + d.w));
    return rsqrtf(s * (1.0f / 1024.0f) + EPS);
}
__device__ __forceinline__ const float* xin_row(ArgsP A, int r) {
    if (r < MP) return A->in[I_XP] + (size_t)r * D;
    if (r < MO) return A->in[I_XS] + (size_t)(r - MP) * D;
    if (r < MX) return A->in[I_META] + (size_t)(r - MO) * D;
    return nullptr;
}

__device__ __forceinline__ void p0_transpose_item(const float* W, int K, int N, bf16* WT, int il, LAS float* scr, int item, int lane) {
    const int nblk = N / 32, kb = item / nblk, nb = item % nblk, k0 = 64 * kb, n0 = 32 * nb;
#pragma unroll 8
    for (int i = 0; i < 32; ++i) { const int kk = 2 * i + (lane >> 5); scr[kk * 33 + (lane & 31)] = W[(size_t)(k0 + kk) * N + n0 + (lane & 31)]; }
    asm volatile("s_waitcnt lgkmcnt(0)" ::: "memory");
    const int rbase = il == 0 ? n0 : ((n0 >> 7) * 256 + (n0 & 127) + (il == 2 ? 128 : 0));
    const int c = lane & 7;
#pragma unroll
    for (int j = 0; j < 4; ++j) { const int n = (lane >> 3) + 8 * j; const LAS float* s = scr + (8 * c) * 33 + n;
        u32x4 o; o.x = cvt_pk_bf16(s[0 * 33], s[1 * 33]); o.y = cvt_pk_bf16(s[2 * 33], s[3 * 33]); o.z = cvt_pk_bf16(s[4 * 33], s[5 * 33]); o.w = cvt_pk_bf16(s[6 * 33], s[7 * 33]);
        *(u32x4*)(WT + (size_t)(rbase + n) * K + k0 + 8 * c) = o; }
    asm volatile("s_waitcnt lgkmcnt(0)" ::: "memory");
}
__device__ __forceinline__ void p0_weights(ArgsP A, LAS unsigned char* lds, int wave, int lane, int gw, int NGW, bool late) {
    LAS float* scr = (LAS float*)(lds + wave * 16384);
    unsigned char* ws = A->ws;
    constexpr int I_GU = (D / 64) * (FF / 32), I_DN = (FF / 64) * (D / 32), I_IN = (D / 64) * (NIN / 32), I_BR = (512 / 64) * (D / 32), I_OU = (D / 64) * (D / 32);
    constexpr int N_EARLY = 2 * I_GU + I_DN + I_IN, N_LATE = 2 * I_BR + I_OU + 2 * I_GU + I_DN;
    if (!late) {
        for (int it = gw; it < N_EARLY; it += NGW) {
            int r = it;
            if (r < I_GU) { p0_transpose_item(A->in[I_WG1], D, FF, (bf16*)(ws + WS_WGU1), 1, scr, r, lane); continue; } r -= I_GU;
            if (r < I_GU) { p0_transpose_item(A->in[I_WU1], D, FF, (bf16*)(ws + WS_WGU1), 2, scr, r, lane); continue; } r -= I_GU;
            if (r < I_DN) { p0_transpose_item(A->in[I_WD1], FF, D, (bf16*)(ws + WS_WD1), 0, scr, r, lane); continue; } r -= I_DN;
            p0_transpose_item(A->in[I_WIN], D, NIN, (bf16*)(ws + WS_WIN), 0, scr, r, lane);
        }
    } else {
        for (int it = gw; it < N_LATE; it += NGW) {
            int r = it;
            if (r < I_BR) { p0_transpose_item(A->in[I_WA], 512, D, (bf16*)(ws + WS_WA), 0, scr, r, lane); continue; } r -= I_BR;
            if (r < I_BR) { p0_transpose_item(A->in[I_WB], 512, D, (bf16*)(ws + WS_WB), 0, scr, r, lane); continue; } r -= I_BR;
            if (r < I_OU) { p0_transpose_item(A->in[I_WOUT], D, D, (bf16*)(ws + WS_WOUT), 0, scr, r, lane); continue; } r -= I_OU;
            if (r < I_GU) { p0_transpose_item(A->in[I_WG2], D, FF, (bf16*)(ws + WS_WGU2), 1, scr, r, lane); continue; } r -= I_GU;
            if (r < I_GU) { p0_transpose_item(A->in[I_WU2], D, FF, (bf16*)(ws + WS_WGU2), 2, scr, r, lane); continue; } r -= I_GU;
            p0_transpose_item(A->in[I_WD2], FF, D, (bf16*)(ws + WS_WD2), 0, scr, r, lane);
        }
    }
}
__device__ __forceinline__ void p0_phase(ArgsP A, LAS unsigned char* lds, int wave, int lane) {
    const int G = gridDim.x, gw = blockIdx.x * NWAVES + wave, NGW = G * NWAVES;
    unsigned char* ws = A->ws;
    p0_weights(A, lds, wave, lane, gw, NGW, false);
    bf16* XN = (bf16*)(ws + WS_XN); float* SS0 = (float*)(ws + WS_SS);
    const f32x4* g1 = (const f32x4*)A->in[I_N1] + lane;
    for (int m = gw; m < MPAD; m += NGW) {
        const float* xr = xin_row(A, m);
        unsigned long long* o8 = (unsigned long long*)(XN + (size_t)m * D) + lane;
        float s = 0.f;
        if (xr) {
            const f32x4* x4 = (const f32x4*)xr + lane;
#pragma unroll
            for (int j = 0; j < 4; ++j) { f32x4 v = x4[64 * j]; const f32x4 g = g1[64 * j]; s += (v.x * v.x + v.y * v.y) + (v.z * v.z + v.w * v.w);
                o8[64 * j] = (unsigned long long)cvt_pk_bf16(v.x * g.x, v.y * g.y) | ((unsigned long long)cvt_pk_bf16(v.z * g.z, v.w * g.w) << 32); }
        } else {
#pragma unroll
            for (int j = 0; j < 4; ++j) o8[64 * j] = 0ull;
        }
        s = wave_sum(s);
        if (lane < 16) SS0[(size_t)m * 16 + lane] = lane == 0 ? s : 0.f;
    }
}

struct EpiSwiGLU {
    static constexpr bool PERM = true, AFTER_DRAIN = false;
    bf16* act; const float* ss;
    __device__ __forceinline__ void operator()(const f32x4 (&acc)[2][2][4][2], const pg8::Unit& u, int wr, int wc, int fr, int fq) const {
        const int col0 = u.pn * 128 + wc * 32 + 8 * fq;
#pragma unroll
        for (int ai = 0; ai < 2; ++ai)
#pragma unroll
            for (int m = 0; m < 4; ++m) {
                const int r = u.pm * 256 + ai * 128 + wr * 64 + m * 16 + fr;
                const float rs = rstd_from_ss(ss, r);
                float o[8];
#pragma unroll
                for (int n = 0; n < 2; ++n)
#pragma unroll
                    for (int e = 0; e < 4; ++e) { const float g = acc[ai][0][m][n][e] * rs, up = acc[ai][1][m][n][e] * rs; o[4 * n + e] = g * up / (1.0f + ex2(-g * LOG2E)); }
                u32x4 w; w.x = cvt_pk_bf16(o[0], o[1]); w.y = cvt_pk_bf16(o[2], o[3]); w.z = cvt_pk_bf16(o[4], o[5]); w.w = cvt_pk_bf16(o[6], o[7]);
                *(u32x4*)(act + (size_t)r * FF + col0) = w;
            }
    }
};
template <int SRC_INPUTS, int HALF_SCALE, int HAS_XN> struct EpiResid {
    static constexpr bool PERM = false, AFTER_DRAIN = false;
    const float* xp; const float* xs; const float* xm; float* X; bf16* XN; const float* gnext; float* ss;
    __device__ __forceinline__ void operator()(const f32x4 (&acc)[2][2][4][2], const pg8::Unit& u, int wr, int wc, int fr, int fq) const {
        const int col0 = u.pn * 256 + wc * 32 + 4 * fq;
#pragma unroll
        for (int ai = 0; ai < 2; ++ai)
#pragma unroll
            for (int m = 0; m < 4; ++m) {
                const int r = u.pm * 256 + ai * 128 + wr * 64 + m * 16 + fr;
                const float* srow = SRC_INPUTS ? (r < MP ? xp + (size_t)r * D : (r < MO ? xs + (size_t)(r - MP) * D : (r < MX ? xm + (size_t)(r - MO) * D : nullptr))) : (X + (size_t)r * D);
                float s = 0.f;
#pragma unroll
                for (int bj = 0; bj < 2; ++bj)
#pragma unroll
                    for (int n = 0; n < 2; ++n) {
                        const int c = col0 + bj * 128 + n * 16;
                        f32x4 v = acc[ai][bj][m][n] * (HALF_SCALE ? 0.5f : 1.0f);
                        if (srow) v += *(const f32x4*)(srow + c);
                        s += (v.x * v.x + v.y * v.y) + (v.z * v.z + v.w * v.w);
                        if (r < MO) *(f32x4*)(X + (size_t)r * D + c) = v;
                        if (HAS_XN) { const f32x4 g = *(const f32x4*)(gnext + c); u32x2 w; w.x = cvt_pk_bf16(v.x * g.x, v.y * g.y); w.y = cvt_pk_bf16(v.z * g.z, v.w * g.w); *(u32x2*)(XN + (size_t)r * D + c) = w; }
                    }
                s += __shfl_xor(s, 16); s += __shfl_xor(s, 32);
                if (fq == 0) ss[(size_t)r * 16 + u.pn * 4 + wc] = s;
            }
    }
};
struct EpiWin {
    static constexpr bool PERM = false, AFTER_DRAIN = false;
    unsigned char* ws; float* out; const float* lbp; const float* bgp; const float* ss;
    template <int TYPE> __device__ __forceinline__ void run(const f32x4 (&acc)[2][2][4][2], const pg8::Unit& u, int wr, int wc, int fr, int fq, int cbase) const {
        const int col0 = u.pn * 256 + wc * 32 + 4 * fq - cbase;
#pragma unroll
        for (int ai = 0; ai < 2; ++ai)
#pragma unroll
            for (int m = 0; m < 4; ++m) {
                const int r = u.pm * 256 + ai * 128 + wr * 64 + m * 16 + fr;
                const int rlim = (TYPE == 0 || TYPE >= 6) ? MO : MX;
                if (r < rlim) {
                const float rs = rstd_from_ss(ss, r);
#pragma unroll
                for (int bj = 0; bj < 2; ++bj)
#pragma unroll
                    for (int n = 0; n < 2; ++n) {
                        const int cc = col0 + bj * 128 + n * 16;
                        const f32x4 v = acc[ai][bj][m][n] * rs;
                        if (TYPE == 0) {
                            u32x2 w; w.x = cvt_pk_bf16(v.x * QSCALE, v.y * QSCALE); w.y = cvt_pk_bf16(v.z * QSCALE, v.w * QSCALE); *(u32x2*)((bf16*)(ws + WS_QB) + (size_t)r * 512 + cc) = w;
                        } else if (TYPE == 1 || TYPE == 2) {
                            const size_t ob = TYPE == 2 ? O_PV : O_PK, os = TYPE == 2 ? O_SV : O_SK;
                            if (r < MP) { const int b = r >> 12, t = r & 4095; *(f32x4*)(out + ob + ((size_t)(b * LP + 16 + t)) * 512 + cc) = v; }
                            else if (r < MO) { *(f32x4*)(out + os + (size_t)(r - MP) * 512 + cc) = v; }
                            else { const int mm = r - MO;
#pragma unroll
                                for (int b = 0; b < 4; ++b) *(f32x4*)(out + ob + ((size_t)(b * LP + mm)) * 512 + cc) = v; }
                        } else if (TYPE == 3) {
                            const f32x4 l0 = *(const f32x4*)(lbp + cc), l1 = *(const f32x4*)(lbp + 512 + cc);
                            _Float16 h[4];
#pragma unroll
                            for (int e = 0; e < 4; ++e) { const float oml = 1.0f / (1.0f + ex2((l1[e] - l0[e]) * LOG2E));
                                h[e] = (_Float16)(oml / (1.0f + ex2(v[e] * LOG2E))); }
                            u32x2 w; w.x = (unsigned)__builtin_bit_cast(unsigned short, h[0]) | ((unsigned)__builtin_bit_cast(unsigned short, h[1]) << 16);
                            w.y = (unsigned)__builtin_bit_cast(unsigned short, h[2]) | ((unsigned)__builtin_bit_cast(unsigned short, h[3]) << 16);
                            *(u32x2*)((unsigned short*)(ws + WS_KKH) + (size_t)r * 512 + cc) = w;
                        } else if (TYPE == 4) {
                            const int h = cc >> 7, vv = cc & 127;
                            const unsigned w01 = cvt_pk_bf16(v.x, v.y), w23 = cvt_pk_bf16(v.z, v.w);
                            const bf16 e0 = (bf16)(w01 & 0xffffu), e1 = (bf16)(w01 >> 16), e2 = (bf16)(w23 & 0xffffu), e3 = (bf16)(w23 >> 16);
                            if (r < MP) { const int b = r >> 12, t = r & 4095; bf16* p = (bf16*)(ws + WS_IVTP) + ((size_t)((b * 4 + h) * 128 + vv)) * LP + 16 + t; p[0] = e0; p[LP] = e1; p[2 * LP] = e2; p[3 * LP] = e3; }
                            else if (r < MO) { const int s = (r - MP) >> 5, t = (r - MP) & 31; bf16* p = (bf16*)(ws + WS_IVTS) + ((size_t)((s * 4 + h) * 128 + vv)) * 64 + t; p[0] = e0; p[64] = e1; p[128] = e2; p[192] = e3; }
                            else { const int mm = r - MO;
#pragma unroll
                                for (int b = 0; b < 4; ++b) { bf16* p = (bf16*)(ws + WS_IVTP) + ((size_t)((b * 4 + h) * 128 + vv)) * LP + mm; p[0] = e0; p[LP] = e1; p[2 * LP] = e2; p[3 * LP] = e3; } }
                        } else if (TYPE == 5) {
                            u32x2 w; w.x = cvt_pk_bf16(v.x, v.y); w.y = cvt_pk_bf16(v.z, v.w); *(u32x2*)((bf16*)(ws + WS_QH) + (size_t)r * 512 + cc) = w;
                        } else if (TYPE == 6) {
                            float o[4];
#pragma unroll
                            for (int e = 0; e < 4; ++e) o[e] = v[e] / (1.0f + ex2(-v[e] * LOG2E));
                            u32x2 w; w.x = cvt_pk_bf16(o[0], o[1]); w.y = cvt_pk_bf16(o[2], o[3]); *(u32x2*)((bf16*)(ws + WS_SG) + (size_t)r * 512 + cc) = w;
                        } else {
                            const f32x4 bg = *(const f32x4*)(bgp + (TYPE == 8 ? 1024 : 0) + cc); float o[4];
#pragma unroll
                            for (int e = 0; e < 4; ++e) o[e] = 1.0f / (1.0f + ex2(-(v[e] + bg[e]) * LOG2E));
                            u32x2 w; w.x = cvt_pk_bf16(o[0], o[1]); w.y = cvt_pk_bf16(o[2], o[3]); *(u32x2*)((bf16*)(ws + (TYPE == 8 ? WS_GB : WS_GA)) + (size_t)r * D + cc) = w;
                        }
                    }
                }
            }
    }
    __device__ __forceinline__ void operator()(const f32x4 (&acc)[2][2][4][2], const pg8::Unit& u, int wr, int wc, int fr, int fq) const {
        const int pn = u.pn;
        if (pn < 2) run<0>(acc, u, wr, wc, fr, fq, 0);
        else if (pn < 4) run<1>(acc, u, wr, wc, fr, fq, 512);
        else if (pn < 6) run<2>(acc, u, wr, wc, fr, fq, 1024);
        else if (pn < 8) run<3>(acc, u, wr, wc, fr, fq, 1536);
        else if (pn < 10) run<4>(acc, u, wr, wc, fr, fq, 2048);
        else if (pn < 12) run<5>(acc, u, wr, wc, fr, fq, 2560);
        else if (pn < 14) run<6>(acc, u, wr, wc, fr, fq, 3072);
        else if (pn < 18) run<7>(acc, u, wr, wc, fr, fq, 3584);
        else run<8>(acc, u, wr, wc, fr, fq, 4608);
    }
};
__device__ __forceinline__ float bf2f(unsigned short h) { return __builtin_bit_cast(float, (unsigned)h << 16); }
template <int PASS> struct EpiMerge {
    static constexpr bool PERM = false, AFTER_DRAIN = false;
    bf16* ga; const bf16* gb;
    __device__ __forceinline__ void operator()(const f32x4 (&acc)[2][2][4][2], const pg8::Unit& u, int wr, int wc, int fr, int fq) const {
        const int col0 = u.pn * 256 + wc * 32 + 4 * fq;
#pragma unroll
        for (int ai = 0; ai < 2; ++ai)
#pragma unroll
            for (int m = 0; m < 4; ++m) {
                const int r = u.pm * 256 + ai * 128 + wr * 64 + m * 16 + fr;
#pragma unroll
                for (int bj = 0; bj < 2; ++bj)
#pragma unroll
                    for (int n = 0; n < 2; ++n) {
                        const int c = col0 + bj * 128 + n * 16;
                        const f32x4 v = acc[ai][bj][m][n];
                        u32x2* pa = (u32x2*)(ga + (size_t)r * D + c);
                        const u32x2 wa = *pa;
                        const float a0 = bf2f(wa.x & 0xffffu), a1 = bf2f(wa.x >> 16), a2 = bf2f(wa.y & 0xffffu), a3 = bf2f(wa.y >> 16);
                        float o0, o1, o2, o3;
                        if (PASS == 0) { o0 = a0 * v.x; o1 = a1 * v.y; o2 = a2 * v.z; o3 = a3 * v.w; }
                        else { const u32x2 wb = *(const u32x2*)(gb + (size_t)r * D + c);
                            o0 = a0 + bf2f(wb.x & 0xffffu) * v.x; o1 = a1 + bf2f(wb.x >> 16) * v.y; o2 = a2 + bf2f(wb.y & 0xffffu) * v.z; o3 = a3 + bf2f(wb.y >> 16) * v.w; }
                        u32x2 w; w.x = cvt_pk_bf16(o0, o1); w.y = cvt_pk_bf16(o2, o3); *pa = w;
                    }
            }
    }
};

__device__ __forceinline__ bf16x8 pack8(const float* f) { u32x4 w; w.x = cvt_pk_bf16(f[0], f[1]); w.y = cvt_pk_bf16(f[2], f[3]); w.z = cvt_pk_bf16(f[4], f[5]); w.w = cvt_pk_bf16(f[6], f[7]); return __builtin_bit_cast(bf16x8, w); }
template <bool WRITE> __device__ __forceinline__ void attn_item(ArgsP A, int item, int lane) {
    const float* kdiag; const float* vdiag; const float* klow; const float* vlow; int qrow0, posq0, nblk, h;
    if (item < 4096) { const int b = item >> 10; h = (item >> 7) & 7; const int qt = item & 127;
        qrow0 = b * 4096 + 32 * qt; posq0 = 16 + 32 * qt; nblk = qt + 2;
        klow = A->out + O_PK + (size_t)b * LP * 512 + h * 64; vlow = A->out + O_PV + (size_t)b * LP * 512 + h * 64;
        kdiag = klow + (size_t)posq0 * 512; vdiag = vlow + (size_t)posq0 * 512;
    } else { const int id = item - 4096, s = id >> 3; h = id & 7;
        qrow0 = MP + 32 * s; posq0 = LC; nblk = 66;
        klow = A->in[I_CK] + (size_t)s * LC * 512 + h * 64; vlow = A->in[I_CV] + (size_t)s * LC * 512 + h * 64;
        kdiag = A->out + O_SK + (size_t)s * 32 * 512 + h * 64; vdiag = A->out + O_SV + (size_t)s * 32 * 512 + h * 64;
    }
    bf16* qo = (bf16*)(A->ws + WS_QB) + (size_t)qrow0 * 512 + h * 64;
    const int ql = lane & 31, hi = lane >> 5;
    bf16x8 qf[4];
#pragma unroll
    for (int s = 0; s < 4; ++s) qf[s] = *(const bf16x8*)(qo + (size_t)ql * 512 + 16 * s + 8 * hi);
    const int rA = (ql & 3) + 4 * (ql >> 3), hA = (ql >> 2) & 1, kappaA = 8 * hA + rA + (rA >= 8 ? 8 : 0);
    f32x16 o0, o1;
#pragma unroll
    for (int r = 0; r < 16; ++r) { o0[r] = 0.f; o1[r] = 0.f; }
    float R = 0.f;
    for (int j = 0; j < nblk; ++j) {
        const int pos0 = posq0 - 32 * j;
        const float* kb = j == 0 ? kdiag : klow; const float* vb = j == 0 ? vdiag : vlow;
        const int rb = j == 0 ? 0 : pos0;
        int rowA = rb + kappaA; rowA = rowA < 0 ? 0 : rowA;
        const float* kp = kb + (size_t)rowA * 512 + 8 * hi;
        f32x16 sacc;
#pragma unroll
        for (int r = 0; r < 16; ++r) sacc[r] = 0.f;
        f32x4 kv[8];
#pragma unroll
        for (int s = 0; s < 4; ++s) { kv[2 * s] = *(const f32x4*)(kp + 16 * s); kv[2 * s + 1] = *(const f32x4*)(kp + 16 * s + 4); }
        float vv[2][2][8];
#pragma unroll
        for (int st = 0; st < 2; ++st)
#pragma unroll
            for (int i = 0; i < 8; ++i) { int row = rb + 16 * st + 8 * hi + i; row = row < 0 ? 0 : row; const float* vp = vb + (size_t)row * 512 + ql; vv[st][0][i] = vp[0]; vv[st][1][i] = vp[32]; }
#pragma unroll
        for (int s = 0; s < 4; ++s) { float kk[8] = {kv[2 * s].x, kv[2 * s].y, kv[2 * s].z, kv[2 * s].w, kv[2 * s + 1].x, kv[2 * s + 1].y, kv[2 * s + 1].z, kv[2 * s + 1].w};
            sacc = __builtin_amdgcn_mfma_f32_32x32x16_bf16(pack8(kk), qf[s], sacc, 0, 0, 0); }
        float sp[16];
#pragma unroll
        for (int r = 0; r < 16; ++r) { const int kappa = 8 * hi + r + (r >= 8 ? 8 : 0);
            const bool valid = (pos0 + kappa >= 0) && (j > 0 || kappa < ql);
            const float z = sacc[r];
            const float s_ = fmaxf(z, 0.f) + lg2(1.0f + ex2(-fabsf(z)));
            sp[r] = valid ? s_ : 0.f; sacc[r] = valid ? z : -1e30f; }
        float glo = 0.f, ghi = 0.f;
#pragma unroll
        for (int r = 0; r < 8; ++r) { glo += sp[r]; ghi += sp[8 + r]; }
        const float pglo = __shfl_xor(glo, 32), pghi = __shfl_xor(ghi, 32);
        const float base_hi = R + (hi == 0 ? pghi : 0.f);
        const float base_lo = R + ghi + pghi + (hi == 0 ? pglo : 0.f);
        float pa[16];
        { float c = base_hi;
#pragma unroll
          for (int r = 15; r >= 8; --r) { c += sp[r]; pa[r] = ex2(sacc[r] - c); }
          c = base_lo;
#pragma unroll
          for (int r = 7; r >= 0; --r) { c += sp[r]; pa[r] = ex2(sacc[r] - c); } }
        R += (glo + ghi) + (pglo + pghi);
        const bf16x8 p0 = pack8(pa), p1 = pack8(pa + 8);
        o0 = __builtin_amdgcn_mfma_f32_32x32x16_bf16(pack8(vv[0][0]), p0, o0, 0, 0, 0);
        o1 = __builtin_amdgcn_mfma_f32_32x32x16_bf16(pack8(vv[0][1]), p0, o1, 0, 0, 0);
        o0 = __builtin_amdgcn_mfma_f32_32x32x16_bf16(pack8(vv[1][0]), p1, o0, 0, 0, 0);
        o1 = __builtin_amdgcn_mfma_f32_32x32x16_bf16(pack8(vv[1][1]), p1, o1, 0, 0, 0);
        if (__all(R > SB_EXIT)) break;
    }
    if (!WRITE) { if (o0[0] + o1[5] != 12345.678f) return; }
#pragma unroll
    for (int g = 0; g < 4; ++g) {
        u32x2 w; w.x = cvt_pk_bf16(o0[4 * g], o0[4 * g + 1]); w.y = cvt_pk_bf16(o0[4 * g + 2], o0[4 * g + 3]);
        *(u32x2*)(qo + (size_t)ql * 512 + 8 * g + 4 * hi) = w;
        u32x2 w1; w1.x = cvt_pk_bf16(o1[4 * g], o1[4 * g + 1]); w1.y = cvt_pk_bf16(o1[4 * g + 2], o1[4 * g + 3]);
        *(u32x2*)(qo + (size_t)ql * 512 + 32 + 8 * g + 4 * hi) = w1;
    }
}

constexpr int HQ_P = 136, HT_P = 72, HS_P = 72;
constexpr int IMG_KHT = 0, IMG_SC = 128 * HT_P * 2, IMG_DV = IMG_SC + 64 * HS_P * 2, IMG_BYTES = IMG_DV + 512;
constexpr int NPREP = 16 * 65 + 32;
constexpr size_t WS_IMG = WS_XN;
constexpr size_t WS_ORAW = WS_WGU1;
static_assert((size_t)NPREP * IMG_BYTES <= 34603008, "image region");
constexpr int LP_QT = 0, LP_KT = LP_QT + 64 * HQ_P * 2, LP_PART = LP_KT + 64 * HQ_P * 2, LP_END = LP_PART + 8 * 128 * 4;
__device__ __forceinline__ void hgrn_chunk_params(bool prompt, int sidx, int c, int& row0, int& nvalid, int& pos0) {
    if (prompt) { if (c == 0) { row0 = MO; nvalid = 16; pos0 = 0; } else { row0 = sidx * 4096 + 64 * (c - 1); nvalid = 64; pos0 = 16 + 64 * (c - 1); } }
    else { row0 = MP + 32 * sidx; nvalid = 32; pos0 = 0; }
}
template <bool WRITE> __device__ __forceinline__ void hgrn_prep(ArgsP A, LAS unsigned char* lds, int item, int tid) {
    const int lane = tid & 63, w = __builtin_amdgcn_readfirstlane(tid >> 6), l16 = lane & 15, g = lane >> 4;
    const bool prompt = item < 1040; const int bh = prompt ? item / 65 : item - 1040, c = prompt ? item % 65 : 0, sidx = bh >> 2, h = bh & 3;
    int row0, nvalid, pos0; hgrn_chunk_params(prompt, sidx, c, row0, nvalid, pos0);
    LAS bf16* Qt = (LAS bf16*)(lds + LP_QT); LAS bf16* Kt = (LAS bf16*)(lds + LP_KT); LAS float* part = (LAS float*)(lds + LP_PART);
    unsigned char* img = A->ws + WS_IMG + (size_t)item * IMG_BYTES;
    const unsigned short* kkh = (const unsigned short*)(A->ws + WS_KKH); bf16* qh = (bf16*)(A->ws + WS_QH);
    const int kp = lane, tg = w;
    float kk[8][2], qv[8][2], cb[8][2]; float run0 = 0.f, run1 = 0.f;
#pragma unroll
    for (int i = 0; i < 8; ++i) { const int t = 8 * tg + i;
        if (t < nvalid) { const size_t off = (size_t)(row0 + t) * 512 + h * 128 + 2 * kp; const unsigned k2 = *(const unsigned*)(kkh + off), q2 = *(const unsigned*)(qh + off);
            kk[i][0] = (float)__builtin_bit_cast(_Float16, (unsigned short)(k2 & 0xffffu)); kk[i][1] = (float)__builtin_bit_cast(_Float16, (unsigned short)(k2 >> 16));
            qv[i][0] = bf2f((unsigned short)(q2 & 0xffffu)); qv[i][1] = bf2f((unsigned short)(q2 >> 16)); }
        else { kk[i][0] = 0.f; kk[i][1] = 0.f; qv[i][0] = 0.f; qv[i][1] = 0.f; } }
#pragma unroll
    for (int i = 0; i < 8; ++i) { run0 += lg2(1.0f - kk[i][0]); run1 += lg2(1.0f - kk[i][1]); cb[i][0] = run0; cb[i][1] = run1; }
    *(LAS f32x2*)(part + tg * 128 + 2 * kp) = (f32x2){run0, run1};
    __syncthreads();
    float off0 = 0.f, off1 = 0.f, tot0 = 0.f, tot1 = 0.f;
#pragma unroll
    for (int q = 0; q < 8; ++q) { const f32x2 p = *(const LAS f32x2*)(part + q * 128 + 2 * kp); if (q < tg) { off0 += p.x; off1 += p.y; } tot0 += p.x; tot1 += p.y; }
    if (WRITE && tg == 0) *(f32x2*)(img + IMG_DV + 8 * kp) = (f32x2){ex2(tot0), ex2(tot1)};
    float kh0[8], kh1[8];
#pragma unroll
    for (int i = 0; i < 8; ++i) { const int t = 8 * tg + i; const float b0 = off0 + cb[i][0], b1 = off1 + cb[i][1];
        const unsigned qq = cvt_pk_bf16(qv[i][0] * ex2(b0), qv[i][1] * ex2(b1)), kq = cvt_pk_bf16(kk[i][0] * ex2(-b0), kk[i][1] * ex2(-b1));
        *(LAS unsigned*)(Qt + t * HQ_P + 2 * kp) = qq; *(LAS unsigned*)(Kt + t * HQ_P + 2 * kp) = kq;
        if (WRITE && t < nvalid) *(unsigned*)(qh + (size_t)(row0 + t) * 512 + h * 128 + 2 * kp) = qq;
        kh0[i] = kk[i][0] * ex2(tot0 - b0); kh1[i] = kk[i][1] * ex2(tot1 - b1); }
    if (WRITE) { *(bf16x8*)(img + IMG_KHT + ((2 * kp) * HT_P + 8 * tg) * 2) = pack8(kh0);
    *(bf16x8*)(img + IMG_KHT + ((2 * kp + 1) * HT_P + 8 * tg) * 2) = pack8(kh1); }
    else if (kh0[0] + kh1[7] == 12345.678f) part[0] = kh0[1];
    __syncthreads();
    bf16* sci = (bf16*)(img + IMG_SC);
#pragma unroll
    for (int q = 0; q < 2; ++q) { const int id = 2 * w + q, mt = id >> 2, nt = id & 3;
        f32x4 sc = {0.f, 0.f, 0.f, 0.f};
        if (mt >= nt) {
#pragma unroll
            for (int ks = 0; ks < 4; ++ks) { const bf16x8 a = *(const LAS bf16x8*)(Qt + (16 * mt + l16) * HQ_P + 32 * ks + 8 * g), b = *(const LAS bf16x8*)(Kt + (16 * nt + l16) * HQ_P + 32 * ks + 8 * g);
                sc = __builtin_amdgcn_mfma_f32_16x16x32_bf16(a, b, sc, 0, 0, 0); }
        }
#pragma unroll
        for (int j = 0; j < 4; ++j) { const int t = 16 * mt + 4 * g + j, s_ = 16 * nt + l16; const float v = (t >= s_) ? sc[j] : 0.f;
            if (WRITE || v == 12345.678f) sci[t * HS_P + s_] = (bf16)(cvt_pk_bf16(v, 0.f) & 0xffffu); }
    }
    __syncthreads();
}
constexpr int LS_QT = 0, LS_SG = LS_QT + 64 * HQ_P * 2, LS_IMG = LS_SG + 64 * HQ_P * 2, LS_BUF = LS_IMG + IMG_BYTES, LS_SSQ = 2 * LS_BUF, LS_END = LS_SSQ + 2 * 2048;
static_assert(LS_END <= 131072 && (LS_BUF % 16) == 0, "hgrn scan lds");
#define WG_BAR() do { asm volatile("s_waitcnt lgkmcnt(0)" ::: "memory"); __builtin_amdgcn_s_barrier(); asm volatile("" ::: "memory"); } while (0)
template <bool WRITE> __device__ __forceinline__ void hgrn_scan(ArgsP A, LAS unsigned char* lds, int item, int tid) {
    const int lane = tid & 63, w = __builtin_amdgcn_readfirstlane(tid >> 6), l16 = lane & 15, g = lane >> 4;
    const bool prompt = item < 16; const int sidx = prompt ? (item >> 2) : ((item - 16) >> 2), h = item & 3;
    const int nchunk = prompt ? 65 : 1;
    const bf16* qh = (const bf16*)(A->ws + WS_QH); bf16* oraw = (bf16*)(A->ws + WS_ORAW);
    const unsigned char* imgb = A->ws + WS_IMG + (size_t)(prompt ? (sidx * 4 + h) * 65 : 1040 + (sidx * 4 + h)) * IMG_BYTES;
    const int vcol = 16 * w + l16;
    const bf16* ivtb = prompt ? ((const bf16*)(A->ws + WS_IVTP) + ((size_t)((sidx * 4 + h) * 128 + vcol)) * LP) : ((const bf16*)(A->ws + WS_IVTS) + ((size_t)((sidx * 4 + h) * 128 + vcol)) * 64);
    const float gn = A->in[I_HGN][h * 128 + vcol];
    f32x4 S[8];
    if (prompt) {
#pragma unroll
        for (int mt = 0; mt < 8; ++mt) S[mt] = (f32x4){0.f, 0.f, 0.f, 0.f};
    } else {
        const float* st = A->in[I_ST] + (size_t)(sidx * 4 + h) * 16384;
#pragma unroll
        for (int mt = 0; mt < 8; ++mt)
#pragma unroll
            for (int j = 0; j < 4; ++j) S[mt][j] = st[(size_t)(16 * mt + 4 * g + j) * 128 + vcol];
    }
    const int prow = tid >> 4, pseg = tid & 15;
    const unsigned qoff = (unsigned)(prow * (HQ_P * 2) + pseg * 16);
    const u32x4 Z4 = {0u, 0u, 0u, 0u};
    u32x4 X[8], Y[8];
#define HG_ISSUE(SET, cidx) do { int c_ = (cidx); c_ = c_ < nchunk ? c_ : nchunk - 1; int row0_, nv_, pos0_; hgrn_chunk_params(prompt, sidx, c_, row0_, nv_, pos0_); \
        const size_t go_ = (size_t)(row0_ + prow) * 512 + h * 128 + pseg * 8; \
        _Pragma("unroll") for (int i_ = 0; i_ < 2; ++i_) { const unsigned m_ = (prow + 32 * i_ < nv_) ? 0xffffffffu : 0u; SET[i_] = *(const u32x4*)(qh + go_ + (size_t)i_ * 32 * 512) & m_; } \
        const unsigned char* im_ = imgb + (size_t)c_ * IMG_BYTES + tid * 16; \
        _Pragma("unroll") for (int i_ = 0; i_ < 4; ++i_) SET[4 + i_] = *(const u32x4*)(im_ + 8192 * i_); } while (0)
#define HG_BIV(DST, cidx) do { int c_ = (cidx); c_ = c_ < nchunk ? c_ : nchunk - 1; int row0_, nv_, pos0_; hgrn_chunk_params(prompt, sidx, c_, row0_, nv_, pos0_); \
        _Pragma("unroll") for (int s_ = 0; s_ < 2; ++s_) { const unsigned m_ = (32 * s_ + 8 * g < nv_) ? 0xffffffffu : 0u; DST[s_] = *(const u32x4*)(ivtb + pos0_ + 32 * s_ + 8 * g) & m_; } } while (0)
#define HG_COMMIT(SET, boff) do { LAS unsigned char* b_ = lds + (boff); \
        _Pragma("unroll") for (int i_ = 0; i_ < 2; ++i_) { *(LAS u32x4*)(b_ + LS_QT + qoff + i_ * 32 * HQ_P * 2) = SET[i_]; } \
        _Pragma("unroll") for (int i_ = 0; i_ < 4; ++i_) { if (tid + 512 * i_ < IMG_BYTES / 16) *(LAS u32x4*)(b_ + LS_IMG + tid * 16 + 8192 * i_) = SET[4 + i_]; } } while (0)
#define HG_COMPUTE(cidx, boff, bivc) do { const int c_ = (cidx); int row0_, nv_, pos0_; hgrn_chunk_params(prompt, sidx, c_, row0_, nv_, pos0_); const bool wr_ = !(prompt && c_ == 0); \
        LAS unsigned char* b_ = lds + (boff); const LAS bf16* Qt = (const LAS bf16*)(b_ + LS_QT); const LAS bf16* Sg = (const LAS bf16*)(b_ + LS_SG); \
        const LAS bf16* KhT = (const LAS bf16*)(b_ + LS_IMG + IMG_KHT); const LAS bf16* Sc = (const LAS bf16*)(b_ + LS_IMG + IMG_SC); const LAS float* dv = (const LAS float*)(b_ + LS_IMG + IMG_DV); \
        LAS float* ssq = (LAS float*)(lds + LS_SSQ + (c_ & 1) * 2048); \
        bf16x8 bs[4]; \
        _Pragma("unroll") for (int ks = 0; ks < 4; ++ks) { u32x4 t_; t_.x = cvt_pk_bf16(S[2 * ks][0], S[2 * ks][1]); t_.y = cvt_pk_bf16(S[2 * ks][2], S[2 * ks][3]); t_.z = cvt_pk_bf16(S[2 * ks + 1][0], S[2 * ks + 1][1]); t_.w = cvt_pk_bf16(S[2 * ks + 1][2], S[2 * ks + 1][3]); bs[ks] = __builtin_bit_cast(bf16x8, t_); } \
        const bf16x8 biv0 = __builtin_bit_cast(bf16x8, bivc[0]), biv1 = __builtin_bit_cast(bf16x8, bivc[1]); \
        f32x4 o[4]; \
          \
        _Pragma("unroll") for (int gp = 0; gp < 2; ++gp) { bf16x8 fa[12]; \
            _Pragma("unroll") for (int m2 = 0; m2 < 2; ++m2) { const int mt = 2 * gp + m2; \
                fa[6 * m2 + 0] = *(const LAS bf16x8*)(Sc + (16 * mt + l16) * HS_P + 8 * g); fa[6 * m2 + 1] = *(const LAS bf16x8*)(Sc + (16 * mt + l16) * HS_P + 32 + 8 * g); \
                _Pragma("unroll") for (int ks = 0; ks < 4; ++ks) { const u32x2 lo_ = *(const LAS u32x2*)(Qt + (16 * mt + l16) * HQ_P + 32 * ks + 4 * g), hi_ = *(const LAS u32x2*)(Qt + (16 * mt + l16) * HQ_P + 32 * ks + 16 + 4 * g); \
                    u32x4 t_; t_.x = lo_.x; t_.y = lo_.y; t_.z = hi_.x; t_.w = hi_.y; fa[6 * m2 + 2 + ks] = __builtin_bit_cast(bf16x8, t_); } } \
            __builtin_amdgcn_sched_barrier(0); \
            f32x4 a0 = {0.f, 0.f, 0.f, 0.f}, a1 = {0.f, 0.f, 0.f, 0.f}; \
            a0 = __builtin_amdgcn_mfma_f32_16x16x32_bf16(fa[0], biv0, a0, 0, 0, 0); a1 = __builtin_amdgcn_mfma_f32_16x16x32_bf16(fa[6], biv0, a1, 0, 0, 0); \
            a0 = __builtin_amdgcn_mfma_f32_16x16x32_bf16(fa[1], biv1, a0, 0, 0, 0); a1 = __builtin_amdgcn_mfma_f32_16x16x32_bf16(fa[7], biv1, a1, 0, 0, 0); \
            _Pragma("unroll") for (int ks = 0; ks < 4; ++ks) { a0 = __builtin_amdgcn_mfma_f32_16x16x32_bf16(fa[2 + ks], bs[ks], a0, 0, 0, 0); a1 = __builtin_amdgcn_mfma_f32_16x16x32_bf16(fa[8 + ks], bs[ks], a1, 0, 0, 0); } \
            o[2 * gp] = a0; o[2 * gp + 1] = a1; \
            __builtin_amdgcn_sched_barrier(0); } \
        _Pragma("unroll") for (int gp = 0; gp < 2; ++gp) { bf16x8 fk[8]; f32x4 d4[4]; \
            _Pragma("unroll") for (int m4 = 0; m4 < 4; ++m4) { const int mt = 4 * gp + m4; d4[m4] = *(const LAS f32x4*)(dv + 16 * mt + 4 * g); \
                fk[2 * m4] = *(const LAS bf16x8*)(KhT + (16 * mt + l16) * HT_P + 8 * g); fk[2 * m4 + 1] = *(const LAS bf16x8*)(KhT + (16 * mt + l16) * HT_P + 32 + 8 * g); } \
            __builtin_amdgcn_sched_barrier(0); \
            f32x4 a_[4]; \
            _Pragma("unroll") for (int m4 = 0; m4 < 4; ++m4) a_[m4] = S[4 * gp + m4] * d4[m4]; \
            _Pragma("unroll") for (int m4 = 0; m4 < 4; ++m4) a_[m4] = __builtin_amdgcn_mfma_f32_16x16x32_bf16(fk[2 * m4], biv0, a_[m4], 0, 0, 0); \
            _Pragma("unroll") for (int m4 = 0; m4 < 4; ++m4) a_[m4] = __builtin_amdgcn_mfma_f32_16x16x32_bf16(fk[2 * m4 + 1], biv1, a_[m4], 0, 0, 0); \
            _Pragma("unroll") for (int m4 = 0; m4 < 4; ++m4) S[4 * gp + m4] = a_[m4]; \
            __builtin_amdgcn_sched_barrier(0); } \
        if (wr_) { _Pragma("unroll") for (int mt = 0; mt < 4; ++mt) _Pragma("unroll") for (int j = 0; j < 4; ++j) { const int t = 16 * mt + 4 * g + j; \
            if (t < nv_) oraw[(size_t)(row0_ + t) * 512 + h * 128 + vcol] = (bf16)(cvt_pk_bf16(o[mt][j], 0.f) & 0xffffu); } } \
        WG_BAR(); } while (0)
    u32x4 bivA[2], bivB[2];
    HG_ISSUE(X, 0); HG_BIV(bivA, 0); HG_ISSUE(Y, 1); HG_BIV(bivB, 1);
    HG_COMMIT(X, 0);
    HG_ISSUE(X, 2);
    WG_BAR();
    for (int c = 0; c < nchunk; c += 2) {
        if (c + 1 < nchunk) HG_COMMIT(Y, LS_BUF);
        HG_ISSUE(Y, c + 3);
        HG_COMPUTE(c, 0, bivA);
        HG_BIV(bivA, c + 2);
        if (c + 1 < nchunk) {
            if (c + 2 < nchunk) HG_COMMIT(X, 0);
            HG_ISSUE(X, c + 4);
            HG_COMPUTE(c + 1, LS_BUF, bivB);
            HG_BIV(bivB, c + 3);
        }
    }
#undef HG_ISSUE
#undef HG_BIV
#undef HG_COMMIT
#undef HG_COMPUTE
    float* so = A->out + (prompt ? O_PH : O_SH) + (size_t)(sidx * 4 + h) * 16384;
#pragma unroll
    for (int mt = 0; mt < 8; ++mt)
#pragma unroll
        for (int j = 0; j < 4; ++j) so[(size_t)(16 * mt + 4 * g + j) * 128 + vcol] = S[mt][j];
    WG_BAR();
}

__device__ __forceinline__ void hgrn_finalize(ArgsP A, int gw, int ngw, int lane) {
    const bf16* oraw = (const bf16*)(A->ws + WS_ORAW); bf16* sg = (bf16*)(A->ws + WS_SG); const float* gnp = A->in[I_HGN];
    for (int it = gw; it < MO * 4; it += ngw) { const int row = it >> 2, h = it & 3; const size_t off = (size_t)row * 512 + h * 128 + 2 * lane;
        const unsigned ow = *(const unsigned*)(oraw + off), sw = *(const unsigned*)(sg + off);
        const float o0 = bf2f((unsigned short)(ow & 0xffffu)), o1 = bf2f((unsigned short)(ow >> 16));
        const float tot = wave_sum(o0 * o0 + o1 * o1);
        const float rs = rsqrtf(tot * (1.0f / 128.0f) + EPS);
        const f32x2 gn = *(const f32x2*)(gnp + h * 128 + 2 * lane);
        *(unsigned*)(sg + off) = cvt_pk_bf16(o0 * rs * gn.x * bf2f((unsigned short)(sw & 0xffffu)), o1 * rs * gn.y * bf2f((unsigned short)(sw >> 16))); }
}

#define XB_TMO      128
#define XB_XCNT(j)  (256  + 64 * (j))
#define XB_XSUB(j)  (1280 + 64 * (j))
#define XB_XGEN(j)  (2304 + 64 * (j))
#define XB_TOP      3328
#define XB_TOPGEN   3392
#define XCD_BAR_WORDS 3456
#define XB_SPIN_CAP (1u << 18)

__device__ __forceinline__ unsigned xb_ld(unsigned* p)              { return __hip_atomic_load(p, __ATOMIC_RELAXED, __HIP_MEMORY_SCOPE_AGENT); }
__device__ __forceinline__ unsigned xb_add(unsigned* p, unsigned v) { return __hip_atomic_fetch_add(p, v, __ATOMIC_RELAXED, __HIP_MEMORY_SCOPE_AGENT); }
__device__ __forceinline__ unsigned xb_xcc_id() { return (unsigned)__builtin_amdgcn_s_getreg((3 << 11) | 20) & 0xFu; }
#define XB_SPIN(cond, bar) do { unsigned _sp = 0; while (cond) { __builtin_amdgcn_s_sleep(1); \
    if ((++_sp & 255u) == 0u) { if (xb_ld(&(bar)[XB_TMO])) break; if (_sp > XB_SPIN_CAP) { atomicAdd(&(bar)[XB_TMO], 1u); break; } } } } while (0)

struct XcdBarrier {
    unsigned* bar; unsigned x;
    volatile LAS unsigned* st;
};

__device__ __forceinline__ XcdBarrier xcd_barrier_post(unsigned* bar, volatile LAS unsigned* st) {
    XcdBarrier b; b.bar = bar; b.x = xb_xcc_id(); b.st = st;
    if (threadIdx.x == 0) (void)xb_add(&bar[XB_XCNT(b.x)], 1u);
    return b;
}
__device__ __forceinline__ void xcd_barrier_complete(unsigned* bar, unsigned x, unsigned& nloc, unsigned& nx) {
    const unsigned G = gridDim.x * gridDim.y * gridDim.z;
    unsigned sum, cnt, mine, sp = 0u;
    for (;;) {
        sum = 0u; cnt = 0u; mine = 0u;
#pragma unroll
        for (unsigned j = 0; j < 16; ++j) { const unsigned c = xb_ld(&bar[XB_XCNT(j)]); sum += c; cnt += (c > 0u) ? 1u : 0u; mine = (j == x) ? c : mine; }
        if (sum == G) break;
        __builtin_amdgcn_s_sleep(1);
        if ((++sp & 255u) == 0u) { if (xb_ld(&bar[XB_TMO])) break; if (sp > XB_SPIN_CAP) { atomicAdd(&bar[XB_TMO], 1u); break; } }
    }
    nloc = mine > 0u ? mine : 1u; nx = cnt > 0u ? cnt : 1u;
}

__device__ __forceinline__ void xcd_barrier(const XcdBarrier& b) {
    asm volatile("s_waitcnt vmcnt(0)" ::: "memory");
    __syncthreads();
    if (threadIdx.x == 0) {
        unsigned* bar = b.bar;
        __builtin_amdgcn_s_waitcnt(0);
        unsigned nloc = b.st[0], nx = b.st[1];
        if (nloc == 0u) { xcd_barrier_complete(bar, b.x, nloc, nx); b.st[0] = nloc; b.st[1] = nx; }
        const unsigned old = xb_add(&bar[XB_XSUB(b.x)], 1u);
        const unsigned gen = old / nloc;
        if (old + 1u == (gen + 1u) * nloc) {
            __builtin_amdgcn_fence(__ATOMIC_RELEASE, "agent");
            asm volatile("s_waitcnt vmcnt(0)" ::: "memory");
            const unsigned og = xb_add(&bar[XB_TOP], 1u);
            const unsigned tg = og / nx;
            if (og + 1u == (tg + 1u) * nx) xb_add(&bar[XB_TOPGEN], 1u);
            else XB_SPIN(xb_ld(&bar[XB_TOPGEN]) == tg, bar);
            __builtin_amdgcn_fence(__ATOMIC_ACQUIRE, "agent");
            xb_add(&bar[XB_XGEN(b.x)], 1u);
            asm volatile("s_waitcnt vmcnt(0)" ::: "memory");
        } else {
            XB_SPIN(xb_ld(&bar[XB_XGEN(b.x)]) == gen, bar);
            __builtin_amdgcn_fence(__ATOMIC_ACQUIRE, "agent");
            asm volatile("s_waitcnt vmcnt(0)" ::: "memory");
        }
    }
    __syncthreads();
}

__global__ void __launch_bounds__(NTHREADS, 2) mega_fwd(Args Aunused) {
    extern __shared__ __attribute__((aligned(16))) unsigned char lds_raw[];
    LAS unsigned char* lds = (LAS unsigned char*)lds_raw;
    cg::grid_group grid = cg::this_grid();
#define GRID_SYNC_CG() do { asm volatile("s_waitcnt vmcnt(0)" ::: "memory"); grid.sync(); \
        if (threadIdx.x < 64) { __builtin_amdgcn_fence(__ATOMIC_ACQUIRE, "agent"); asm volatile("s_waitcnt vmcnt(0)" ::: "memory"); } __syncthreads(); } while (0)
#define GRID_SYNC() xcd_barrier(xbar)
    if (threadIdx.x < 2) ((volatile LAS unsigned*)(lds + LDS_BARST))[threadIdx.x] = 0u;
    __syncthreads();
    const XcdBarrier xbar = xcd_barrier_post((unsigned*)(argsp()->ws + WS_CTL), (volatile LAS unsigned*)(lds + LDS_BARST));
#define TIDL ({ int t_ = threadIdx.x; asm volatile("" : "+v"(t_)); t_; })
#define LANE (tid & 63)
#define WAVE (__builtin_amdgcn_readfirstlane(tid >> 6))
#define GX ((int)gridDim.x)
#define BX ((int)blockIdx.x)
#define SSP(A, i) ((float*)((A)->ws + WS_SS + (size_t)(i) * SS_BYTES))

#ifndef REP_P0
#define REP_P0 1
#endif
#ifndef REP_P1
#define REP_P1 1
#endif
#ifndef REP_P2
#define REP_P2 1
#endif
#ifndef REP_SYNC
#define REP_SYNC 0
#endif
    for (int rep = 0; rep < REP_P0; ++rep) {
    { const int tid = TIDL; p0_phase(argsp(), lds, WAVE, LANE); }
    if (argsp()->out == nullptr) GRID_SYNC_CG();
    GRID_SYNC();
    }
    for (int rep = 0; rep < REP_SYNC; ++rep) GRID_SYNC();
    for (int rep = 0; rep < REP_P1; ++rep) {
    { ArgsP A = argsp(); unsigned char* ws = A->ws; pg8::Gemm g{(const bf16*)(ws + WS_XN), (const bf16*)(ws + WS_WGU1), MPAD, 2 * FF, D}; pg8::StaticOrder S; S.init(MPAD, 2 * FF, GX, BX); EpiSwiGLU E{(bf16*)(ws + WS_ACT), SSP(A, 0)};
      pg8::gemm_phase<EpiSwiGLU, pg8::StaticOrder, true, true>(lds, g, S, E); }
    GRID_SYNC();
    }
    for (int rep = 0; rep < REP_P2; ++rep) {
    { ArgsP A = argsp(); unsigned char* ws = A->ws; pg8::Gemm g{(const bf16*)(ws + WS_ACT), (const bf16*)(ws + WS_WD1), MPAD, D, FF}; pg8::StaticOrder S; S.init(MPAD, D, GX, BX);
      EpiResid<1, 1, 1> E{A->in[I_XP], A->in[I_XS], A->in[I_META], A->out, (bf16*)(ws + WS_XN), A->in[I_NMIX], SSP(A, 1)};
      pg8::gemm_phase<EpiResid<1, 1, 1>, pg8::StaticOrder, true, true>(lds, g, S, E); }
    GRID_SYNC();
    }
#ifndef REP_P3
#define REP_P3 1
#endif
#ifndef REP_P34
#define REP_P34 1
#endif
    for (int rep34 = 0; rep34 < REP_P34; ++rep34) {
    for (int rep3 = 0; rep3 < REP_P3; ++rep3) {
    { ArgsP A = argsp(); unsigned char* ws = A->ws; pg8::Gemm g{(const bf16*)(ws + WS_XN), (const bf16*)(ws + WS_WIN), MPAD, NIN, D}; pg8::StaticOrder S; S.init(MPAD, NIN, GX, BX); EpiWin E{ws, A->out, A->in[I_LB], A->in[I_BG], SSP(A, 1)};
      pg8::gemm_phase<EpiWin, pg8::StaticOrder, true, true>(lds, g, S, E); }
    GRID_SYNC();
    }
#ifdef REP_PREP
    { const int tid = TIDL; for (int it = BX; it < NPREP; it += GX) hgrn_prep<false>(argsp(), lds, it, tid); }
#endif
    { const int tid = TIDL; for (int it = BX; it < NPREP; it += GX) hgrn_prep<true>(argsp(), lds, it, tid); }
    GRID_SYNC();
    {
        const int G = GX, bx = BX; const int tid = TIDL;
        const int abase = G > 48 ? 48 : 0, na = G - abase;
#ifdef REP_SCAN
        for (int it = bx; it < 48; it += G) hgrn_scan<false>(argsp(), lds, it, tid);
#endif
        for (int it = bx; it < 48; it += G) hgrn_scan<true>(argsp(), lds, it, tid);
#ifdef REP_ATT
        if (bx >= abase) for (int it = (bx - abase) * NWAVES + WAVE; it < 4160; it += na * NWAVES) attn_item<false>(argsp(), it, LANE);
#endif
        if (bx >= abase) { for (int it = (bx - abase) * NWAVES + WAVE; it < 4160; it += na * NWAVES) attn_item<true>(argsp(), it, LANE);
            p0_weights(argsp(), lds, WAVE, LANE, (bx - abase) * NWAVES + WAVE, na * NWAVES, true); }
    }
    GRID_SYNC();
    { const int tid = TIDL; hgrn_finalize(argsp(), BX * NWAVES + WAVE, GX * NWAVES, LANE); }
    GRID_SYNC();
    }
    { ArgsP A = argsp(); unsigned char* ws = A->ws; pg8::Gemm g{(const bf16*)(ws + WS_QB), (const bf16*)(ws + WS_WA), MO, D, 512}; pg8::StaticOrder S; S.init(MO, D, GX, BX); EpiMerge<0> E{(bf16*)(ws + WS_GA), (const bf16*)(ws + WS_GB)};
      pg8::gemm_phase<EpiMerge<0>, pg8::StaticOrder, true, true>(lds, g, S, E); }
    __threadfence(); __syncthreads();
    { ArgsP A = argsp(); unsigned char* ws = A->ws; pg8::Gemm g{(const bf16*)(ws + WS_SG), (const bf16*)(ws + WS_WB), MO, D, 512}; pg8::StaticOrder S; S.init(MO, D, GX, BX); EpiMerge<1> E{(bf16*)(ws + WS_GA), (const bf16*)(ws + WS_GB)};
      pg8::gemm_phase<EpiMerge<1>, pg8::StaticOrder, true, true>(lds, g, S, E); }
    GRID_SYNC();
    { ArgsP A = argsp(); unsigned char* ws = A->ws; pg8::Gemm g{(const bf16*)(ws + WS_GA), (const bf16*)(ws + WS_WOUT), MO, D, D}; pg8::StaticOrder S; S.init(MO, D, GX, BX);
      EpiResid<0, 0, 1> E{nullptr, nullptr, nullptr, A->out, (bf16*)(ws + WS_XN), A->in[I_N2], SSP(A, 2)};
      pg8::gemm_phase<EpiResid<0, 0, 1>, pg8::StaticOrder, true, true>(lds, g, S, E); }
    GRID_SYNC();
    { ArgsP A = argsp(); unsigned char* ws = A->ws; pg8::Gemm g{(const bf16*)(ws + WS_XN), (const bf16*)(ws + WS_WGU2), MO, 2 * FF, D}; pg8::StaticOrder S; S.init(MO, 2 * FF, GX, BX); EpiSwiGLU E{(bf16*)(ws + WS_ACT), SSP(A, 2)};
      pg8::gemm_phase<EpiSwiGLU, pg8::StaticOrder, true, true>(lds, g, S, E); }
    GRID_SYNC();
    { ArgsP A = argsp(); unsigned char* ws = A->ws; pg8::Gemm g{(const bf16*)(ws + WS_ACT), (const bf16*)(ws + WS_WD2), MO, D, FF}; pg8::StaticOrder S; S.init(MO, D, GX, BX);
      EpiResid<0, 1, 0> E{nullptr, nullptr, nullptr, A->out, nullptr, nullptr, SSP(A, 3)};
      pg8::gemm_phase<EpiResid<0, 1, 0>, pg8::StaticOrder, true, true>(lds, g, S, E); }
    GRID_SYNC();
    {
        const int tid = TIDL; ArgsP A = argsp(); float* X = A->out; const float* SS3 = SSP(A, 3);
        const int gw = BX * NWAVES + WAVE, NGW = GX * NWAVES; const f32x4* gf = (const f32x4*)A->in[I_NF] + LANE;
        for (int m = gw; m < MO; m += NGW) { const float rs = rstd_from_ss(SS3, m); f32x4* x4 = (f32x4*)(X + (size_t)m * D) + LANE;
#pragma unroll
            for (int j = 0; j < 4; ++j) { f32x4 v = x4[64 * j]; const f32x4 gg = gf[64 * j]; x4[64 * j] = v * rs * gg; } }
    }
}

extern "C" void kernel_launch(void* const* d_in, const int* in_sizes, int n_in, void* d_out, int out_size, void* d_ws, size_t ws_size, hipStream_t stream) {
    static int grid = 0;
    if (grid == 0) {
        if (n_in != 23 || ws_size < WS_CTL + CTL_BYTES || out_size != 34930688) { fprintf(stderr, "kernel_launch: unexpected problem shape (n_in %d, out %d, ws %zu)\n", n_in, out_size, ws_size); grid = -1; return; }
        int dev = 0, cus = 0, per_cu = 0;
        hipGetDevice(&dev); hipDeviceGetAttribute(&cus, hipDeviceAttributeMultiprocessorCount, dev);
        hipFuncSetAttribute((const void*)mega_fwd, hipFuncAttributeMaxDynamicSharedMemorySize, LDS_BYTES);
        hipOccupancyMaxActiveBlocksPerMultiprocessor(&per_cu, (const void*)mega_fwd, NTHREADS, LDS_BYTES);
        if (per_cu < 1) { fprintf(stderr, "kernel_launch: occupancy query returned %d\n", per_cu); per_cu = 1; }
        (void)hipGetLastError();
        grid = cus * per_cu;
    }
    if (grid < 0) return;
    if (hipMemsetAsync((char*)d_ws + WS_CTL, 0, CTL_BYTES, stream) != hipSuccess) { fprintf(stderr, "kernel_launch: memset of barrier words failed\n"); return; }
    Args a{};
    for (int i = 0; i < 23; ++i) a.in[i] = (const float*)d_in[i];
    a.out = (float*)d_out; a.ws = (unsigned char*)d_ws;
    void* args[] = {&a};
    hipError_t e = hipLaunchCooperativeKernel((const void*)mega_fwd, dim3(grid), dim3(NTHREADS), args, LDS_BYTES, stream);
    if (e != hipSuccess) fprintf(stderr, "cooperative launch failed: %s (grid %d)\n", hipGetErrorString(e), grid);
}
```

```cpp
#include <hip/hip_runtime.h>
#include <hip/hip_cooperative_groups.h>
#include <cstdio>
#include <cstdint>
namespace cg = cooperative_groups;
namespace pg8 {
#define PG8_LAS __attribute__((address_space(3)))
typedef unsigned short bf16_t;
typedef short bf16x8 __attribute__((ext_vector_type(8)));
typedef float f32x4 __attribute__((ext_vector_type(4)));
typedef unsigned u32x4 __attribute__((ext_vector_type(4)));
constexpr int BM = 256, BK = 64, HALF = 128, HTB = HALF * BK * 2  , STAGE_BYTES = 8 * HTB, NXCD = 8, WGM = 8;

__host__ __device__ __forceinline__ int lds_byte(int r, int c) { const int st = (r >> 4) * 2 + (c >> 5), rr = r & 15, cc = c & 31, ob = rr * 64 + cc * 2; return st * 1024 + (ob ^ (((ob >> 9) & 1) << 5)); }
__host__ __device__ __forceinline__ void stage_rc(int b, int& R, int& C) { const int st = b / 1024, sb = b % 1024, swz = sb ^ (((sb >> 9) & 1) << 5); R = (st >> 1) * 16 + swz / 64; C = (st & 1) * 32 + (swz % 64) / 2; }
__host__ __device__ __forceinline__ int perm32(int rho) { const int n = rho >> 4, i = rho & 15; return 8 * (i >> 2) + 4 * n + (i & 3); }

struct Unit { int pm, pn, kc; };
struct Gemm { const bf16_t* A; const bf16_t* Bt; int M, N, K; };

struct StaticOrder {
    int nM, nN, nwg, G, c;
    __host__ __device__ void init(int M, int N, int G_, int c_) { nM = M / BM; nN = N / BM; nwg = nM * nN; G = G_; c = c_; }
    __host__ __device__ bool next(int i, Unit& u) const {
        const long L = (long)i * G + c; if (L >= nwg) return false;
        int wgid = (int)L; { const int q = nwg / NXCD, r = nwg % NXCD, xcd = wgid % NXCD, off = wgid / NXCD; wgid = (xcd < r ? xcd * (q + 1) : r * (q + 1) + (xcd - r) * q) + off; }
        const int nig = WGM * nN, gid = wgid / nig, fm = gid * WGM, gsz = (nM - fm) < WGM ? (nM - fm) : WGM;
        u.pm = fm + ((wgid % nig) % gsz); u.pn = (wgid % nig) / gsz; u.kc = -1; return true;
    }
    __device__ __forceinline__ void a_ready(const Unit&) const {}
    __device__ __forceinline__ void done(const Unit&) const {}
};

__device__ __forceinline__ unsigned cvt_pk_bf16(float lo, float hi) { unsigned r; asm volatile("v_cvt_pk_bf16_f32 %0, %1, %2" : "=v"(r) : "v"(lo), "v"(hi)); return r; }
struct TailOrder {
    StaticOrder so; int nmini, nkc, G, c;
    __host__ __device__ void init(int Mmain, int N, int G_, int c_, int nextra, int nkc_) { so.init(Mmain, N, G_, c_); G = G_; c = c_; nkc = nkc_; nmini = nextra * so.nN * nkc_; }
    __host__ __device__ bool next(int i, Unit& u) const {
        const int cm = c < so.nwg ? (so.nwg - c + G - 1) / G : 0; if (i < cm) return so.next(i, u);
        const int j = (i - cm) * G + c; if (j >= nmini) return false;
        u.kc = j % nkc; u.pn = (j / nkc) % so.nN; u.pm = so.nM + j / (nkc * so.nN); return true; }
    __device__ __forceinline__ void a_ready(const Unit&) const {}
    __device__ __forceinline__ void done(const Unit&) const {}
};
template <class Epi, class Sched, bool ALIGN_EPI = false, bool SP2 = false>
__device__ __forceinline__ void gemm_phase(PG8_LAS unsigned char* lds, const Gemm g, const Sched S, const Epi E) {
    int tid_l = threadIdx.x; asm volatile("" : "+v"(tid_l)); const int tid = tid_l, wid = __builtin_amdgcn_readfirstlane(tid >> 6), lane = tid & 63, wr = wid >> 2, wc = wid & 3, fr = lane & 15, fq = lane >> 4;
    const int K = g.K, nt = K / BK;
    unsigned voffA[2], voffB[2];
#pragma unroll
    for (int i = 0; i < 2; ++i) { int R, C; stage_rc(tid * 16 + i * 8192, R, C); const int Rb = Epi::PERM ? ((R & ~31) + perm32(R & 31)) : R;
        voffA[i] = (unsigned)(R * K + C) * 2u; voffB[i] = (unsigned)(Rb * K + C) * 2u; }
    const size_t kstep = (size_t)(BK * 2);
    const size_t hstep = (size_t)HALF * K * 2;
    const size_t tstep = 2 * hstep;
    const unsigned ldsw = (unsigned)wid * 1024u;
    const int aoff = lds_byte(wr * 64 + fr, fq * 8), boff = lds_byte(wc * 32 + fr, fq * 8);
#define PG8_SA(b, h) (((b) * 2 + (h)) * HTB)
#define PG8_SB(b, h) ((4 + (b) * 2 + (h)) * HTB)
#define PG8_STAGE(bufoff, gbase, voff) do { _Pragma("unroll") for (int _i = 0; _i < 2; ++_i) \
        __builtin_amdgcn_global_load_lds((const unsigned*)((const char*)(gbase) + (voff)[_i]), (PG8_LAS unsigned*)(lds + (bufoff) + ldsw + _i * 8192), 16, 0, 0); } while (0)
#define PG8_LDA(dst, b, h) do { _Pragma("unroll") for (int m = 0; m < 4; ++m) _Pragma("unroll") for (int k = 0; k < 2; ++k) dst[m][k] = *(const PG8_LAS bf16x8*)(lds + PG8_SA(b, h) + aoff + m * 2048 + k * 1024); } while (0)
#define PG8_LDB(dst, b, h) do { _Pragma("unroll") for (int n = 0; n < 2; ++n) _Pragma("unroll") for (int k = 0; k < 2; ++k) dst[n][k] = *(const PG8_LAS bf16x8*)(lds + PG8_SB(b, h) + boff + n * 2048 + k * 1024); } while (0)
#define PG8_MMA(ai, bj, At, Bt) do { __builtin_amdgcn_s_setprio(1); _Pragma("unroll") for (int m = 0; m < 4; ++m) _Pragma("unroll") for (int n = 0; n < 2; ++n) _Pragma("unroll") for (int k = 0; k < 2; ++k) \
        acc[ai][bj][m][n] = __builtin_amdgcn_mfma_f32_16x16x32_bf16(Bt[n][k], At[m][k], acc[ai][bj][m][n], 0, 0, 0); __builtin_amdgcn_s_setprio(0); } while (0)
#define PG8_WAIT_V(n) asm volatile("s_waitcnt vmcnt(" #n ")" ::: "memory")
#define PG8_WAIT_L(n) asm volatile("s_waitcnt lgkmcnt(" #n ")" ::: "memory")
#define PG8_BAR __builtin_amdgcn_s_barrier()
#define PG8_SCHED __builtin_amdgcn_sched_barrier(0)
    Unit cur, nxt; nxt.pm = 0; nxt.pn = 0; nxt.kc = -1; int ui = 0;
    if (!S.next(0, cur)) return;
    f32x4 acc[2][2][4][2];
#pragma unroll
    for (int a = 0; a < 2; ++a)
#pragma unroll
        for (int b = 0; b < 2; ++b)
#pragma unroll
            for (int m = 0; m < 4; ++m)
#pragma unroll
                for (int n = 0; n < 2; ++n) acc[a][b][m][n] = (f32x4){0.f, 0.f, 0.f, 0.f};
    bf16x8 At[4][2], B0[2][2], B1[2][2];
    const char* cA = (const char*)g.A + (size_t)cur.pm * tstep + (cur.kc < 0 ? 0 : cur.kc * 512); const char* cB = (const char*)g.Bt + (size_t)cur.pn * tstep + (cur.kc < 0 ? 0 : cur.kc * 512);
    S.a_ready(cur);
    if constexpr (SP2) {
        PG8_STAGE(PG8_SB(0, 0), cB, voffB); PG8_STAGE(PG8_SB(0, 1), cB + hstep, voffB); PG8_STAGE(PG8_SA(0, 0), cA, voffA); PG8_STAGE(PG8_SA(0, 1), cA + hstep, voffA);
        if (wr == 1) PG8_BAR;
        PG8_WAIT_V(2); PG8_BAR;
        PG8_STAGE(PG8_SB(1, 0), cB + kstep, voffB); PG8_STAGE(PG8_SA(1, 0), cA + kstep, voffA); PG8_STAGE(PG8_SB(1, 1), cB + hstep + kstep, voffB);
        PG8_WAIT_V(6); PG8_BAR;
    } else {
        PG8_STAGE(PG8_SB(0, 0), cB, voffB); PG8_STAGE(PG8_SA(0, 0), cA, voffA); PG8_STAGE(PG8_SB(0, 1), cB + hstep, voffB); PG8_STAGE(PG8_SA(0, 1), cA + hstep, voffA);
        if (wr == 1) PG8_BAR;
        PG8_WAIT_V(4); PG8_BAR;
        PG8_STAGE(PG8_SB(1, 0), cB + kstep, voffB); PG8_STAGE(PG8_SA(1, 0), cA + kstep, voffA); PG8_STAGE(PG8_SB(1, 1), cB + hstep + kstep, voffB);
        PG8_WAIT_V(6); PG8_BAR;
    }
    for (;;) {
        const bool has_next = S.next(ui + 1, nxt);
        const int nk0 = nxt.kc < 0 ? 0 : nxt.kc * 512;
        const char* nA = has_next ? (const char*)g.A + (size_t)nxt.pm * tstep + nk0 : cA; const char* nB = has_next ? (const char*)g.Bt + (size_t)nxt.pn * tstep + nk0 : cB;
        const int unt = cur.kc < 0 ? nt : 4;
        for (int t = 0; t < unt; t += 2) {
            const bool last = (t == unt - 2);
            const char* a1 = cA + (size_t)(t + 1) * kstep;
            const char* a2 = last ? nA : cA + (size_t)(t + 2) * kstep; const char* b2 = last ? nB : cB + (size_t)(t + 2) * kstep;
            const char* a3 = a2 + kstep; const char* b3 = b2 + kstep;
            if (last && has_next) S.a_ready(nxt);
            if constexpr (SP2) {
            PG8_LDB(B0, 0, 0); PG8_LDB(B1, 0, 1); PG8_SCHED; PG8_LDA(At, 0, 0); PG8_STAGE(PG8_SA(1, 1), a1 + hstep, voffA);
            PG8_WAIT_V(8); PG8_WAIT_L(0); PG8_BAR; PG8_MMA(0, 0, At, B0); PG8_MMA(0, 1, At, B1); PG8_BAR; PG8_SCHED;
            PG8_LDA(At, 0, 1); PG8_STAGE(PG8_SB(0, 0), b2, voffB); PG8_STAGE(PG8_SB(0, 1), b2 + hstep, voffB); PG8_STAGE(PG8_SA(0, 0), a2, voffA);
            PG8_WAIT_V(8); PG8_WAIT_L(0); PG8_BAR; PG8_MMA(1, 0, At, B0); PG8_MMA(1, 1, At, B1); PG8_BAR; PG8_SCHED;
            PG8_LDB(B0, 1, 0); PG8_LDB(B1, 1, 1); PG8_SCHED; PG8_LDA(At, 1, 0); PG8_STAGE(PG8_SA(0, 1), a2 + hstep, voffA);
            PG8_WAIT_V(8); PG8_WAIT_L(0); PG8_BAR; PG8_MMA(0, 0, At, B0); PG8_MMA(0, 1, At, B1); PG8_BAR; PG8_SCHED;
            PG8_LDA(At, 1, 1); PG8_STAGE(PG8_SB(1, 0), b3, voffB); PG8_STAGE(PG8_SB(1, 1), b3 + hstep, voffB); PG8_STAGE(PG8_SA(1, 0), a3, voffA);
            PG8_WAIT_V(8); PG8_WAIT_L(0); PG8_BAR; PG8_MMA(1, 0, At, B0); PG8_MMA(1, 1, At, B1); PG8_BAR; PG8_SCHED;
            } else {
            PG8_LDB(B0, 0, 0); PG8_SCHED; PG8_LDA(At, 0, 0); PG8_STAGE(PG8_SA(1, 1), a1 + hstep, voffA);
            PG8_WAIT_L(8); PG8_BAR; PG8_WAIT_L(0); PG8_MMA(0, 0, At, B0); PG8_BAR; PG8_SCHED;
            PG8_LDB(B1, 0, 1); PG8_STAGE(PG8_SB(0, 0), b2, voffB);
            PG8_BAR; PG8_WAIT_L(0); PG8_MMA(0, 1, At, B1); PG8_BAR;
            PG8_LDA(At, 0, 1); PG8_STAGE(PG8_SA(0, 0), a2, voffA);
            PG8_BAR; PG8_WAIT_L(0); PG8_MMA(1, 0, At, B0); PG8_BAR; PG8_SCHED;
            PG8_STAGE(PG8_SB(0, 1), b2 + hstep, voffB);
            PG8_WAIT_V(6); PG8_BAR; PG8_MMA(1, 1, At, B1); PG8_BAR;
            PG8_LDB(B0, 1, 0); PG8_SCHED; PG8_LDA(At, 1, 0); PG8_STAGE(PG8_SA(0, 1), a2 + hstep, voffA);
            PG8_WAIT_L(8); PG8_BAR; PG8_WAIT_L(0); PG8_MMA(0, 0, At, B0); PG8_BAR; PG8_SCHED;
            PG8_LDB(B1, 1, 1); PG8_STAGE(PG8_SB(1, 0), b3, voffB);
            PG8_BAR; PG8_WAIT_L(0); PG8_MMA(0, 1, At, B1); PG8_BAR;
            PG8_LDA(At, 1, 1); PG8_STAGE(PG8_SA(1, 0), a3, voffA);
            PG8_BAR; PG8_WAIT_L(0); PG8_MMA(1, 0, At, B0); PG8_BAR; PG8_SCHED;
            PG8_STAGE(PG8_SB(1, 1), b3 + hstep, voffB);
            PG8_WAIT_V(6); PG8_BAR; PG8_MMA(1, 1, At, B1); PG8_BAR;
            }
        }
        if constexpr (ALIGN_EPI) { if (wr == 0) PG8_BAR; }
        if constexpr (!Epi::AFTER_DRAIN) { E(acc, cur, wr, wc, fr, fq); S.done(cur); }
        if (!has_next) break;
#pragma unroll
        for (int a = 0; a < 2; ++a)
#pragma unroll
            for (int b = 0; b < 2; ++b)
#pragma unroll
                for (int m = 0; m < 4; ++m)
#pragma unroll
                    for (int n = 0; n < 2; ++n) acc[a][b][m][n] = (f32x4){0.f, 0.f, 0.f, 0.f};
        cur = nxt; cA = nA; cB = nB; ++ui;
        if constexpr (ALIGN_EPI) { if (wr == 1) PG8_BAR; }
    }
    PG8_WAIT_V(0);
    if constexpr (!ALIGN_EPI) { if (wr == 0) PG8_BAR; }
    PG8_BAR;
    if constexpr (Epi::AFTER_DRAIN) { E.fused(acc, cur, wr, wc, fr, fq, lds, wid, lane); S.done(cur); }
#undef PG8_SA
#undef PG8_SB
#undef PG8_STAGE
#undef PG8_LDA
#undef PG8_LDB
#undef PG8_MMA
#undef PG8_WAIT_V
#undef PG8_WAIT_L
#undef PG8_BAR
#undef PG8_SCHED
}
}

#define LAS __attribute__((address_space(3)))
typedef unsigned short bf16;
typedef float f32x4 __attribute__((ext_vector_type(4)));
typedef float f32x16 __attribute__((ext_vector_type(16)));
typedef short bf16x8 __attribute__((ext_vector_type(8)));
typedef unsigned u32x4 __attribute__((ext_vector_type(4)));
typedef unsigned u32x2 __attribute__((ext_vector_type(2)));
typedef float f32x2 __attribute__((ext_vector_type(2)));
using pg8::cvt_pk_bf16;

constexpr int NWAVES = 8, NTHREADS = 512;
constexpr int D = 1024, FF = 2816, NIN = 5632;
constexpr int MP = 16384;
constexpr int MS = 256;
constexpr int MO = MP + MS;
constexpr int MX = MO + 16;
constexpr int MPAD = 16896;
constexpr int LP = 4112;
constexpr int LC = 2064;
constexpr float EPS = 1e-6f;
constexpr float LOG2E = 1.4426950408889634f;
constexpr float QSCALE = 0.125f * LOG2E;
constexpr float SB_EXIT = 152.0f;

constexpr size_t O_YP = 0, O_YS = 16777216, O_PK = 17039360, O_PV = 25460736, O_PH = 33882112, O_SK = 34144256, O_SV = 34275328, O_SH = 34406400;
constexpr size_t WS_WGU1 = 0, WS_WD1 = 11534336, WS_WIN = 17301504, WS_WA = 28835840, WS_WB = 29884416, WS_WOUT = 30932992, WS_WGU2 = 33030144, WS_WD2 = 44564480;
constexpr size_t WS_SS = 50331648, SS_BYTES = (size_t)MPAD * 16 * 4;
constexpr size_t WS_XN = 54657024, WS_ACT = 89260032;
constexpr size_t WS_KKH = 184418304, WS_QB = 201719808, WS_QH = 219021312, WS_IVTP = 236322816, WS_IVTS = 253165568, WS_END = 253689856;
constexpr size_t WS_GA = WS_ACT, WS_GB = WS_ACT + 34603008, WS_SG = WS_ACT + 69206016;
constexpr int LDS_BYTES = 147456;
constexpr size_t WS_SLAB = 219021312;
constexpr size_t WS_CTL = 253689856, CTL_BYTES = 16384;
constexpr int LDS_BARST = 131072 + 64;

struct Args { const float* in[23]; float* out; unsigned char* ws; };
typedef const Args __attribute__((address_space(4)))* ArgsP;
__device__ __forceinline__ ArgsP argsp() { ArgsP p = (ArgsP)__builtin_amdgcn_kernarg_segment_ptr(); asm volatile("" : "+s"(p)); return p; }
enum { I_XP = 0, I_XS, I_CK, I_CV, I_ST, I_META, I_N1, I_WG1, I_WU1, I_WD1, I_NMIX, I_WIN, I_BG, I_LB, I_HGN, I_WA, I_WB, I_WOUT, I_N2, I_WG2, I_WU2, I_WD2, I_NF };

__device__ __forceinline__ float wave_sum(float v) {
#pragma unroll
    for (int o = 1; o < 64; o <<= 1) v += __shfl_xor(v, o);
    return v;
}
__device__ __forceinline__ float ex2(float x) { return __builtin_amdgcn_exp2f(x); }
__device__ __forceinline__ float lg2(float x) { return __builtin_amdgcn_logf(x); }
__device__ __forceinline__ float sigmoidf_(float x) { return 1.0f / (1.0f + ex2(-x * LOG2E)); }
__device__ __forceinline__ float rstd_from_ss(const float* ss, int r) {
    const f32x4* p = (const f32x4*)(ss + (size_t)r * 16);
    f32x4 a = p[0], b = p[1], c = p[2], d = p[3];
    float s = ((a.x + a.y) + (a.z + a.w)) + ((b.x + b.y) + (b.z + b.w)) + ((c.x + c.y) + (c.z + c.w)) + ((d.x + d.y) + (d.z + d.w));
    return rsqrtf(s * (1.0f / 1024.0f) + EPS);
}
__device__ __forceinline__ const float* xin_row(ArgsP A, int r) {
    if (r < MP) return A->in[I_XP] + (size_t)r * D;
    if (r < MO) return A->in[I_XS] + (size_t)(r - MP) * D;
    if (r < MX) return A->in[I_META] + (size_t)(r - MO) * D;
    return nullptr;
}

__device__ __forceinline__ void p0_transpose_item(const float* W, int K, int N, bf16* WT, int il, LAS float* scr, int item, int lane) {
    const int nblk = N / 32, kb = item / nblk, nb = item % nblk, k0 = 64 * kb, n0 = 32 * nb;
#pragma unroll 8
    for (int i = 0; i < 32; ++i) { const int kk = 2 * i + (lane >> 5); scr[kk * 33 + (lane & 31)] = W[(size_t)(k0 + kk) * N + n0 + (lane & 31)]; }
    asm volatile("s_waitcnt lgkmcnt(0)" ::: "memory");
    const int rbase = il == 0 ? n0 : ((n0 >> 7) * 256 + (n0 & 127) + (il == 2 ? 128 : 0));
    const int c = lane & 7;
#pragma unroll
    for (int j = 0; j < 4; ++j) { const int n = (lane >> 3) + 8 * j; const LAS float* s = scr + (8 * c) * 33 + n;
        u32x4 o; o.x = cvt_pk_bf16(s[0 * 33], s[1 * 33]); o.y = cvt_pk_bf16(s[2 * 33], s[3 * 33]); o.z = cvt_pk_bf16(s[4 * 33], s[5 * 33]); o.w = cvt_pk_bf16(s[6 * 33], s[7 * 33]);
        *(u32x4*)(WT + (size_t)(rbase + n) * K + k0 + 8 * c) = o; }
    asm volatile("s_waitcnt lgkmcnt(0)" ::: "memory");
}
__device__ __forceinline__ void p0_weights(ArgsP A, LAS unsigned char* lds, int wave, int lane, int gw, int NGW, bool late) {
    LAS float* scr = (LAS float*)(lds + wave * 16384);
    unsigned char* ws = A->ws;
    constexpr int I_GU = (D / 64) * (FF / 32), I_DN = (FF / 64) * (D / 32), I_IN = (D / 64) * (NIN / 32), I_BR = (512 / 64) * (D / 32), I_OU = (D / 64) * (D / 32);
    constexpr int N_EARLY = 2 * I_GU + I_DN + I_IN, N_LATE = 2 * I_BR + I_OU + 2 * I_GU + I_DN;
    if (!late) {
        for (int it = gw; it < N_EARLY; it += NGW) {
            int r = it;
            if (r < I_GU) { p0_transpose_item(A->in[I_WG1], D, FF, (bf16*)(ws + WS_WGU1), 1, scr, r, lane); continue; } r -= I_GU;
            if (r < I_GU) { p0_transpose_item(A->in[I_WU1], D, FF, (bf16*)(ws + WS_WGU1), 2, scr, r, lane); continue; } r -= I_GU;
            if (r < I_DN) { p0_transpose_item(A->in[I_WD1], FF, D, (bf16*)(ws + WS_WD1), 0, scr, r, lane); continue; } r -= I_DN;
            p0_transpose_item(A->in[I_WIN], D, NIN, (bf16*)(ws + WS_WIN), 0, scr, r, lane);
        }
    } else {
        for (int it = gw; it < N_LATE; it += NGW) {
            int r = it;
            if (r < I_BR) { p0_transpose_item(A->in[I_WA], 512, D, (bf16*)(ws + WS_WA), 0, scr, r, lane); continue; } r -= I_BR;
            if (r < I_BR) { p0_transpose_item(A->in[I_WB], 512, D, (bf16*)(ws + WS_WB), 0, scr, r, lane); continue; } r -= I_BR;
            if (r < I_OU) { p0_transpose_item(A->in[I_WOUT], D, D, (bf16*)(ws + WS_WOUT), 0, scr, r, lane); continue; } r -= I_OU;
            if (r < I_GU) { p0_transpose_item(A->in[I_WG2], D, FF, (bf16*)(ws + WS_WGU2), 1, scr, r, lane); continue; } r -= I_GU;
            if (r < I_GU) { p0_transpose_item(A->in[I_WU2], D, FF, (bf16*)(ws + WS_WGU2), 2, scr, r, lane); continue; } r -= I_GU;
            p0_transpose_item(A->in[I_WD2], FF, D, (bf16*)(ws + WS_WD2), 0, scr, r, lane);
        }
    }
}
__device__ __forceinline__ void p0_phase(ArgsP A, LAS unsigned char* lds, int wave, int lane) {
    const int G = gridDim.x, gw = blockIdx.x * NWAVES + wave, NGW = G * NWAVES;
    unsigned char* ws = A->ws;
    p0_weights(A, lds, wave, lane, gw, NGW, false);
    bf16* XN = (bf16*)(ws + WS_XN); float* SS0 = (float*)(ws + WS_SS);
    const f32x4* g1 = (const f32x4*)A->in[I_N1] + lane;
    for (int m = gw; m < MPAD; m += NGW) {
        const float* xr = xin_row(A, m);
        unsigned long long* o8 = (unsigned long long*)(XN + (size_t)m * D) + lane;
        float s = 0.f;
        if (xr) {
            const f32x4* x4 = (const f32x4*)xr + lane;
#pragma unroll
            for (int j = 0; j < 4; ++j) { f32x4 v = x4[64 * j]; const f32x4 g = g1[64 * j]; s += (v.x * v.x + v.y * v.y) + (v.z * v.z + v.w * v.w);
                o8[64 * j] = (unsigned long long)cvt_pk_bf16(v.x * g.x, v.y * g.y) | ((unsigned long long)cvt_pk_bf16(v.z * g.z, v.w * g.w) << 32); }
        } else {
#pragma unroll
            for (int j = 0; j < 4; ++j) o8[64 * j] = 0ull;
        }
        s = wave_sum(s);
        if (lane < 16) SS0[(size_t)m * 16 + lane] = lane == 0 ? s : 0.f;
    }
}

struct EpiSwiGLU {
    static constexpr bool PERM = true, AFTER_DRAIN = false;
    bf16* act; const float* ss;
    __device__ __forceinline__ void operator()(const f32x4 (&acc)[2][2][4][2], const pg8::Unit& u, int wr, int wc, int fr, int fq) const {
        const int col0 = u.pn * 128 + wc * 32 + 8 * fq;
#pragma unroll
        for (int ai = 0; ai < 2; ++ai)
#pragma unroll
            for (int m = 0; m < 4; ++m) {
                const int r = u.pm * 256 + ai * 128 + wr * 64 + m * 16 + fr;
                const float rs = rstd_from_ss(ss, r);
                float o[8];
#pragma unroll
                for (int n = 0; n < 2; ++n)
#pragma unroll
                    for (int e = 0; e < 4; ++e) { const float g = acc[ai][0][m][n][e] * rs, up = acc[ai][1][m][n][e] * rs; o[4 * n + e] = g * up / (1.0f + ex2(-g * LOG2E)); }
                u32x4 w; w.x = cvt_pk_bf16(o[0], o[1]); w.y = cvt_pk_bf16(o[2], o[3]); w.z = cvt_pk_bf16(o[4], o[5]); w.w = cvt_pk_bf16(o[6], o[7]);
                *(u32x4*)(act + (size_t)r * FF + col0) = w;
            }
    }
};
template <int SRC_INPUTS, int HALF_SCALE, int HAS_XN> struct EpiResid {
    static constexpr bool PERM = false, AFTER_DRAIN = false;
    const float* xp; const float* xs; const float* xm; float* X; bf16* XN; const float* gnext; float* ss; float* slab; int ntile, pm0;
    __device__ __forceinline__ void operator()(const f32x4 (&acc)[2][2][4][2], const pg8::Unit& u, int wr, int wc, int fr, int fq) const {
        const int col0 = u.pn * 256 + wc * 32 + 4 * fq;
        if (u.kc >= 0) {
            float* sl = slab + ((size_t)(u.kc * ntile + (u.pm - pm0)) * 256) * 1024;
#pragma unroll
            for (int ai = 0; ai < 2; ++ai)
#pragma unroll
                for (int m = 0; m < 4; ++m)
#pragma unroll
                    for (int bj = 0; bj < 2; ++bj)
#pragma unroll
                        for (int n = 0; n < 2; ++n) *(f32x4*)(sl + (size_t)(ai * 128 + wr * 64 + m * 16 + fr) * 1024 + col0 + bj * 128 + n * 16) = acc[ai][bj][m][n];
            return;
        }
#pragma unroll
        for (int ai = 0; ai < 2; ++ai)
#pragma unroll
            for (int m = 0; m < 4; ++m) {
                const int r = u.pm * 256 + ai * 128 + wr * 64 + m * 16 + fr;
                const float* srow = SRC_INPUTS ? (r < MP ? xp + (size_t)r * D : (r < MO ? xs + (size_t)(r - MP) * D : (r < MX ? xm + (size_t)(r - MO) * D : nullptr))) : (X + (size_t)r * D);
                float s = 0.f;
#pragma unroll
                for (int bj = 0; bj < 2; ++bj)
#pragma unroll
                    for (int n = 0; n < 2; ++n) {
                        const int c = col0 + bj * 128 + n * 16;
                        f32x4 v = acc[ai][bj][m][n] * (HALF_SCALE ? 0.5f : 1.0f);
                        if (srow) v += *(const f32x4*)(srow + c);
                        s += (v.x * v.x + v.y * v.y) + (v.z * v.z + v.w * v.w);
                        if (r < MO) *(f32x4*)(X + (size_t)r * D + c) = v;
                        if (HAS_XN) { const f32x4 g = *(const f32x4*)(gnext + c); u32x2 w; w.x = cvt_pk_bf16(v.x * g.x, v.y * g.y); w.y = cvt_pk_bf16(v.z * g.z, v.w * g.w); *(u32x2*)(XN + (size_t)r * D + c) = w; }
                    }
                s += __shfl_xor(s, 16); s += __shfl_xor(s, 32);
                if (fq == 0) ss[(size_t)r * 16 + u.pn * 4 + wc] = s;
            }
    }
};
template <int SRC_INPUTS, int HALF_SCALE, int HAS_XN> __device__ __forceinline__ void resid_finish(const float* xp, const float* xs, const float* xm, float* X, bf16* XN, const float* gnext, float* ss,
                                                                                                   const float* slab, int nkc, int ntile, int nrows, int gw, int ngw, int lane) {
    for (int rr = gw; rr < nrows; rr += ngw) { const int r = MP + rr;
        const float* srow = SRC_INPUTS ? (r < MO ? xs + (size_t)(r - MP) * D : xm + (size_t)(r - MO) * D) : (X + (size_t)r * D);
        float s = 0.f;
#pragma unroll
        for (int j = 0; j < 4; ++j) { const int c = 4 * lane + 256 * j; f32x4 a = {0.f, 0.f, 0.f, 0.f};
            for (int kc = 0; kc < nkc; ++kc) a += *(const f32x4*)(slab + ((size_t)kc * ntile * 256 + rr) * 1024 + c);
            f32x4 v = a * (HALF_SCALE ? 0.5f : 1.0f) + *(const f32x4*)(srow + c);
            s += (v.x * v.x + v.y * v.y) + (v.z * v.z + v.w * v.w);
            if (r < MO) *(f32x4*)(X + (size_t)r * D + c) = v;
            if (HAS_XN) { const f32x4 g = *(const f32x4*)(gnext + c); u32x2 w; w.x = cvt_pk_bf16(v.x * g.x, v.y * g.y); w.y = cvt_pk_bf16(v.z * g.z, v.w * g.w); *(u32x2*)(XN + (size_t)r * D + c) = w; } }
        s = wave_sum(s);
        if (lane < 16) ss[(size_t)r * 16 + lane] = lane == 0 ? s : 0.f; }
}
struct EpiWin {
    static constexpr bool PERM = false, AFTER_DRAIN = false;
    unsigned char* ws; float* out; const float* lbp; const float* bgp; const float* ss;
    template <int TYPE> __device__ __forceinline__ void run(const f32x4 (&acc)[2][2][4][2], const pg8::Unit& u, int wr, int wc, int fr, int fq, int cbase) const {
        const int col0 = u.pn * 256 + wc * 32 + 4 * fq - cbase;
#pragma unroll
        for (int ai = 0; ai < 2; ++ai)
#pragma unroll
            for (int m = 0; m < 4; ++m) {
                const int r = u.pm * 256 + ai * 128 + wr * 64 + m * 16 + fr;
                const int rlim = (TYPE == 0 || TYPE >= 6) ? MO : MX;
                if (r < rlim) {
                const float rs = rstd_from_ss(ss, r);
#pragma unroll
                for (int bj = 0; bj < 2; ++bj)
#pragma unroll
                    for (int n = 0; n < 2; ++n) {
                        const int cc = col0 + bj * 128 + n * 16;
                        const f32x4 v = acc[ai][bj][m][n] * rs;
                        if (TYPE == 0) {
                            u32x2 w; w.x = cvt_pk_bf16(v.x * QSCALE, v.y * QSCALE); w.y = cvt_pk_bf16(v.z * QSCALE, v.w * QSCALE); *(u32x2*)((bf16*)(ws + WS_QB) + (size_t)r * 512 + cc) = w;
                        } else if (TYPE == 1 || TYPE == 2) {
                            const size_t ob = TYPE == 2 ? O_PV : O_PK, os = TYPE == 2 ? O_SV : O_SK;
                            if (r < MP) { const int b = r >> 12, t = r & 4095; *(f32x4*)(out + ob + ((size_t)(b * LP + 16 + t)) * 512 + cc) = v; }
                            else if (r < MO) { *(f32x4*)(out + os + (size_t)(r - MP) * 512 + cc) = v; }
                            else { const int mm = r - MO;
#pragma unroll
                                for (int b = 0; b < 4; ++b) *(f32x4*)(out + ob + ((size_t)(b * LP + mm)) * 512 + cc) = v; }
                        } else if (TYPE == 3) {
                            const f32x4 l0 = *(const f32x4*)(lbp + cc), l1 = *(const f32x4*)(lbp + 512 + cc);
                            _Float16 h[4];
#pragma unroll
                            for (int e = 0; e < 4; ++e) { const float oml = 1.0f / (1.0f + ex2((l1[e] - l0[e]) * LOG2E));
                                h[e] = (_Float16)(oml / (1.0f + ex2(v[e] * LOG2E))); }
                            u32x2 w; w.x = (unsigned)__builtin_bit_cast(unsigned short, h[0]) | ((unsigned)__builtin_bit_cast(unsigned short, h[1]) << 16);
                            w.y = (unsigned)__builtin_bit_cast(unsigned short, h[2]) | ((unsigned)__builtin_bit_cast(unsigned short, h[3]) << 16);
                            *(u32x2*)((unsigned short*)(ws + WS_KKH) + (size_t)r * 512 + cc) = w;
                        } else if (TYPE == 4) {
                            const int h = cc >> 7, vv = cc & 127;
                            const unsigned w01 = cvt_pk_bf16(v.x, v.y), w23 = cvt_pk_bf16(v.z, v.w);
                            const bf16 e0 = (bf16)(w01 & 0xffffu), e1 = (bf16)(w01 >> 16), e2 = (bf16)(w23 & 0xffffu), e3 = (bf16)(w23 >> 16);
                            if (r < MP) { const int b = r >> 12, t = r & 4095; bf16* p = (bf16*)(ws + WS_IVTP) + ((size_t)((b * 4 + h) * 128 + vv)) * LP + 16 + t; p[0] = e0; p[LP] = e1; p[2 * LP] = e2; p[3 * LP] = e3; }
                            else if (r < MO) { const int s = (r - MP) >> 5, t = (r - MP) & 31; bf16* p = (bf16*)(ws + WS_IVTS) + ((size_t)((s * 4 + h) * 128 + vv)) * 64 + t; p[0] = e0; p[64] = e1; p[128] = e2; p[192] = e3; }
                            else { const int mm = r - MO;
#pragma unroll
                                for (int b = 0; b < 4; ++b) { bf16* p = (bf16*)(ws + WS_IVTP) + ((size_t)((b * 4 + h) * 128 + vv)) * LP + mm; p[0] = e0; p[LP] = e1; p[2 * LP] = e2; p[3 * LP] = e3; } }
                        } else if (TYPE == 5) {
                            u32x2 w; w.x = cvt_pk_bf16(v.x, v.y); w.y = cvt_pk_bf16(v.z, v.w); *(u32x2*)((bf16*)(ws + WS_QH) + (size_t)r * 512 + cc) = w;
                        } else if (TYPE == 6) {
                            float o[4];
#pragma unroll
                            for (int e = 0; e < 4; ++e) o[e] = v[e] / (1.0f + ex2(-v[e] * LOG2E));
                            u32x2 w; w.x = cvt_pk_bf16(o[0], o[1]); w.y = cvt_pk_bf16(o[2], o[3]); *(u32x2*)((bf16*)(ws + WS_SG) + (size_t)r * 512 + cc) = w;
                        } else {
                            const f32x4 bg = *(const f32x4*)(bgp + (TYPE == 8 ? 1024 : 0) + cc); float o[4];
#pragma unroll
                            for (int e = 0; e < 4; ++e) o[e] = 1.0f / (1.0f + ex2(-(v[e] + bg[e]) * LOG2E));
                            u32x2 w; w.x = cvt_pk_bf16(o[0], o[1]); w.y = cvt_pk_bf16(o[2], o[3]); *(u32x2*)((bf16*)(ws + (TYPE == 8 ? WS_GB : WS_GA)) + (size_t)r * D + cc) = w;
                        }
                    }
                }
            }
    }
    __device__ __forceinline__ void operator()(const f32x4 (&acc)[2][2][4][2], const pg8::Unit& u, int wr, int wc, int fr, int fq) const {
        const int pn = u.pn;
        if (pn < 2) run<0>(acc, u, wr, wc, fr, fq, 0);
        else if (pn < 4) run<1>(acc, u, wr, wc, fr, fq, 512);
        else if (pn < 6) run<2>(acc, u, wr, wc, fr, fq, 1024);
        else if (pn < 8) run<3>(acc, u, wr, wc, fr, fq, 1536);
        else if (pn < 10) run<4>(acc, u, wr, wc, fr, fq, 2048);
        else if (pn < 12) run<5>(acc, u, wr, wc, fr, fq, 2560);
        else if (pn < 14) run<6>(acc, u, wr, wc, fr, fq, 3072);
        else if (pn < 18) run<7>(acc, u, wr, wc, fr, fq, 3584);
        else run<8>(acc, u, wr, wc, fr, fq, 4608);
    }
};
__device__ __forceinline__ float bf2f(unsigned short h) { return __builtin_bit_cast(float, (unsigned)h << 16); }
template <int PASS> struct EpiMerge {
    static constexpr bool PERM = false, AFTER_DRAIN = false;
    bf16* ga; const bf16* gb;
    __device__ __forceinline__ void operator()(const f32x4 (&acc)[2][2][4][2], const pg8::Unit& u, int wr, int wc, int fr, int fq) const {
        const int col0 = u.pn * 256 + wc * 32 + 4 * fq;
#pragma unroll
        for (int ai = 0; ai < 2; ++ai)
#pragma unroll
            for (int m = 0; m < 4; ++m) {
                const int r = u.pm * 256 + ai * 128 + wr * 64 + m * 16 + fr;
#pragma unroll
                for (int bj = 0; bj < 2; ++bj)
#pragma unroll
                    for (int n = 0; n < 2; ++n) {
                        const int c = col0 + bj * 128 + n * 16;
                        const f32x4 v = acc[ai][bj][m][n];
                        u32x2* pa = (u32x2*)(ga + (size_t)r * D + c);
                        const u32x2 wa = *pa;
                        const float a0 = bf2f(wa.x & 0xffffu), a1 = bf2f(wa.x >> 16), a2 = bf2f(wa.y & 0xffffu), a3 = bf2f(wa.y >> 16);
                        float o0, o1, o2, o3;
                        if (PASS == 0) { o0 = a0 * v.x; o1 = a1 * v.y; o2 = a2 * v.z; o3 = a3 * v.w; }
                        else { const u32x2 wb = *(const u32x2*)(gb + (size_t)r * D + c);
                            o0 = a0 + bf2f(wb.x & 0xffffu) * v.x; o1 = a1 + bf2f(wb.x >> 16) * v.y; o2 = a2 + bf2f(wb.y & 0xffffu) * v.z; o3 = a3 + bf2f(wb.y >> 16) * v.w; }
                        u32x2 w; w.x = cvt_pk_bf16(o0, o1); w.y = cvt_pk_bf16(o2, o3); *pa = w;
                    }
            }
    }
};

__device__ __forceinline__ bf16x8 pack8(const float* f) { u32x4 w; w.x = cvt_pk_bf16(f[0], f[1]); w.y = cvt_pk_bf16(f[2], f[3]); w.z = cvt_pk_bf16(f[4], f[5]); w.w = cvt_pk_bf16(f[6], f[7]); return __builtin_bit_cast(bf16x8, w); }
template <bool WRITE> __device__ __forceinline__ void attn_item(ArgsP A, int item, int lane) {
    const float* kdiag; const float* vdiag; const float* klow; const float* vlow; int qrow0, posq0, nblk, h;
    if (item < 4096) { const int b = item >> 10; h = (item >> 7) & 7; const int qt = item & 127;
        qrow0 = b * 4096 + 32 * qt; posq0 = 16 + 32 * qt; nblk = qt + 2;
        klow = A->out + O_PK + (size_t)b * LP * 512 + h * 64; vlow = A->out + O_PV + (size_t)b * LP * 512 + h * 64;
        kdiag = klow + (size_t)posq0 * 512; vdiag = vlow + (size_t)posq0 * 512;
    } else { const int id = item - 4096, s = id >> 3; h = id & 7;
        qrow0 = MP + 32 * s; posq0 = LC; nblk = 66;
        klow = A->in[I_CK] + (size_t)s * LC * 512 + h * 64; vlow = A->in[I_CV] + (size_t)s * LC * 512 + h * 64;
        kdiag = A->out + O_SK + (size_t)s * 32 * 512 + h * 64; vdiag = A->out + O_SV + (size_t)s * 32 * 512 + h * 64;
    }
    bf16* qo = (bf16*)(A->ws + WS_QB) + (size_t)qrow0 * 512 + h * 64;
    const int ql = lane & 31, hi = lane >> 5;
    bf16x8 qf[4];
#pragma unroll
    for (int s = 0; s < 4; ++s) qf[s] = *(const bf16x8*)(qo + (size_t)ql * 512 + 16 * s + 8 * hi);
    const int rA = (ql & 3) + 4 * (ql >> 3), hA = (ql >> 2) & 1, kappaA = 8 * hA + rA + (rA >= 8 ? 8 : 0);
    f32x16 o0, o1;
#pragma unroll
    for (int r = 0; r < 16; ++r) { o0[r] = 0.f; o1[r] = 0.f; }
    float R = 0.f;
    for (int j = 0; j < nblk; ++j) {
        const int pos0 = posq0 - 32 * j;
        const float* kb = j == 0 ? kdiag : klow; const float* vb = j == 0 ? vdiag : vlow;
        const int rb = j == 0 ? 0 : pos0;
        int rowA = rb + kappaA; rowA = rowA < 0 ? 0 : rowA;
        const float* kp = kb + (size_t)rowA * 512 + 8 * hi;
        f32x16 sacc;
#pragma unroll
        for (int r = 0; r < 16; ++r) sacc[r] = 0.f;
        f32x4 kv[8];
#pragma unroll
        for (int s = 0; s < 4; ++s) { kv[2 * s] = *(const f32x4*)(kp + 16 * s); kv[2 * s + 1] = *(const f32x4*)(kp + 16 * s + 4); }
        float vv[2][2][8];
#pragma unroll
        for (int st = 0; st < 2; ++st)
#pragma unroll
            for (int i = 0; i < 8; ++i) { int row = rb + 16 * st + 8 * hi + i; row = row < 0 ? 0 : row; const float* vp = vb + (size_t)row * 512 + ql; vv[st][0][i] = vp[0]; vv[st][1][i] = vp[32]; }
#pragma unroll
        for (int s = 0; s < 4; ++s) { float kk[8] = {kv[2 * s].x, kv[2 * s].y, kv[2 * s].z, kv[2 * s].w, kv[2 * s + 1].x, kv[2 * s + 1].y, kv[2 * s + 1].z, kv[2 * s + 1].w};
            sacc = __builtin_amdgcn_mfma_f32_32x32x16_bf16(pack8(kk), qf[s], sacc, 0, 0, 0); }
        float sp[16];
#pragma unroll
        for (int r = 0; r < 16; ++r) { const int kappa = 8 * hi + r + (r >= 8 ? 8 : 0);
            const bool valid = (pos0 + kappa >= 0) && (j > 0 || kappa < ql);
            const float z = sacc[r];
            const float s_ = fmaxf(z, 0.f) + lg2(1.0f + ex2(-fabsf(z)));
            sp[r] = valid ? s_ : 0.f; sacc[r] = valid ? z : -1e30f; }
        float glo = 0.f, ghi = 0.f;
#pragma unroll
        for (int r = 0; r < 8; ++r) { glo += sp[r]; ghi += sp[8 + r]; }
        const float pglo = __shfl_xor(glo, 32), pghi = __shfl_xor(ghi, 32);
        const float base_hi = R + (hi == 0 ? pghi : 0.f);
        const float base_lo = R + ghi + pghi + (hi == 0 ? pglo : 0.f);
        float pa[16];
        { float c = base_hi;
#pragma unroll
          for (int r = 15; r >= 8; --r) { c += sp[r]; pa[r] = ex2(sacc[r] - c); }
          c = base_lo;
#pragma unroll
          for (int r = 7; r >= 0; --r) { c += sp[r]; pa[r] = ex2(sacc[r] - c); } }
        R += (glo + ghi) + (pglo + pghi);
        const bf16x8 p0 = pack8(pa), p1 = pack8(pa + 8);
        o0 = __builtin_amdgcn_mfma_f32_32x32x16_bf16(pack8(vv[0][0]), p0, o0, 0, 0, 0);
        o1 = __builtin_amdgcn_mfma_f32_32x32x16_bf16(pack8(vv[0][1]), p0, o1, 0, 0, 0);
        o0 = __builtin_amdgcn_mfma_f32_32x32x16_bf16(pack8(vv[1][0]), p1, o0, 0, 0, 0);
        o1 = __builtin_amdgcn_mfma_f32_32x32x16_bf16(pack8(vv[1][1]), p1, o1, 0, 0, 0);
        if (__all(R > SB_EXIT)) break;
    }
    if (!WRITE) { if (o0[0] + o1[5] != 12345.678f) return; }
#pragma unroll
    for (int g = 0; g < 4; ++g) {
        u32x2 w; w.x = cvt_pk_bf16(o0[4 * g], o0[4 * g + 1]); w.y = cvt_pk_bf16(o0[4 * g + 2], o0[4 * g + 3]);
        *(u32x2*)(qo + (size_t)ql * 512 + 8 * g + 4 * hi) = w;
        u32x2 w1; w1.x = cvt_pk_bf16(o1[4 * g], o1[4 * g + 1]); w1.y = cvt_pk_bf16(o1[4 * g + 2], o1[4 * g + 3]);
        *(u32x2*)(qo + (size_t)ql * 512 + 32 + 8 * g + 4 * hi) = w1;
    }
}

constexpr int HQ_P = 136, HT_P = 72, HS_P = 72;
constexpr int IMG_KHT = 0, IMG_SC = 128 * HT_P * 2, IMG_DV = IMG_SC + 64 * HS_P * 2, IMG_BYTES = IMG_DV + 512;
constexpr int NPREP = 16 * 65 + 32;
constexpr size_t WS_IMG = WS_XN;
constexpr size_t WS_ORAW = WS_WGU1;
static_assert((size_t)NPREP * IMG_BYTES <= 34603008, "image region");
constexpr int LP_QT = 0, LP_KT = LP_QT + 64 * HQ_P * 2, LP_PART = LP_KT + 64 * HQ_P * 2, LP_END = LP_PART + 8 * 128 * 4;
__device__ __forceinline__ void hgrn_chunk_params(bool prompt, int sidx, int c, int& row0, int& nvalid, int& pos0) {
    if (prompt) { if (c == 0) { row0 = MO; nvalid = 16; pos0 = 0; } else { row0 = sidx * 4096 + 64 * (c - 1); nvalid = 64; pos0 = 16 + 64 * (c - 1); } }
    else { row0 = MP + 32 * sidx; nvalid = 32; pos0 = 0; }
}
template <bool WRITE> __device__ __forceinline__ void hgrn_prep(ArgsP A, LAS unsigned char* lds, int item, int tid) {
    const int lane = tid & 63, w = __builtin_amdgcn_readfirstlane(tid >> 6), l16 = lane & 15, g = lane >> 4;
    const bool prompt = item < 1040; const int bh = prompt ? item / 65 : item - 1040, c = prompt ? item % 65 : 0, sidx = bh >> 2, h = bh & 3;
    int row0, nvalid, pos0; hgrn_chunk_params(prompt, sidx, c, row0, nvalid, pos0);
    LAS bf16* Qt = (LAS bf16*)(lds + LP_QT); LAS bf16* Kt = (LAS bf16*)(lds + LP_KT); LAS float* part = (LAS float*)(lds + LP_PART);
    unsigned char* img = A->ws + WS_IMG + (size_t)item * IMG_BYTES;
    const unsigned short* kkh = (const unsigned short*)(A->ws + WS_KKH); bf16* qh = (bf16*)(A->ws + WS_QH);
    const int kp = lane, tg = w;
    float kk[8][2], qv[8][2], cb[8][2]; float run0 = 0.f, run1 = 0.f;
#pragma unroll
    for (int i = 0; i < 8; ++i) { const int t = 8 * tg + i;
        if (t < nvalid) { const size_t off = (size_t)(row0 + t) * 512 + h * 128 + 2 * kp; const unsigned k2 = *(const unsigned*)(kkh + off), q2 = *(const unsigned*)(qh + off);
            kk[i][0] = (float)__builtin_bit_cast(_Float16, (unsigned short)(k2 & 0xffffu)); kk[i][1] = (float)__builtin_bit_cast(_Float16, (unsigned short)(k2 >> 16));
            qv[i][0] = bf2f((unsigned short)(q2 & 0xffffu)); qv[i][1] = bf2f((unsigned short)(q2 >> 16)); }
        else { kk[i][0] = 0.f; kk[i][1] = 0.f; qv[i][0] = 0.f; qv[i][1] = 0.f; } }
#pragma unroll
    for (int i = 0; i < 8; ++i) { run0 += lg2(1.0f - kk[i][0]); run1 += lg2(1.0f - kk[i][1]); cb[i][0] = run0; cb[i][1] = run1; }
    *(LAS f32x2*)(part + tg * 128 + 2 * kp) = (f32x2){run0, run1};
    __syncthreads();
    float off0 = 0.f, off1 = 0.f, tot0 = 0.f, tot1 = 0.f;
#pragma unroll
    for (int q = 0; q < 8; ++q) { const f32x2 p = *(const LAS f32x2*)(part + q * 128 + 2 * kp); if (q < tg) { off0 += p.x; off1 += p.y; } tot0 += p.x; tot1 += p.y; }
    if (WRITE && tg == 0) *(f32x2*)(img + IMG_DV + 8 * kp) = (f32x2){ex2(tot0), ex2(tot1)};
    float kh0[8], kh1[8];
#pragma unroll
    for (int i = 0; i < 8; ++i) { const int t = 8 * tg + i; const float b0 = off0 + cb[i][0], b1 = off1 + cb[i][1];
        const unsigned qq = cvt_pk_bf16(qv[i][0] * ex2(b0), qv[i][1] * ex2(b1)), kq = cvt_pk_bf16(kk[i][0] * ex2(-b0), kk[i][1] * ex2(-b1));
        *(LAS unsigned*)(Qt + t * HQ_P + 2 * kp) = qq; *(LAS unsigned*)(Kt + t * HQ_P + 2 * kp) = kq;
        if (WRITE && t < nvalid) *(unsigned*)(qh + (size_t)(row0 + t) * 512 + h * 128 + 2 * kp) = qq;
        kh0[i] = kk[i][0] * ex2(tot0 - b0); kh1[i] = kk[i][1] * ex2(tot1 - b1); }
    if (WRITE) { *(bf16x8*)(img + IMG_KHT + ((2 * kp) * HT_P + 8 * tg) * 2) = pack8(kh0);
    *(bf16x8*)(img + IMG_KHT + ((2 * kp + 1) * HT_P + 8 * tg) * 2) = pack8(kh1); }
    else if (kh0[0] + kh1[7] == 12345.678f) part[0] = kh0[1];
    __syncthreads();
    bf16* sci = (bf16*)(img + IMG_SC);
#pragma unroll
    for (int q = 0; q < 2; ++q) { const int id = 2 * w + q, mt = id >> 2, nt = id & 3;
        f32x4 sc = {0.f, 0.f, 0.f, 0.f};
        if (mt >= nt) {
#pragma unroll
            for (int ks = 0; ks < 4; ++ks) { const bf16x8 a = *(const LAS bf16x8*)(Qt + (16 * mt + l16) * HQ_P + 32 * ks + 8 * g), b = *(const LAS bf16x8*)(Kt + (16 * nt + l16) * HQ_P + 32 * ks + 8 * g);
                sc = __builtin_amdgcn_mfma_f32_16x16x32_bf16(a, b, sc, 0, 0, 0); }
        }
#pragma unroll
        for (int j = 0; j < 4; ++j) { const int t = 16 * mt + 4 * g + j, s_ = 16 * nt + l16; const float v = (t >= s_) ? sc[j] : 0.f;
            if (WRITE || v == 12345.678f) sci[t * HS_P + s_] = (bf16)(cvt_pk_bf16(v, 0.f) & 0xffffu); }
    }
    __syncthreads();
}
constexpr int LS_QT = 0, LS_SG = LS_QT + 64 * HQ_P * 2, LS_IMG = LS_SG + 64 * HQ_P * 2, LS_BUF = LS_IMG + IMG_BYTES, LS_SSQ = 2 * LS_BUF, LS_END = LS_SSQ + 2 * 2048;
static_assert(LS_END <= 131072 && (LS_BUF % 16) == 0, "hgrn scan lds");
#define WG_BAR() do { asm volatile("s_waitcnt lgkmcnt(0)" ::: "memory"); __builtin_amdgcn_s_barrier(); asm volatile("" ::: "memory"); } while (0)
template <bool WRITE> __device__ __forceinline__ void hgrn_scan(ArgsP A, LAS unsigned char* lds, int item, int tid) {
    const int lane = tid & 63, w = __builtin_amdgcn_readfirstlane(tid >> 6), l16 = lane & 15, g = lane >> 4;
    const bool prompt = item < 16; const int sidx = prompt ? (item >> 2) : ((item - 16) >> 2), h = item & 3;
    const int nchunk = prompt ? 65 : 1;
    const bf16* qh = (const bf16*)(A->ws + WS_QH); bf16* oraw = (bf16*)(A->ws + WS_ORAW);
    const unsigned char* imgb = A->ws + WS_IMG + (size_t)(prompt ? (sidx * 4 + h) * 65 : 1040 + (sidx * 4 + h)) * IMG_BYTES;
    const int vcol = 16 * w + l16;
    const bf16* ivtb = prompt ? ((const bf16*)(A->ws + WS_IVTP) + ((size_t)((sidx * 4 + h) * 128 + vcol)) * LP) : ((const bf16*)(A->ws + WS_IVTS) + ((size_t)((sidx * 4 + h) * 128 + vcol)) * 64);
    const float gn = A->in[I_HGN][h * 128 + vcol];
    f32x4 S[8];
    if (prompt) {
#pragma unroll
        for (int mt = 0; mt < 8; ++mt) S[mt] = (f32x4){0.f, 0.f, 0.f, 0.f};
    } else {
        const float* st = A->in[I_ST] + (size_t)(sidx * 4 + h) * 16384;
#pragma unroll
        for (int mt = 0; mt < 8; ++mt)
#pragma unroll
            for (int j = 0; j < 4; ++j) S[mt][j] = st[(size_t)(16 * mt + 4 * g + j) * 128 + vcol];
    }
    const int prow = tid >> 4, pseg = tid & 15;
    const unsigned qoff = (unsigned)(prow * (HQ_P * 2) + pseg * 16);
    const u32x4 Z4 = {0u, 0u, 0u, 0u};
    u32x4 X[8], Y[8];
#define HG_ISSUE(SET, cidx) do { int c_ = (cidx); c_ = c_ < nchunk ? c_ : nchunk - 1; int row0_, nv_, pos0_; hgrn_chunk_params(prompt, sidx, c_, row0_, nv_, pos0_); \
        const size_t go_ = (size_t)(row0_ + prow) * 512 + h * 128 + pseg * 8; \
        _Pragma("unroll") for (int i_ = 0; i_ < 2; ++i_) { const unsigned m_ = (prow + 32 * i_ < nv_) ? 0xffffffffu : 0u; SET[i_] = *(const u32x4*)(qh + go_ + (size_t)i_ * 32 * 512) & m_; } \
        const unsigned char* im_ = imgb + (size_t)c_ * IMG_BYTES + tid * 16; \
        _Pragma("unroll") for (int i_ = 0; i_ < 4; ++i_) SET[4 + i_] = *(const u32x4*)(im_ + 8192 * i_); } while (0)
#define HG_BIV(DST, cidx) do { int c_ = (cidx); c_ = c_ < nchunk ? c_ : nchunk - 1; int row0_, nv_, pos0_; hgrn_chunk_params(prompt, sidx, c_, row0_, nv_, pos0_); \
        _Pragma("unroll") for (int s_ = 0; s_ < 2; ++s_) { const unsigned m_ = (32 * s_ + 8 * g < nv_) ? 0xffffffffu : 0u; DST[s_] = *(const u32x4*)(ivtb + pos0_ + 32 * s_ + 8 * g) & m_; } } while (0)
#define HG_COMMIT(SET, boff) do { LAS unsigned char* b_ = lds + (boff); \
        _Pragma("unroll") for (int i_ = 0; i_ < 2; ++i_) { *(LAS u32x4*)(b_ + LS_QT + qoff + i_ * 32 * HQ_P * 2) = SET[i_]; } \
        _Pragma("unroll") for (int i_ = 0; i_ < 4; ++i_) { if (tid + 512 * i_ < IMG_BYTES / 16) *(LAS u32x4*)(b_ + LS_IMG + tid * 16 + 8192 * i_) = SET[4 + i_]; } } while (0)
#define HG_COMPUTE(cidx, boff, bivc) do { const int c_ = (cidx); int row0_, nv_, pos0_; hgrn_chunk_params(prompt, sidx, c_, row0_, nv_, pos0_); const bool wr_ = !(prompt && c_ == 0); \
        LAS unsigned char* b_ = lds + (boff); const LAS bf16* Qt = (const LAS bf16*)(b_ + LS_QT); const LAS bf16* Sg = (const LAS bf16*)(b_ + LS_SG); \
        const LAS bf16* KhT = (const LAS bf16*)(b_ + LS_IMG + IMG_KHT); const LAS bf16* Sc = (const LAS bf16*)(b_ + LS_IMG + IMG_SC); const LAS float* dv = (const LAS float*)(b_ + LS_IMG + IMG_DV); \
        LAS float* ssq = (LAS float*)(lds + LS_SSQ + (c_ & 1) * 2048); \
        bf16x8 bs[4]; \
        _Pragma("unroll") for (int ks = 0; ks < 4; ++ks) { u32x4 t_; t_.x = cvt_pk_bf16(S[2 * ks][0], S[2 * ks][1]); t_.y = cvt_pk_bf16(S[2 * ks][2], S[2 * ks][3]); t_.z = cvt_pk_bf16(S[2 * ks + 1][0], S[2 * ks + 1][1]); t_.w = cvt_pk_bf16(S[2 * ks + 1][2], S[2 * ks + 1][3]); bs[ks] = __builtin_bit_cast(bf16x8, t_); } \
        const bf16x8 biv0 = __builtin_bit_cast(bf16x8, bivc[0]), biv1 = __builtin_bit_cast(bf16x8, bivc[1]); \
        f32x4 o[4]; \
          \
        _Pragma("unroll") for (int gp = 0; gp < 2; ++gp) { bf16x8 fa[12]; \
            _Pragma("unroll") for (int m2 = 0; m2 < 2; ++m2) { const int mt = 2 * gp + m2; \
                fa[6 * m2 + 0] = *(const LAS bf16x8*)(Sc + (16 * mt + l16) * HS_P + 8 * g); fa[6 * m2 + 1] = *(const LAS bf16x8*)(Sc + (16 * mt + l16) * HS_P + 32 + 8 * g); \
                _Pragma("unroll") for (int ks = 0; ks < 4; ++ks) { const u32x2 lo_ = *(const LAS u32x2*)(Qt + (16 * mt + l16) * HQ_P + 32 * ks + 4 * g), hi_ = *(const LAS u32x2*)(Qt + (16 * mt + l16) * HQ_P + 32 * ks + 16 + 4 * g); \
                    u32x4 t_; t_.x = lo_.x; t_.y = lo_.y; t_.z = hi_.x; t_.w = hi_.y; fa[6 * m2 + 2 + ks] = __builtin_bit_cast(bf16x8, t_); } } \
            __builtin_amdgcn_sched_barrier(0); \
            f32x4 a0 = {0.f, 0.f, 0.f, 0.f}, a1 = {0.f, 0.f, 0.f, 0.f}; \
            a0 = __builtin_amdgcn_mfma_f32_16x16x32_bf16(fa[0], biv0, a0, 0, 0, 0); a1 = __builtin_amdgcn_mfma_f32_16x16x32_bf16(fa[6], biv0, a1, 0, 0, 0); \
            a0 = __builtin_amdgcn_mfma_f32_16x16x32_bf16(fa[1], biv1, a0, 0, 0, 0); a1 = __builtin_amdgcn_mfma_f32_16x16x32_bf16(fa[7], biv1, a1, 0, 0, 0); \
            _Pragma("unroll") for (int ks = 0; ks < 4; ++ks) { a0 = __builtin_amdgcn_mfma_f32_16x16x32_bf16(fa[2 + ks], bs[ks], a0, 0, 0, 0); a1 = __builtin_amdgcn_mfma_f32_16x16x32_bf16(fa[8 + ks], bs[ks], a1, 0, 0, 0); } \
            o[2 * gp] = a0; o[2 * gp + 1] = a1; \
            __builtin_amdgcn_sched_barrier(0); } \
        _Pragma("unroll") for (int gp = 0; gp < 2; ++gp) { bf16x8 fk[8]; f32x4 d4[4]; \
            _Pragma("unroll") for (int m4 = 0; m4 < 4; ++m4) { const int mt = 4 * gp + m4; d4[m4] = *(const LAS f32x4*)(dv + 16 * mt + 4 * g); \
                fk[2 * m4] = *(const LAS bf16x8*)(KhT + (16 * mt + l16) * HT_P + 8 * g); fk[2 * m4 + 1] = *(const LAS bf16x8*)(KhT + (16 * mt + l16) * HT_P + 32 + 8 * g); } \
            __builtin_amdgcn_sched_barrier(0); \
            f32x4 a_[4]; \
            _Pragma("unroll") for (int m4 = 0; m4 < 4; ++m4) a_[m4] = S[4 * gp + m4] * d4[m4]; \
            _Pragma("unroll") for (int m4 = 0; m4 < 4; ++m4) a_[m4] = __builtin_amdgcn_mfma_f32_16x16x32_bf16(fk[2 * m4], biv0, a_[m4], 0, 0, 0); \
            _Pragma("unroll") for (int m4 = 0; m4 < 4; ++m4) a_[m4] = __builtin_amdgcn_mfma_f32_16x16x32_bf16(fk[2 * m4 + 1], biv1, a_[m4], 0, 0, 0); \
            _Pragma("unroll") for (int m4 = 0; m4 < 4; ++m4) S[4 * gp + m4] = a_[m4]; \
            __builtin_amdgcn_sched_barrier(0); } \
        if (wr_) { _Pragma("unroll") for (int mt = 0; mt < 4; ++mt) _Pragma("unroll") for (int j = 0; j < 4; ++j) { const int t = 16 * mt + 4 * g + j; \
            if (t < nv_) oraw[(size_t)(row0_ + t) * 512 + h * 128 + vcol] = (bf16)(cvt_pk_bf16(o[mt][j], 0.f) & 0xffffu); } } \
        WG_BAR(); } while (0)
    u32x4 bivA[2], bivB[2];
    HG_ISSUE(X, 0); HG_BIV(bivA, 0); HG_ISSUE(Y, 1); HG_BIV(bivB, 1);
    HG_COMMIT(X, 0);
    HG_ISSUE(X, 2);
    WG_BAR();
    for (int c = 0; c < nchunk; c += 2) {
        if (c + 1 < nchunk) HG_COMMIT(Y, LS_BUF);
        HG_ISSUE(Y, c + 3);
        HG_COMPUTE(c, 0, bivA);
        HG_BIV(bivA, c + 2);
        if (c + 1 < nchunk) {
            if (c + 2 < nchunk) HG_COMMIT(X, 0);
            HG_ISSUE(X, c + 4);
            HG_COMPUTE(c + 1, LS_BUF, bivB);
            HG_BIV(bivB, c + 3);
        }
    }
#undef HG_ISSUE
#undef HG_BIV
#undef HG_COMMIT
#undef HG_COMPUTE
    float* so = A->out + (prompt ? O_PH : O_SH) + (size_t)(sidx * 4 + h) * 16384;
#pragma unroll
    for (int mt = 0; mt < 8; ++mt)
#pragma unroll
        for (int j = 0; j < 4; ++j) so[(size_t)(16 * mt + 4 * g + j) * 128 + vcol] = S[mt][j];
    WG_BAR();
}

__device__ __forceinline__ void hgrn_finalize(ArgsP A, int gw, int ngw, int lane) {
    const bf16* oraw = (const bf16*)(A->ws + WS_ORAW); bf16* sg = (bf16*)(A->ws + WS_SG); const float* gnp = A->in[I_HGN];
    for (int it = gw; it < MO * 4; it += ngw) { const int row = it >> 2, h = it & 3; const size_t off = (size_t)row * 512 + h * 128 + 2 * lane;
        const unsigned ow = *(const unsigned*)(oraw + off), sw = *(const unsigned*)(sg + off);
        const float o0 = bf2f((unsigned short)(ow & 0xffffu)), o1 = bf2f((unsigned short)(ow >> 16));
        const float tot = wave_sum(o0 * o0 + o1 * o1);
        const float rs = rsqrtf(tot * (1.0f / 128.0f) + EPS);
        const f32x2 gn = *(const f32x2*)(gnp + h * 128 + 2 * lane);
        *(unsigned*)(sg + off) = cvt_pk_bf16(o0 * rs * gn.x * bf2f((unsigned short)(sw & 0xffffu)), o1 * rs * gn.y * bf2f((unsigned short)(sw >> 16))); }
}

#define XB_TMO      128
#define XB_XCNT(j)  (256  + 64 * (j))
#define XB_XSUB(j)  (1280 + 64 * (j))
#define XB_XGEN(j)  (2304 + 64 * (j))
#define XB_TOP      3328
#define XB_TOPGEN   3392
#define XCD_BAR_WORDS 3456
#define XB_SPIN_CAP (1u << 18)

__device__ __forceinline__ unsigned xb_ld(unsigned* p)              { return __hip_atomic_load(p, __ATOMIC_RELAXED, __HIP_MEMORY_SCOPE_AGENT); }
__device__ __forceinline__ unsigned xb_add(unsigned* p, unsigned v) { return __hip_atomic_fetch_add(p, v, __ATOMIC_RELAXED, __HIP_MEMORY_SCOPE_AGENT); }
__device__ __forceinline__ unsigned xb_xcc_id() { return (unsigned)__builtin_amdgcn_s_getreg((3 << 11) | 20) & 0xFu; }
#define XB_SPIN(cond, bar) do { unsigned _sp = 0; while (cond) { __builtin_amdgcn_s_sleep(1); \
    if ((++_sp & 255u) == 0u) { if (xb_ld(&(bar)[XB_TMO])) break; if (_sp > XB_SPIN_CAP) { atomicAdd(&(bar)[XB_TMO], 1u); break; } } } } while (0)

struct XcdBarrier {
    unsigned* bar; unsigned x;
    volatile LAS unsigned* st;
};

__device__ __forceinline__ XcdBarrier xcd_barrier_post(unsigned* bar, volatile LAS unsigned* st) {
    XcdBarrier b; b.bar = bar; b.x = xb_xcc_id(); b.st = st;
    if (threadIdx.x == 0) (void)xb_add(&bar[XB_XCNT(b.x)], 1u);
    return b;
}
__device__ __forceinline__ void xcd_barrier_complete(unsigned* bar, unsigned x, unsigned& nloc, unsigned& nx) {
    const unsigned G = gridDim.x * gridDim.y * gridDim.z;
    unsigned sum, cnt, mine, sp = 0u;
    for (;;) {
        sum = 0u; cnt = 0u; mine = 0u;
#pragma unroll
        for (unsigned j = 0; j < 16; ++j) { const unsigned c = xb_ld(&bar[XB_XCNT(j)]); sum += c; cnt += (c > 0u) ? 1u : 0u; mine = (j == x) ? c : mine; }
        if (sum == G) break;
        __builtin_amdgcn_s_sleep(1);
        if ((++sp & 255u) == 0u) { if (xb_ld(&bar[XB_TMO])) break; if (sp > XB_SPIN_CAP) { atomicAdd(&bar[XB_TMO], 1u); break; } }
    }
    nloc = mine > 0u ? mine : 1u; nx = cnt > 0u ? cnt : 1u;
}

__device__ __forceinline__ void xcd_barrier(const XcdBarrier& b) {
    asm volatile("s_waitcnt vmcnt(0)" ::: "memory");
    __syncthreads();
    if (threadIdx.x == 0) {
        unsigned* bar = b.bar;
        __builtin_amdgcn_s_waitcnt(0);
        unsigned nloc = b.st[0], nx = b.st[1];
        if (nloc == 0u) { xcd_barrier_complete(bar, b.x, nloc, nx); b.st[0] = nloc; b.st[1] = nx; }
        const unsigned old = xb_add(&bar[XB_XSUB(b.x)], 1u);
        const unsigned gen = old / nloc;
        if (old + 1u == (gen + 1u) * nloc) {
            __builtin_amdgcn_fence(__ATOMIC_RELEASE, "agent");
            asm volatile("s_waitcnt vmcnt(0)" ::: "memory");
            const unsigned og = xb_add(&bar[XB_TOP], 1u);
            const unsigned tg = og / nx;
            if (og + 1u == (tg + 1u) * nx) xb_add(&bar[XB_TOPGEN], 1u);
            else XB_SPIN(xb_ld(&bar[XB_TOPGEN]) == tg, bar);
            __builtin_amdgcn_fence(__ATOMIC_ACQUIRE, "agent");
            xb_add(&bar[XB_XGEN(b.x)], 1u);
            asm volatile("s_waitcnt vmcnt(0)" ::: "memory");
        } else {
            XB_SPIN(xb_ld(&bar[XB_XGEN(b.x)]) == gen, bar);
            __builtin_amdgcn_fence(__ATOMIC_ACQUIRE, "agent");
            asm volatile("s_waitcnt vmcnt(0)" ::: "memory");
        }
    }
    __syncthreads();
}

__global__ void __launch_bounds__(NTHREADS, 2) mega_fwd(Args Aunused) {
    extern __shared__ __attribute__((aligned(16))) unsigned char lds_raw[];
    LAS unsigned char* lds = (LAS unsigned char*)lds_raw;
    cg::grid_group grid = cg::this_grid();
#define GRID_SYNC_CG() do { asm volatile("s_waitcnt vmcnt(0)" ::: "memory"); grid.sync(); \
        if (threadIdx.x < 64) { __builtin_amdgcn_fence(__ATOMIC_ACQUIRE, "agent"); asm volatile("s_waitcnt vmcnt(0)" ::: "memory"); } __syncthreads(); } while (0)
#define GRID_SYNC() xcd_barrier(xbar)
    if (threadIdx.x < 2) ((volatile LAS unsigned*)(lds + LDS_BARST))[threadIdx.x] = 0u;
    __syncthreads();
    const XcdBarrier xbar = xcd_barrier_post((unsigned*)(argsp()->ws + WS_CTL), (volatile LAS unsigned*)(lds + LDS_BARST));
#define TIDL ({ int t_ = threadIdx.x; asm volatile("" : "+v"(t_)); t_; })
#define LANE (tid & 63)
#define WAVE (__builtin_amdgcn_readfirstlane(tid >> 6))
#define GX ((int)gridDim.x)
#define BX ((int)blockIdx.x)
#define SSP(A, i) ((float*)((A)->ws + WS_SS + (size_t)(i) * SS_BYTES))

#ifndef REP_P0
#define REP_P0 1
#endif
#ifndef REP_P1
#define REP_P1 1
#endif
#ifndef REP_P2
#define REP_P2 1
#endif
#ifndef REP_SYNC
#define REP_SYNC 0
#endif
    for (int rep = 0; rep < REP_P0; ++rep) {
    { const int tid = TIDL; p0_phase(argsp(), lds, WAVE, LANE); }
    if (argsp()->out == nullptr) GRID_SYNC_CG();
    GRID_SYNC();
    }
    for (int rep = 0; rep < REP_SYNC; ++rep) GRID_SYNC();
    for (int rep = 0; rep < REP_P1; ++rep) {
    { ArgsP A = argsp(); unsigned char* ws = A->ws; pg8::Gemm g{(const bf16*)(ws + WS_XN), (const bf16*)(ws + WS_WGU1), MPAD, 2 * FF, D}; pg8::StaticOrder S; S.init(MPAD, 2 * FF, GX, BX); EpiSwiGLU E{(bf16*)(ws + WS_ACT), SSP(A, 0)};
      pg8::gemm_phase<EpiSwiGLU, pg8::StaticOrder, true, true>(lds, g, S, E); }
    GRID_SYNC();
    }
    for (int rep = 0; rep < REP_P2; ++rep) {
    { ArgsP A = argsp(); unsigned char* ws = A->ws; pg8::Gemm g{(const bf16*)(ws + WS_ACT), (const bf16*)(ws + WS_WD1), MPAD, D, FF}; pg8::TailOrder S; S.init(MP, D, GX, BX, 2, 11);
      EpiResid<1, 1, 1> E{A->in[I_XP], A->in[I_XS], A->in[I_META], A->out, (bf16*)(ws + WS_XN), A->in[I_NMIX], SSP(A, 1), (float*)(ws + WS_SLAB), 2, 64};
      pg8::gemm_phase<EpiResid<1, 1, 1>, pg8::TailOrder, true, true>(lds, g, S, E); }
    GRID_SYNC();
    { const int tid = TIDL; ArgsP A = argsp(); unsigned char* ws = A->ws;
      resid_finish<1, 1, 1>(A->in[I_XP], A->in[I_XS], A->in[I_META], A->out, (bf16*)(ws + WS_XN), A->in[I_NMIX], SSP(A, 1), (const float*)(ws + WS_SLAB), 11, 2, 272, BX * NWAVES + WAVE, GX * NWAVES, LANE); }
    GRID_SYNC();
    }
#ifndef REP_P3
#define REP_P3 1
#endif
#ifndef REP_P34
#define REP_P34 1
#endif
    for (int rep34 = 0; rep34 < REP_P34; ++rep34) {
    for (int rep3 = 0; rep3 < REP_P3; ++rep3) {
    { ArgsP A = argsp(); unsigned char* ws = A->ws; pg8::Gemm g{(const bf16*)(ws + WS_XN), (const bf16*)(ws + WS_WIN), MPAD, NIN, D}; pg8::StaticOrder S; S.init(MPAD, NIN, GX, BX); EpiWin E{ws, A->out, A->in[I_LB], A->in[I_BG], SSP(A, 1)};
      pg8::gemm_phase<EpiWin, pg8::StaticOrder, true, true>(lds, g, S, E); }
    GRID_SYNC();
    }
#ifdef REP_PREP
    { const int tid = TIDL; for (int it = BX; it < NPREP; it += GX) hgrn_prep<false>(argsp(), lds, it, tid); }
#endif
    { const int tid = TIDL; for (int it = BX; it < NPREP; it += GX) hgrn_prep<true>(argsp(), lds, it, tid); }
    GRID_SYNC();
    {
        const int G = GX, bx = BX; const int tid = TIDL;
        const int abase = G > 48 ? 48 : 0, na = G - abase;
#ifdef REP_SCAN
        for (int it = bx; it < 48; it += G) hgrn_scan<false>(argsp(), lds, it, tid);
#endif
        for (int it = bx; it < 48; it += G) hgrn_scan<true>(argsp(), lds, it, tid);
#ifdef REP_ATT
        if (bx >= abase) for (int it = (bx - abase) * NWAVES + WAVE; it < 4160; it += na * NWAVES) attn_item<false>(argsp(), it, LANE);
#endif
        if (bx >= abase) { for (int it = (bx - abase) * NWAVES + WAVE; it < 4160; it += na * NWAVES) attn_item<true>(argsp(), it, LANE);
            p0_weights(argsp(), lds, WAVE, LANE, (bx - abase) * NWAVES + WAVE, na * NWAVES, true); }
    }
    GRID_SYNC();
    { const int tid = TIDL; hgrn_finalize(argsp(), BX * NWAVES + WAVE, GX * NWAVES, LANE); }
    GRID_SYNC();
    }
    { ArgsP A = argsp(); unsigned char* ws = A->ws; pg8::Gemm g{(const bf16*)(ws + WS_QB), (const bf16*)(ws + WS_WA), MO, D, 512}; pg8::StaticOrder S; S.init(MO, D, GX, BX); EpiMerge<0> E{(bf16*)(ws + WS_GA), (const bf16*)(ws + WS_GB)};
      pg8::gemm_phase<EpiMerge<0>, pg8::StaticOrder, true, true>(lds, g, S, E); }
    __threadfence(); __syncthreads();
    { ArgsP A = argsp(); unsigned char* ws = A->ws; pg8::Gemm g{(const bf16*)(ws + WS_SG), (const bf16*)(ws + WS_WB), MO, D, 512}; pg8::StaticOrder S; S.init(MO, D, GX, BX); EpiMerge<1> E{(bf16*)(ws + WS_GA), (const bf16*)(ws + WS_GB)};
      pg8::gemm_phase<EpiMerge<1>, pg8::StaticOrder, true, true>(lds, g, S, E); }
    GRID_SYNC();
    { ArgsP A = argsp(); unsigned char* ws = A->ws; pg8::Gemm g{(const bf16*)(ws + WS_GA), (const bf16*)(ws + WS_WOUT), MO, D, D}; pg8::StaticOrder S; S.init(MO, D, GX, BX);
      EpiResid<0, 0, 1> E{nullptr, nullptr, nullptr, A->out, (bf16*)(ws + WS_XN), A->in[I_N2], SSP(A, 2), nullptr, 0, 0};
      pg8::gemm_phase<EpiResid<0, 0, 1>, pg8::StaticOrder, true, true>(lds, g, S, E); }
    GRID_SYNC();
#ifndef REP_P7
#define REP_P7 1
#endif
    for (int rep = 0; rep < REP_P7; ++rep) {
    { ArgsP A = argsp(); unsigned char* ws = A->ws; pg8::Gemm g{(const bf16*)(ws + WS_XN), (const bf16*)(ws + WS_WGU2), MO, 2 * FF, D}; pg8::StaticOrder S; S.init(MO, 2 * FF, GX, BX); EpiSwiGLU E{(bf16*)(ws + WS_ACT), SSP(A, 2)};
      pg8::gemm_phase<EpiSwiGLU, pg8::StaticOrder, true, true>(lds, g, S, E); }
    GRID_SYNC();
    }
    { ArgsP A = argsp(); unsigned char* ws = A->ws; pg8::Gemm g{(const bf16*)(ws + WS_ACT), (const bf16*)(ws + WS_WD2), MO, D, FF}; pg8::TailOrder S; S.init(MP, D, GX, BX, 1, 11);
      EpiResid<0, 1, 0> E{nullptr, nullptr, nullptr, A->out, nullptr, nullptr, SSP(A, 3), (float*)(ws + WS_SLAB), 1, 64};
      pg8::gemm_phase<EpiResid<0, 1, 0>, pg8::TailOrder, true, true>(lds, g, S, E); }
    GRID_SYNC();
    { const int tid = TIDL; ArgsP A = argsp(); unsigned char* ws = A->ws;
      resid_finish<0, 1, 0>(nullptr, nullptr, nullptr, A->out, nullptr, nullptr, SSP(A, 3), (const float*)(ws + WS_SLAB), 11, 1, 256, BX * NWAVES + WAVE, GX * NWAVES, LANE); }
    GRID_SYNC();
    {
        const int tid = TIDL; ArgsP A = argsp(); float* X = A->out; const float* SS3 = SSP(A, 3);
        const int gw = BX * NWAVES + WAVE, NGW = GX * NWAVES; const f32x4* gf = (const f32x4*)A->in[I_NF] + LANE;
        for (int m = gw; m < MO; m += NGW) { const float rs = rstd_from_ss(SS3, m); f32x4* x4 = (f32x4*)(X + (size_t)m * D) + LANE;
#pragma unroll
            for (int j = 0; j < 4; ++j) { f32x4 v = x4[64 * j]; const f32x4 gg = gf[64 * j]; x4[64 * j] = v * rs * gg; } }
    }
}

extern "C" void kernel_launch(void* const* d_in, const int* in_sizes, int n_in, void* d_out, int out_size, void* d_ws, size_t ws_size, hipStream_t stream) {
    static int grid = 0;
    if (grid == 0) {
        if (n_in != 23 || ws_size < WS_CTL + CTL_BYTES || out_size != 34930688) { fprintf(stderr, "kernel_launch: unexpected problem shape (n_in %d, out %d, ws %zu)\n", n_in, out_size, ws_size); grid = -1; return; }
        int dev = 0, cus = 0, per_cu = 0;
        hipGetDevice(&dev); hipDeviceGetAttribute(&cus, hipDeviceAttributeMultiprocessorCount, dev);
        hipFuncSetAttribute((const void*)mega_fwd, hipFuncAttributeMaxDynamicSharedMemorySize, LDS_BYTES);
        hipOccupancyMaxActiveBlocksPerMultiprocessor(&per_cu, (const void*)mega_fwd, NTHREADS, LDS_BYTES);
        if (per_cu < 1) { fprintf(stderr, "kernel_launch: occupancy query returned %d\n", per_cu); per_cu = 1; }
        (void)hipGetLastError();
        grid = cus * per_cu;
    }
    if (grid < 0) return;
    if (hipMemsetAsync((char*)d_ws + WS_CTL, 0, CTL_BYTES, stream) != hipSuccess) { fprintf(stderr, "kernel_launch: memset of barrier words failed\n"); return; }
    Args a{};
    for (int i = 0; i < 23; ++i) a.in[i] = (const float*)d_in[i];
    a.out = (float*)d_out; a.ws = (unsigned char*)d_ws;
    void* args[] = {&a};
    hipError_t e = hipLaunchCooperativeKernel((const void*)mega_fwd, dim3(grid), dim3(NTHREADS), args, LDS_BYTES, stream);
    if (e != hipSuccess) fprintf(stderr, "cooperative launch failed: %s (grid %d)\n", hipGetErrorString(e), grid);
}
```

```cpp
#include <hip/hip_runtime.h>
#include <hip/hip_cooperative_groups.h>
#include <cstdio>
#include <cstdint>
namespace cg = cooperative_groups;
namespace pg8 {
#define PG8_LAS __attribute__((address_space(3)))
typedef unsigned short bf16_t;
typedef short bf16x8 __attribute__((ext_vector_type(8)));
typedef float f32x4 __attribute__((ext_vector_type(4)));
typedef unsigned u32x4 __attribute__((ext_vector_type(4)));
constexpr int BM = 256, BK = 64, HALF = 128, HTB = HALF * BK * 2  , STAGE_BYTES = 8 * HTB, NXCD = 8, WGM = 8;

__host__ __device__ __forceinline__ int lds_byte(int r, int c) { const int st = (r >> 4) * 2 + (c >> 5), rr = r & 15, cc = c & 31, ob = rr * 64 + cc * 2; return st * 1024 + (ob ^ (((ob >> 9) & 1) << 5)); }
__host__ __device__ __forceinline__ void stage_rc(int b, int& R, int& C) { const int st = b / 1024, sb = b % 1024, swz = sb ^ (((sb >> 9) & 1) << 5); R = (st >> 1) * 16 + swz / 64; C = (st & 1) * 32 + (swz % 64) / 2; }
__host__ __device__ __forceinline__ int perm32(int rho) { const int n = rho >> 4, i = rho & 15; return 8 * (i >> 2) + 4 * n + (i & 3); }

struct Unit { int pm, pn, kc; };
struct Gemm { const bf16_t* A; const bf16_t* Bt; int M, N, K; long adelta, bdelta; int ksplit, ntk; };

struct StaticOrder {
    int nM, nN, nwg, G, c;
    __host__ __device__ void init(int M, int N, int G_, int c_) { nM = M / BM; nN = N / BM; nwg = nM * nN; G = G_; c = c_; }
    __host__ __device__ bool next(int i, Unit& u) const {
        const long L = (long)i * G + c; if (L >= nwg) return false;
        int wgid = (int)L; { const int q = nwg / NXCD, r = nwg % NXCD, xcd = wgid % NXCD, off = wgid / NXCD; wgid = (xcd < r ? xcd * (q + 1) : r * (q + 1) + (xcd - r) * q) + off; }
        const int nig = WGM * nN, gid = wgid / nig, fm = gid * WGM, gsz = (nM - fm) < WGM ? (nM - fm) : WGM;
        u.pm = fm + ((wgid % nig) % gsz); u.pn = (wgid % nig) / gsz; u.kc = -1; return true;
    }
    __device__ __forceinline__ void a_ready(const Unit&) const {}
    __device__ __forceinline__ void done(const Unit&) const {}
};

__device__ __forceinline__ unsigned cvt_pk_bf16(float lo, float hi) { unsigned r; asm volatile("v_cvt_pk_bf16_f32 %0, %1, %2" : "=v"(r) : "v"(lo), "v"(hi)); return r; }
struct TailOrder {
    StaticOrder so; int nmini, nkc, G, c;
    __host__ __device__ void init(int Mmain, int N, int G_, int c_, int nextra, int nkc_) { so.init(Mmain, N, G_, c_); G = G_; c = c_; nkc = nkc_; nmini = nextra * so.nN * nkc_; }
    __host__ __device__ bool next(int i, Unit& u) const {
        const int cm = c < so.nwg ? (so.nwg - c + G - 1) / G : 0; if (i < cm) return so.next(i, u);
        const int j = (i - cm) * G + c; if (j >= nmini) return false;
        u.kc = j % nkc; u.pn = (j / nkc) % so.nN; u.pm = so.nM + j / (nkc * so.nN); return true; }
    __device__ __forceinline__ void a_ready(const Unit&) const {}
    __device__ __forceinline__ void done(const Unit&) const {}
};
template <class Epi, class Sched, bool ALIGN_EPI = false, bool SP2 = false>
__device__ __forceinline__ void gemm_phase(PG8_LAS unsigned char* lds, const Gemm g, const Sched S, const Epi E) {
    int tid_l = threadIdx.x; asm volatile("" : "+v"(tid_l)); const int tid = tid_l, wid = __builtin_amdgcn_readfirstlane(tid >> 6), lane = tid & 63, wr = wid >> 2, wc = wid & 3, fr = lane & 15, fq = lane >> 4;
    const int K = g.K, nt = g.ntk ? g.ntk : K / BK, ks = g.ksplit ? g.ksplit : 0x7fffffff;
    unsigned voffA[2], voffB[2];
#pragma unroll
    for (int i = 0; i < 2; ++i) { int R, C; stage_rc(tid * 16 + i * 8192, R, C); const int Rb = Epi::PERM ? ((R & ~31) + perm32(R & 31)) : R;
        voffA[i] = (unsigned)(R * K + C) * 2u; voffB[i] = (unsigned)(Rb * K + C) * 2u; }
    const size_t kstep = (size_t)(BK * 2);
    const size_t hstep = (size_t)HALF * K * 2;
    const size_t tstep = 2 * hstep;
    const unsigned ldsw = (unsigned)wid * 1024u;
    const int aoff = lds_byte(wr * 64 + fr, fq * 8), boff = lds_byte(wc * 32 + fr, fq * 8);
#define PG8_SA(b, h) (((b) * 2 + (h)) * HTB)
#define PG8_SB(b, h) ((4 + (b) * 2 + (h)) * HTB)
#define PG8_STAGE(bufoff, gbase, voff) do { _Pragma("unroll") for (int _i = 0; _i < 2; ++_i) \
        __builtin_amdgcn_global_load_lds((const unsigned*)((const char*)(gbase) + (voff)[_i]), (PG8_LAS unsigned*)(lds + (bufoff) + ldsw + _i * 8192), 16, 0, 0); } while (0)
#define PG8_LDA(dst, b, h) do { _Pragma("unroll") for (int m = 0; m < 4; ++m) _Pragma("unroll") for (int k = 0; k < 2; ++k) dst[m][k] = *(const PG8_LAS bf16x8*)(lds + PG8_SA(b, h) + aoff + m * 2048 + k * 1024); } while (0)
#define PG8_LDB(dst, b, h) do { _Pragma("unroll") for (int n = 0; n < 2; ++n) _Pragma("unroll") for (int k = 0; k < 2; ++k) dst[n][k] = *(const PG8_LAS bf16x8*)(lds + PG8_SB(b, h) + boff + n * 2048 + k * 1024); } while (0)
#define PG8_MMA(ai, bj, At, Bt) do { __builtin_amdgcn_s_setprio(1); _Pragma("unroll") for (int m = 0; m < 4; ++m) _Pragma("unroll") for (int n = 0; n < 2; ++n) _Pragma("unroll") for (int k = 0; k < 2; ++k) \
        acc[ai][bj][m][n] = __builtin_amdgcn_mfma_f32_16x16x32_bf16(Bt[n][k], At[m][k], acc[ai][bj][m][n], 0, 0, 0); __builtin_amdgcn_s_setprio(0); } while (0)
#define PG8_WAIT_V(n) asm volatile("s_waitcnt vmcnt(" #n ")" ::: "memory")
#define PG8_WAIT_L(n) asm volatile("s_waitcnt lgkmcnt(" #n ")" ::: "memory")
#define PG8_BAR __builtin_amdgcn_s_barrier()
#define PG8_SCHED __builtin_amdgcn_sched_barrier(0)
    Unit cur, nxt; nxt.pm = 0; nxt.pn = 0; nxt.kc = -1; int ui = 0;
    if (!S.next(0, cur)) return;
    f32x4 acc[2][2][4][2];
#pragma unroll
    for (int a = 0; a < 2; ++a)
#pragma unroll
        for (int b = 0; b < 2; ++b)
#pragma unroll
            for (int m = 0; m < 4; ++m)
#pragma unroll
                for (int n = 0; n < 2; ++n) acc[a][b][m][n] = (f32x4){0.f, 0.f, 0.f, 0.f};
    bf16x8 At[4][2], B0[2][2], B1[2][2];
    const char* cA = (const char*)g.A + (size_t)cur.pm * tstep + (cur.kc < 0 ? 0 : cur.kc * 512); const char* cB = (const char*)g.Bt + (size_t)cur.pn * tstep + (cur.kc < 0 ? 0 : cur.kc * 512);
    S.a_ready(cur);
    if constexpr (SP2) {
        PG8_STAGE(PG8_SB(0, 0), cB, voffB); PG8_STAGE(PG8_SB(0, 1), cB + hstep, voffB); PG8_STAGE(PG8_SA(0, 0), cA, voffA); PG8_STAGE(PG8_SA(0, 1), cA + hstep, voffA);
        if (wr == 1) PG8_BAR;
        PG8_WAIT_V(2); PG8_BAR;
        PG8_STAGE(PG8_SB(1, 0), cB + kstep, voffB); PG8_STAGE(PG8_SA(1, 0), cA + kstep, voffA); PG8_STAGE(PG8_SB(1, 1), cB + hstep + kstep, voffB);
        PG8_WAIT_V(6); PG8_BAR;
    } else {
        PG8_STAGE(PG8_SB(0, 0), cB, voffB); PG8_STAGE(PG8_SA(0, 0), cA, voffA); PG8_STAGE(PG8_SB(0, 1), cB + hstep, voffB); PG8_STAGE(PG8_SA(0, 1), cA + hstep, voffA);
        if (wr == 1) PG8_BAR;
        PG8_WAIT_V(4); PG8_BAR;
        PG8_STAGE(PG8_SB(1, 0), cB + kstep, voffB); PG8_STAGE(PG8_SA(1, 0), cA + kstep, voffA); PG8_STAGE(PG8_SB(1, 1), cB + hstep + kstep, voffB);
        PG8_WAIT_V(6); PG8_BAR;
    }
    for (;;) {
        const bool has_next = S.next(ui + 1, nxt);
        const int nk0 = nxt.kc < 0 ? 0 : nxt.kc * 512;
        const char* nA = has_next ? (const char*)g.A + (size_t)nxt.pm * tstep + nk0 : cA; const char* nB = has_next ? (const char*)g.Bt + (size_t)nxt.pn * tstep + nk0 : cB;
        const int unt = cur.kc < 0 ? nt : 4;
        for (int t = 0; t < unt; t += 2) {
            const bool last = (t == unt - 2);
            if constexpr (Epi::HAS_MID) { if (t == ks) E.mid(acc, cur, wr, wc, fr, fq); }
            const char* a1 = cA + (size_t)(t + 1) * kstep + (t + 1 >= ks ? g.adelta : 0);
            const char* a2 = last ? nA : cA + (size_t)(t + 2) * kstep + (t + 2 >= ks ? g.adelta : 0); const char* b2 = last ? nB : cB + (size_t)(t + 2) * kstep + (t + 2 >= ks ? g.bdelta : 0);
            const char* a3 = a2 + kstep; const char* b3 = b2 + kstep;
            if (last && has_next) S.a_ready(nxt);
            if constexpr (SP2) {
            PG8_LDB(B0, 0, 0); PG8_LDB(B1, 0, 1); PG8_SCHED; PG8_LDA(At, 0, 0); PG8_STAGE(PG8_SA(1, 1), a1 + hstep, voffA);
            PG8_WAIT_V(8); PG8_WAIT_L(0); PG8_BAR; PG8_MMA(0, 0, At, B0); PG8_MMA(0, 1, At, B1); PG8_BAR; PG8_SCHED;
            PG8_LDA(At, 0, 1); PG8_STAGE(PG8_SB(0, 0), b2, voffB); PG8_STAGE(PG8_SB(0, 1), b2 + hstep, voffB); PG8_STAGE(PG8_SA(0, 0), a2, voffA);
            PG8_WAIT_V(8); PG8_WAIT_L(0); PG8_BAR; PG8_MMA(1, 0, At, B0); PG8_MMA(1, 1, At, B1); PG8_BAR; PG8_SCHED;
            PG8_LDB(B0, 1, 0); PG8_LDB(B1, 1, 1); PG8_SCHED; PG8_LDA(At, 1, 0); PG8_STAGE(PG8_SA(0, 1), a2 + hstep, voffA);
            PG8_WAIT_V(8); PG8_WAIT_L(0); PG8_BAR; PG8_MMA(0, 0, At, B0); PG8_MMA(0, 1, At, B1); PG8_BAR; PG8_SCHED;
            PG8_LDA(At, 1, 1); PG8_STAGE(PG8_SB(1, 0), b3, voffB); PG8_STAGE(PG8_SB(1, 1), b3 + hstep, voffB); PG8_STAGE(PG8_SA(1, 0), a3, voffA);
            PG8_WAIT_V(8); PG8_WAIT_L(0); PG8_BAR; PG8_MMA(1, 0, At, B0); PG8_MMA(1, 1, At, B1); PG8_BAR; PG8_SCHED;
            } else {
            PG8_LDB(B0, 0, 0); PG8_SCHED; PG8_LDA(At, 0, 0); PG8_STAGE(PG8_SA(1, 1), a1 + hstep, voffA);
            PG8_WAIT_L(8); PG8_BAR; PG8_WAIT_L(0); PG8_MMA(0, 0, At, B0); PG8_BAR; PG8_SCHED;
            PG8_LDB(B1, 0, 1); PG8_STAGE(PG8_SB(0, 0), b2, voffB);
            PG8_BAR; PG8_WAIT_L(0); PG8_MMA(0, 1, At, B1); PG8_BAR;
            PG8_LDA(At, 0, 1); PG8_STAGE(PG8_SA(0, 0), a2, voffA);
            PG8_BAR; PG8_WAIT_L(0); PG8_MMA(1, 0, At, B0); PG8_BAR; PG8_SCHED;
            PG8_STAGE(PG8_SB(0, 1), b2 + hstep, voffB);
            PG8_WAIT_V(6); PG8_BAR; PG8_MMA(1, 1, At, B1); PG8_BAR;
            PG8_LDB(B0, 1, 0); PG8_SCHED; PG8_LDA(At, 1, 0); PG8_STAGE(PG8_SA(0, 1), a2 + hstep, voffA);
            PG8_WAIT_L(8); PG8_BAR; PG8_WAIT_L(0); PG8_MMA(0, 0, At, B0); PG8_BAR; PG8_SCHED;
            PG8_LDB(B1, 1, 1); PG8_STAGE(PG8_SB(1, 0), b3, voffB);
            PG8_BAR; PG8_WAIT_L(0); PG8_MMA(0, 1, At, B1); PG8_BAR;
            PG8_LDA(At, 1, 1); PG8_STAGE(PG8_SA(1, 0), a3, voffA);
            PG8_BAR; PG8_WAIT_L(0); PG8_MMA(1, 0, At, B0); PG8_BAR; PG8_SCHED;
            PG8_STAGE(PG8_SB(1, 1), b3 + hstep, voffB);
            PG8_WAIT_V(6); PG8_BAR; PG8_MMA(1, 1, At, B1); PG8_BAR;
            }
        }
        if constexpr (ALIGN_EPI) { if (wr == 0) PG8_BAR; }
        if constexpr (!Epi::AFTER_DRAIN) { E(acc, cur, wr, wc, fr, fq); S.done(cur); }
        if (!has_next) break;
#pragma unroll
        for (int a = 0; a < 2; ++a)
#pragma unroll
            for (int b = 0; b < 2; ++b)
#pragma unroll
                for (int m = 0; m < 4; ++m)
#pragma unroll
                    for (int n = 0; n < 2; ++n) acc[a][b][m][n] = (f32x4){0.f, 0.f, 0.f, 0.f};
        cur = nxt; cA = nA; cB = nB; ++ui;
        if constexpr (ALIGN_EPI) { if (wr == 1) PG8_BAR; }
    }
    PG8_WAIT_V(0);
    if constexpr (!ALIGN_EPI) { if (wr == 0) PG8_BAR; }
    PG8_BAR;
    if constexpr (Epi::AFTER_DRAIN) { E.fused(acc, cur, wr, wc, fr, fq, lds, wid, lane); S.done(cur); }
#undef PG8_SA
#undef PG8_SB
#undef PG8_STAGE
#undef PG8_LDA
#undef PG8_LDB
#undef PG8_MMA
#undef PG8_WAIT_V
#undef PG8_WAIT_L
#undef PG8_BAR
#undef PG8_SCHED
}
}

#define LAS __attribute__((address_space(3)))
typedef unsigned short bf16;
typedef float f32x4 __attribute__((ext_vector_type(4)));
typedef float f32x16 __attribute__((ext_vector_type(16)));
typedef short bf16x8 __attribute__((ext_vector_type(8)));
typedef unsigned u32x4 __attribute__((ext_vector_type(4)));
typedef unsigned u32x2 __attribute__((ext_vector_type(2)));
typedef float f32x2 __attribute__((ext_vector_type(2)));
using pg8::cvt_pk_bf16;

constexpr int NWAVES = 8, NTHREADS = 512;
constexpr int D = 1024, FF = 2816, NIN = 5632;
constexpr int MP = 16384;
constexpr int MS = 256;
constexpr int MO = MP + MS;
constexpr int MX = MO + 16;
constexpr int MPAD = 16896;
constexpr int LP = 4112;
constexpr int LC = 2064;
constexpr float EPS = 1e-6f;
constexpr float LOG2E = 1.4426950408889634f;
constexpr float QSCALE = 0.125f * LOG2E;
constexpr float SB_EXIT = 152.0f;

constexpr size_t O_YP = 0, O_YS = 16777216, O_PK = 17039360, O_PV = 25460736, O_PH = 33882112, O_SK = 34144256, O_SV = 34275328, O_SH = 34406400;
constexpr size_t WS_WGU1 = 0, WS_WD1 = 11534336, WS_WIN = 17301504, WS_WA = 28835840, WS_WB = 29884416, WS_WOUT = 30932992, WS_WGU2 = 33030144, WS_WD2 = 44564480;
constexpr size_t WS_SS = 50331648, SS_BYTES = (size_t)MPAD * 16 * 4;
constexpr size_t WS_XN = 54657024, WS_ACT = 89260032;
constexpr size_t WS_KKH = 184418304, WS_QB = 201719808, WS_QH = 219021312, WS_IVTP = 236322816, WS_IVTS = 253165568, WS_END = 253689856;
constexpr size_t WS_GA = WS_ACT, WS_GB = WS_ACT + 34603008, WS_SG = WS_ACT + 69206016;
constexpr int LDS_BYTES = 147456;
constexpr size_t WS_MRG = 219021312;
constexpr size_t WS_SLAB = 219021312;
constexpr size_t WS_CTL = 253689856, CTL_BYTES = 16384;
constexpr int LDS_BARST = 131072 + 64;

struct Args { const float* in[23]; float* out; unsigned char* ws; };
typedef const Args __attribute__((address_space(4)))* ArgsP;
__device__ __forceinline__ ArgsP argsp() { ArgsP p = (ArgsP)__builtin_amdgcn_kernarg_segment_ptr(); asm volatile("" : "+s"(p)); return p; }
enum { I_XP = 0, I_XS, I_CK, I_CV, I_ST, I_META, I_N1, I_WG1, I_WU1, I_WD1, I_NMIX, I_WIN, I_BG, I_LB, I_HGN, I_WA, I_WB, I_WOUT, I_N2, I_WG2, I_WU2, I_WD2, I_NF };

__device__ __forceinline__ float wave_sum(float v) {
#pragma unroll
    for (int o = 1; o < 64; o <<= 1) v += __shfl_xor(v, o);
    return v;
}
__device__ __forceinline__ float ex2(float x) { return __builtin_amdgcn_exp2f(x); }
__device__ __forceinline__ float lg2(float x) { return __builtin_amdgcn_logf(x); }
__device__ __forceinline__ float sigmoidf_(float x) { return 1.0f / (1.0f + ex2(-x * LOG2E)); }
__device__ __forceinline__ float rstd_from_ss(const float* ss, int r) {
    const f32x4* p = (const f32x4*)(ss + (size_t)r * 16);
    f32x4 a = p[0], b = p[1], c = p[2], d = p[3];
    float s = ((a.x + a.y) + (a.z + a.w)) + ((b.x + b.y) + (b.z + b.w)) + ((c.x + c.y) + (c.z + c.w)) + ((d.x + d.y) + (d.z + d.w));
    return rsqrtf(s * (1.0f / 1024.0f) + EPS);
}
__device__ __forceinline__ const float* xin_row(ArgsP A, int r) {
    if (r < MP) return A->in[I_XP] + (size_t)r * D;
    if (r < MO) return A->in[I_XS] + (size_t)(r - MP) * D;
    if (r < MX) return A->in[I_META] + (size_t)(r - MO) * D;
    return nullptr;
}

__device__ __forceinline__ void p0_transpose_item(const float* W, int K, int N, bf16* WT, int il, LAS float* scr, int item, int lane) {
    const int nblk = N / 32, kb = item / nblk, nb = item % nblk, k0 = 64 * kb, n0 = 32 * nb;
#pragma unroll 8
    for (int i = 0; i < 32; ++i) { const int kk = 2 * i + (lane >> 5); scr[kk * 33 + (lane & 31)] = W[(size_t)(k0 + kk) * N + n0 + (lane & 31)]; }
    asm volatile("s_waitcnt lgkmcnt(0)" ::: "memory");
    const int rbase = il == 0 ? n0 : ((n0 >> 7) * 256 + (n0 & 127) + (il == 2 ? 128 : 0));
    const int c = lane & 7;
#pragma unroll
    for (int j = 0; j < 4; ++j) { const int n = (lane >> 3) + 8 * j; const LAS float* s = scr + (8 * c) * 33 + n;
        u32x4 o; o.x = cvt_pk_bf16(s[0 * 33], s[1 * 33]); o.y = cvt_pk_bf16(s[2 * 33], s[3 * 33]); o.z = cvt_pk_bf16(s[4 * 33], s[5 * 33]); o.w = cvt_pk_bf16(s[6 * 33], s[7 * 33]);
        *(u32x4*)(WT + (size_t)(rbase + n) * K + k0 + 8 * c) = o; }
    asm volatile("s_waitcnt lgkmcnt(0)" ::: "memory");
}
__device__ __forceinline__ void p0_weights(ArgsP A, LAS unsigned char* lds, int wave, int lane, int gw, int NGW, bool late) {
    LAS float* scr = (LAS float*)(lds + wave * 16384);
    unsigned char* ws = A->ws;
    constexpr int I_GU = (D / 64) * (FF / 32), I_DN = (FF / 64) * (D / 32), I_IN = (D / 64) * (NIN / 32), I_BR = (512 / 64) * (D / 32), I_OU = (D / 64) * (D / 32);
    constexpr int N_EARLY = 2 * I_GU + I_DN + I_IN, N_LATE = 2 * I_BR + I_OU + 2 * I_GU + I_DN;
    if (!late) {
        for (int it = gw; it < N_EARLY; it += NGW) {
            int r = it;
            if (r < I_GU) { p0_transpose_item(A->in[I_WG1], D, FF, (bf16*)(ws + WS_WGU1), 1, scr, r, lane); continue; } r -= I_GU;
            if (r < I_GU) { p0_transpose_item(A->in[I_WU1], D, FF, (bf16*)(ws + WS_WGU1), 2, scr, r, lane); continue; } r -= I_GU;
            if (r < I_DN) { p0_transpose_item(A->in[I_WD1], FF, D, (bf16*)(ws + WS_WD1), 0, scr, r, lane); continue; } r -= I_DN;
            p0_transpose_item(A->in[I_WIN], D, NIN, (bf16*)(ws + WS_WIN), 0, scr, r, lane);
        }
    } else {
        for (int it = gw; it < N_LATE; it += NGW) {
            int r = it;
            if (r < I_BR) { p0_transpose_item(A->in[I_WA], 512, D, (bf16*)(ws + WS_WA), 0, scr, r, lane); continue; } r -= I_BR;
            if (r < I_BR) { p0_transpose_item(A->in[I_WB], 512, D, (bf16*)(ws + WS_WB), 0, scr, r, lane); continue; } r -= I_BR;
            if (r < I_OU) { p0_transpose_item(A->in[I_WOUT], D, D, (bf16*)(ws + WS_WOUT), 0, scr, r, lane); continue; } r -= I_OU;
            if (r < I_GU) { p0_transpose_item(A->in[I_WG2], D, FF, (bf16*)(ws + WS_WGU2), 1, scr, r, lane); continue; } r -= I_GU;
            if (r < I_GU) { p0_transpose_item(A->in[I_WU2], D, FF, (bf16*)(ws + WS_WGU2), 2, scr, r, lane); continue; } r -= I_GU;
            p0_transpose_item(A->in[I_WD2], FF, D, (bf16*)(ws + WS_WD2), 0, scr, r, lane);
        }
    }
}
__device__ __forceinline__ void p0_phase(ArgsP A, LAS unsigned char* lds, int wave, int lane) {
    const int G = gridDim.x, gw = blockIdx.x * NWAVES + wave, NGW = G * NWAVES;
    unsigned char* ws = A->ws;
    p0_weights(A, lds, wave, lane, gw, NGW, false);
    bf16* XN = (bf16*)(ws + WS_XN); float* SS0 = (float*)(ws + WS_SS);
    const f32x4* g1 = (const f32x4*)A->in[I_N1] + lane;
    for (int m = gw; m < MPAD; m += NGW) {
        const float* xr = xin_row(A, m);
        unsigned long long* o8 = (unsigned long long*)(XN + (size_t)m * D) + lane;
        float s = 0.f;
        if (xr) {
            const f32x4* x4 = (const f32x4*)xr + lane;
#pragma unroll
            for (int j = 0; j < 4; ++j) { f32x4 v = x4[64 * j]; const f32x4 g = g1[64 * j]; s += (v.x * v.x + v.y * v.y) + (v.z * v.z + v.w * v.w);
                o8[64 * j] = (unsigned long long)cvt_pk_bf16(v.x * g.x, v.y * g.y) | ((unsigned long long)cvt_pk_bf16(v.z * g.z, v.w * g.w) << 32); }
        } else {
#pragma unroll
            for (int j = 0; j < 4; ++j) o8[64 * j] = 0ull;
        }
        s = wave_sum(s);
        if (lane < 16) SS0[(size_t)m * 16 + lane] = lane == 0 ? s : 0.f;
    }
}

struct EpiSwiGLU {
    static constexpr bool PERM = true, AFTER_DRAIN = false, HAS_MID = false;
    bf16* act; const float* ss;
    __device__ __forceinline__ void operator()(const f32x4 (&acc)[2][2][4][2], const pg8::Unit& u, int wr, int wc, int fr, int fq) const {
        const int col0 = u.pn * 128 + wc * 32 + 8 * fq;
#pragma unroll
        for (int ai = 0; ai < 2; ++ai)
#pragma unroll
            for (int m = 0; m < 4; ++m) {
                const int r = u.pm * 256 + ai * 128 + wr * 64 + m * 16 + fr;
                const float rs = rstd_from_ss(ss, r);
                float o[8];
#pragma unroll
                for (int n = 0; n < 2; ++n)
#pragma unroll
                    for (int e = 0; e < 4; ++e) { const float g = acc[ai][0][m][n][e] * rs, up = acc[ai][1][m][n][e] * rs; o[4 * n + e] = g * up / (1.0f + ex2(-g * LOG2E)); }
                u32x4 w; w.x = cvt_pk_bf16(o[0], o[1]); w.y = cvt_pk_bf16(o[2], o[3]); w.z = cvt_pk_bf16(o[4], o[5]); w.w = cvt_pk_bf16(o[6], o[7]);
                *(u32x4*)(act + (size_t)r * FF + col0) = w;
            }
    }
};
template <int SRC_INPUTS, int HALF_SCALE, int HAS_XN> struct EpiResid {
    static constexpr bool PERM = false, AFTER_DRAIN = false, HAS_MID = false;
    const float* xp; const float* xs; const float* xm; float* X; bf16* XN; const float* gnext; float* ss; float* slab; int ntile, pm0;
    __device__ __forceinline__ void operator()(const f32x4 (&acc)[2][2][4][2], const pg8::Unit& u, int wr, int wc, int fr, int fq) const {
        const int col0 = u.pn * 256 + wc * 32 + 4 * fq;
        if (u.kc >= 0) {
            float* sl = slab + ((size_t)(u.kc * ntile + (u.pm - pm0)) * 256) * 1024;
#pragma unroll
            for (int ai = 0; ai < 2; ++ai)
#pragma unroll
                for (int m = 0; m < 4; ++m)
#pragma unroll
                    for (int bj = 0; bj < 2; ++bj)
#pragma unroll
                        for (int n = 0; n < 2; ++n) *(f32x4*)(sl + (size_t)(ai * 128 + wr * 64 + m * 16 + fr) * 1024 + col0 + bj * 128 + n * 16) = acc[ai][bj][m][n];
            return;
        }
#pragma unroll
        for (int ai = 0; ai < 2; ++ai)
#pragma unroll
            for (int m = 0; m < 4; ++m) {
                const int r = u.pm * 256 + ai * 128 + wr * 64 + m * 16 + fr;
                const float* srow = SRC_INPUTS ? (r < MP ? xp + (size_t)r * D : (r < MO ? xs + (size_t)(r - MP) * D : (r < MX ? xm + (size_t)(r - MO) * D : nullptr))) : (X + (size_t)r * D);
                float s = 0.f;
#pragma unroll
                for (int bj = 0; bj < 2; ++bj)
#pragma unroll
                    for (int n = 0; n < 2; ++n) {
                        const int c = col0 + bj * 128 + n * 16;
                        f32x4 v = acc[ai][bj][m][n] * (HALF_SCALE ? 0.5f : 1.0f);
                        if (srow) v += *(const f32x4*)(srow + c);
                        s += (v.x * v.x + v.y * v.y) + (v.z * v.z + v.w * v.w);
                        if (r < MO) *(f32x4*)(X + (size_t)r * D + c) = v;
                        if (HAS_XN) { const f32x4 g = *(const f32x4*)(gnext + c); u32x2 w; w.x = cvt_pk_bf16(v.x * g.x, v.y * g.y); w.y = cvt_pk_bf16(v.z * g.z, v.w * g.w); *(u32x2*)(XN + (size_t)r * D + c) = w; }
                    }
                s += __shfl_xor(s, 16); s += __shfl_xor(s, 32);
                if (fq == 0) ss[(size_t)r * 16 + u.pn * 4 + wc] = s;
            }
    }
};
template <int SRC_INPUTS, int HALF_SCALE, int HAS_XN> __device__ __forceinline__ void resid_finish(const float* xp, const float* xs, const float* xm, float* X, bf16* XN, const float* gnext, float* ss,
                                                                                                   const float* slab, int nkc, int ntile, int nrows, int gw, int ngw, int lane) {
    for (int rr = gw; rr < nrows; rr += ngw) { const int r = MP + rr;
        const float* srow = SRC_INPUTS ? (r < MO ? xs + (size_t)(r - MP) * D : xm + (size_t)(r - MO) * D) : (X + (size_t)r * D);
        float s = 0.f;
#pragma unroll
        for (int j = 0; j < 4; ++j) { const int c = 4 * lane + 256 * j; f32x4 a = {0.f, 0.f, 0.f, 0.f};
            for (int kc = 0; kc < nkc; ++kc) a += *(const f32x4*)(slab + ((size_t)kc * ntile * 256 + rr) * 1024 + c);
            f32x4 v = a * (HALF_SCALE ? 0.5f : 1.0f) + *(const f32x4*)(srow + c);
            s += (v.x * v.x + v.y * v.y) + (v.z * v.z + v.w * v.w);
            if (r < MO) *(f32x4*)(X + (size_t)r * D + c) = v;
            if (HAS_XN) { const f32x4 g = *(const f32x4*)(gnext + c); u32x2 w; w.x = cvt_pk_bf16(v.x * g.x, v.y * g.y); w.y = cvt_pk_bf16(v.z * g.z, v.w * g.w); *(u32x2*)(XN + (size_t)r * D + c) = w; } }
        s = wave_sum(s);
        if (lane < 16) ss[(size_t)r * 16 + lane] = lane == 0 ? s : 0.f; }
}
struct EpiWin {
    static constexpr bool PERM = false, AFTER_DRAIN = false, HAS_MID = false;
    unsigned char* ws; float* out; const float* lbp; const float* bgp; const float* ss;
    template <int TYPE> __device__ __forceinline__ void run(const f32x4 (&acc)[2][2][4][2], const pg8::Unit& u, int wr, int wc, int fr, int fq, int cbase) const {
        const int col0 = u.pn * 256 + wc * 32 + 4 * fq - cbase;
#pragma unroll
        for (int ai = 0; ai < 2; ++ai)
#pragma unroll
            for (int m = 0; m < 4; ++m) {
                const int r = u.pm * 256 + ai * 128 + wr * 64 + m * 16 + fr;
                const int rlim = (TYPE == 0 || TYPE >= 6) ? MO : MX;
                if (r < rlim) {
                const float rs = rstd_from_ss(ss, r);
#pragma unroll
                for (int bj = 0; bj < 2; ++bj)
#pragma unroll
                    for (int n = 0; n < 2; ++n) {
                        const int cc = col0 + bj * 128 + n * 16;
                        const f32x4 v = acc[ai][bj][m][n] * rs;
                        if (TYPE == 0) {
                            u32x2 w; w.x = cvt_pk_bf16(v.x * QSCALE, v.y * QSCALE); w.y = cvt_pk_bf16(v.z * QSCALE, v.w * QSCALE); *(u32x2*)((bf16*)(ws + WS_QB) + (size_t)r * 512 + cc) = w;
                        } else if (TYPE == 1 || TYPE == 2) {
                            const size_t ob = TYPE == 2 ? O_PV : O_PK, os = TYPE == 2 ? O_SV : O_SK;
                            if (r < MP) { const int b = r >> 12, t = r & 4095; *(f32x4*)(out + ob + ((size_t)(b * LP + 16 + t)) * 512 + cc) = v; }
                            else if (r < MO) { *(f32x4*)(out + os + (size_t)(r - MP) * 512 + cc) = v; }
                            else { const int mm = r - MO;
#pragma unroll
                                for (int b = 0; b < 4; ++b) *(f32x4*)(out + ob + ((size_t)(b * LP + mm)) * 512 + cc) = v; }
                        } else if (TYPE == 3) {
                            const f32x4 l0 = *(const f32x4*)(lbp + cc), l1 = *(const f32x4*)(lbp + 512 + cc);
                            _Float16 h[4];
#pragma unroll
                            for (int e = 0; e < 4; ++e) { const float oml = 1.0f / (1.0f + ex2((l1[e] - l0[e]) * LOG2E));
                                h[e] = (_Float16)(oml / (1.0f + ex2(v[e] * LOG2E))); }
                            u32x2 w; w.x = (unsigned)__builtin_bit_cast(unsigned short, h[0]) | ((unsigned)__builtin_bit_cast(unsigned short, h[1]) << 16);
                            w.y = (unsigned)__builtin_bit_cast(unsigned short, h[2]) | ((unsigned)__builtin_bit_cast(unsigned short, h[3]) << 16);
                            *(u32x2*)((unsigned short*)(ws + WS_KKH) + (size_t)r * 512 + cc) = w;
                        } else if (TYPE == 4) {
                            const int h = cc >> 7, vv = cc & 127;
                            const unsigned w01 = cvt_pk_bf16(v.x, v.y), w23 = cvt_pk_bf16(v.z, v.w);
                            const bf16 e0 = (bf16)(w01 & 0xffffu), e1 = (bf16)(w01 >> 16), e2 = (bf16)(w23 & 0xffffu), e3 = (bf16)(w23 >> 16);
                            if (r < MP) { const int b = r >> 12, t = r & 4095; bf16* p = (bf16*)(ws + WS_IVTP) + ((size_t)((b * 4 + h) * 128 + vv)) * LP + 16 + t; p[0] = e0; p[LP] = e1; p[2 * LP] = e2; p[3 * LP] = e3; }
                            else if (r < MO) { const int s = (r - MP) >> 5, t = (r - MP) & 31; bf16* p = (bf16*)(ws + WS_IVTS) + ((size_t)((s * 4 + h) * 128 + vv)) * 64 + t; p[0] = e0; p[64] = e1; p[128] = e2; p[192] = e3; }
                            else { const int mm = r - MO;
#pragma unroll
                                for (int b = 0; b < 4; ++b) { bf16* p = (bf16*)(ws + WS_IVTP) + ((size_t)((b * 4 + h) * 128 + vv)) * LP + mm; p[0] = e0; p[LP] = e1; p[2 * LP] = e2; p[3 * LP] = e3; } }
                        } else if (TYPE == 5) {
                            u32x2 w; w.x = cvt_pk_bf16(v.x, v.y); w.y = cvt_pk_bf16(v.z, v.w); *(u32x2*)((bf16*)(ws + WS_QH) + (size_t)r * 512 + cc) = w;
                        } else if (TYPE == 6) {
                            float o[4];
#pragma unroll
                            for (int e = 0; e < 4; ++e) o[e] = v[e] / (1.0f + ex2(-v[e] * LOG2E));
                            u32x2 w; w.x = cvt_pk_bf16(o[0], o[1]); w.y = cvt_pk_bf16(o[2], o[3]); *(u32x2*)((bf16*)(ws + WS_SG) + (size_t)r * 512 + cc) = w;
                        } else {
                            const f32x4 bg = *(const f32x4*)(bgp + (TYPE == 8 ? 1024 : 0) + cc); float o[4];
#pragma unroll
                            for (int e = 0; e < 4; ++e) o[e] = 1.0f / (1.0f + ex2(-(v[e] + bg[e]) * LOG2E));
                            u32x2 w; w.x = cvt_pk_bf16(o[0], o[1]); w.y = cvt_pk_bf16(o[2], o[3]); *(u32x2*)((bf16*)(ws + (TYPE == 8 ? WS_GB : WS_GA)) + (size_t)r * D + cc) = w;
                        }
                    }
                }
            }
    }
    __device__ __forceinline__ void operator()(const f32x4 (&acc)[2][2][4][2], const pg8::Unit& u, int wr, int wc, int fr, int fq) const {
        const int pn = u.pn;
        if (pn < 2) run<0>(acc, u, wr, wc, fr, fq, 0);
        else if (pn < 4) run<1>(acc, u, wr, wc, fr, fq, 512);
        else if (pn < 6) run<2>(acc, u, wr, wc, fr, fq, 1024);
        else if (pn < 8) run<3>(acc, u, wr, wc, fr, fq, 1536);
        else if (pn < 10) run<4>(acc, u, wr, wc, fr, fq, 2048);
        else if (pn < 12) run<5>(acc, u, wr, wc, fr, fq, 2560);
        else if (pn < 14) run<6>(acc, u, wr, wc, fr, fq, 3072);
        else if (pn < 18) run<7>(acc, u, wr, wc, fr, fq, 3584);
        else run<8>(acc, u, wr, wc, fr, fq, 4608);
    }
};
__device__ __forceinline__ float bf2f(unsigned short h) { return __builtin_bit_cast(float, (unsigned)h << 16); }
__device__ __forceinline__ float bf2f(unsigned h) { return __builtin_bit_cast(float, h << 16); }
struct EpiMergeF {
    static constexpr bool PERM = false, AFTER_DRAIN = false, HAS_MID = true;
    const bf16* ga; const bf16* gb; bf16* merged;
    __device__ __forceinline__ void mid(f32x4 (&acc)[2][2][4][2], const pg8::Unit& u, int wr, int wc, int fr_in, int fq_in) const {
        int fr = fr_in, fq = fq_in; asm volatile("" : "+v"(fr), "+v"(fq));
        const int col0 = u.pn * 256 + wc * 32 + 4 * fq;
#pragma unroll
        for (int ai = 0; ai < 2; ++ai)
#pragma unroll
            for (int m = 0; m < 4; ++m) {
                const size_t ro = (size_t)(u.pm * 256 + ai * 128 + wr * 64 + m * 16 + fr) * D + col0;
#pragma unroll
                for (int bj = 0; bj < 2; ++bj) { u32x2 wa[2], wb[2];
#pragma unroll
                    for (int n = 0; n < 2; ++n) { wa[n] = *(const u32x2*)(ga + ro + bj * 128 + n * 16); wb[n] = *(const u32x2*)(gb + ro + bj * 128 + n * 16); }
#pragma unroll
                    for (int n = 0; n < 2; ++n) { f32x4& v = acc[ai][bj][m][n]; const u32x2 a = wa[n], b = wb[n];
                        v.x *= bf2f(a.x & 0xffffu) * __builtin_amdgcn_rcpf(bf2f(b.x & 0xffffu)); v.y *= bf2f(a.x >> 16) * __builtin_amdgcn_rcpf(bf2f(b.x >> 16));
                        v.z *= bf2f(a.y & 0xffffu) * __builtin_amdgcn_rcpf(bf2f(b.y & 0xffffu)); v.w *= bf2f(a.y >> 16) * __builtin_amdgcn_rcpf(bf2f(b.y >> 16)); } }
            }
    }
    __device__ __forceinline__ void operator()(const f32x4 (&acc)[2][2][4][2], const pg8::Unit& u, int wr, int wc, int fr, int fq) const {
        const int col0 = u.pn * 256 + wc * 32 + 4 * fq;
#pragma unroll
        for (int ai = 0; ai < 2; ++ai)
#pragma unroll
            for (int m = 0; m < 4; ++m) {
                const size_t ro = (size_t)(u.pm * 256 + ai * 128 + wr * 64 + m * 16 + fr) * D + col0;
                u32x2 wb[2][2];
#pragma unroll
                for (int bj = 0; bj < 2; ++bj)
#pragma unroll
                    for (int n = 0; n < 2; ++n) wb[bj][n] = *(const u32x2*)(gb + ro + bj * 128 + n * 16);
#pragma unroll
                for (int bj = 0; bj < 2; ++bj)
#pragma unroll
                    for (int n = 0; n < 2; ++n) { const f32x4 v = acc[ai][bj][m][n]; const u32x2 b = wb[bj][n];
                        u32x2 w; w.x = cvt_pk_bf16(v.x * bf2f(b.x & 0xffffu), v.y * bf2f(b.x >> 16)); w.y = cvt_pk_bf16(v.z * bf2f(b.y & 0xffffu), v.w * bf2f(b.y >> 16));
                        *(u32x2*)(merged + ro + bj * 128 + n * 16) = w; }
            }
    }
};

__device__ __forceinline__ bf16x8 pack8(const float* f) { u32x4 w; w.x = cvt_pk_bf16(f[0], f[1]); w.y = cvt_pk_bf16(f[2], f[3]); w.z = cvt_pk_bf16(f[4], f[5]); w.w = cvt_pk_bf16(f[6], f[7]); return __builtin_bit_cast(bf16x8, w); }
template <bool WRITE> __device__ __forceinline__ void attn_item(ArgsP A, int item, int lane) {
    const float* kdiag; const float* vdiag; const float* klow; const float* vlow; int qrow0, posq0, nblk, h;
    if (item < 4096) { const int b = item >> 10; h = (item >> 7) & 7; const int qt = item & 127;
        qrow0 = b * 4096 + 32 * qt; posq0 = 16 + 32 * qt; nblk = qt + 2;
        klow = A->out + O_PK + (size_t)b * LP * 512 + h * 64; vlow = A->out + O_PV + (size_t)b * LP * 512 + h * 64;
        kdiag = klow + (size_t)posq0 * 512; vdiag = vlow + (size_t)posq0 * 512;
    } else { const int id = item - 4096, s = id >> 3; h = id & 7;
        qrow0 = MP + 32 * s; posq0 = LC; nblk = 66;
        klow = A->in[I_CK] + (size_t)s * LC * 512 + h * 64; vlow = A->in[I_CV] + (size_t)s * LC * 512 + h * 64;
        kdiag = A->out + O_SK + (size_t)s * 32 * 512 + h * 64; vdiag = A->out + O_SV + (size_t)s * 32 * 512 + h * 64;
    }
    bf16* qo = (bf16*)(A->ws + WS_QB) + (size_t)qrow0 * 512 + h * 64;
    const int ql = lane & 31, hi = lane >> 5;
    bf16x8 qf[4];
#pragma unroll
    for (int s = 0; s < 4; ++s) qf[s] = *(const bf16x8*)(qo + (size_t)ql * 512 + 16 * s + 8 * hi);
    const int rA = (ql & 3) + 4 * (ql >> 3), hA = (ql >> 2) & 1, kappaA = 8 * hA + rA + (rA >= 8 ? 8 : 0);
    f32x16 o0, o1;
#pragma unroll
    for (int r = 0; r < 16; ++r) { o0[r] = 0.f; o1[r] = 0.f; }
    float R = 0.f;
    for (int j = 0; j < nblk; ++j) {
        const int pos0 = posq0 - 32 * j;
        const float* kb = j == 0 ? kdiag : klow; const float* vb = j == 0 ? vdiag : vlow;
        const int rb = j == 0 ? 0 : pos0;
        int rowA = rb + kappaA; rowA = rowA < 0 ? 0 : rowA;
        const float* kp = kb + (size_t)rowA * 512 + 8 * hi;
        f32x16 sacc;
#pragma unroll
        for (int r = 0; r < 16; ++r) sacc[r] = 0.f;
        f32x4 kv[8];
#pragma unroll
        for (int s = 0; s < 4; ++s) { kv[2 * s] = *(const f32x4*)(kp + 16 * s); kv[2 * s + 1] = *(const f32x4*)(kp + 16 * s + 4); }
        float vv[2][2][8];
#pragma unroll
        for (int st = 0; st < 2; ++st)
#pragma unroll
            for (int i = 0; i < 8; ++i) { int row = rb + 16 * st + 8 * hi + i; row = row < 0 ? 0 : row; const float* vp = vb + (size_t)row * 512 + ql; vv[st][0][i] = vp[0]; vv[st][1][i] = vp[32]; }
#pragma unroll
        for (int s = 0; s < 4; ++s) { float kk[8] = {kv[2 * s].x, kv[2 * s].y, kv[2 * s].z, kv[2 * s].w, kv[2 * s + 1].x, kv[2 * s + 1].y, kv[2 * s + 1].z, kv[2 * s + 1].w};
            sacc = __builtin_amdgcn_mfma_f32_32x32x16_bf16(pack8(kk), qf[s], sacc, 0, 0, 0); }
        float sp[16];
#pragma unroll
        for (int r = 0; r < 16; ++r) { const int kappa = 8 * hi + r + (r >= 8 ? 8 : 0);
            const bool valid = (pos0 + kappa >= 0) && (j > 0 || kappa < ql);
            const float z = sacc[r];
            const float s_ = fmaxf(z, 0.f) + lg2(1.0f + ex2(-fabsf(z)));
            sp[r] = valid ? s_ : 0.f; sacc[r] = valid ? z : -1e30f; }
        float glo = 0.f, ghi = 0.f;
#pragma unroll
        for (int r = 0; r < 8; ++r) { glo += sp[r]; ghi += sp[8 + r]; }
        const float pglo = __shfl_xor(glo, 32), pghi = __shfl_xor(ghi, 32);
        const float base_hi = R + (hi == 0 ? pghi : 0.f);
        const float base_lo = R + ghi + pghi + (hi == 0 ? pglo : 0.f);
        float pa[16];
        { float c = base_hi;
#pragma unroll
          for (int r = 15; r >= 8; --r) { c += sp[r]; pa[r] = ex2(sacc[r] - c); }
          c = base_lo;
#pragma unroll
          for (int r = 7; r >= 0; --r) { c += sp[r]; pa[r] = ex2(sacc[r] - c); } }
        R += (glo + ghi) + (pglo + pghi);
        const bf16x8 p0 = pack8(pa), p1 = pack8(pa + 8);
        o0 = __builtin_amdgcn_mfma_f32_32x32x16_bf16(pack8(vv[0][0]), p0, o0, 0, 0, 0);
        o1 = __builtin_amdgcn_mfma_f32_32x32x16_bf16(pack8(vv[0][1]), p0, o1, 0, 0, 0);
        o0 = __builtin_amdgcn_mfma_f32_32x32x16_bf16(pack8(vv[1][0]), p1, o0, 0, 0, 0);
        o1 = __builtin_amdgcn_mfma_f32_32x32x16_bf16(pack8(vv[1][1]), p1, o1, 0, 0, 0);
        if (__all(R > SB_EXIT)) break;
    }
    if (!WRITE) { if (o0[0] + o1[5] != 12345.678f) return; }
#pragma unroll
    for (int g = 0; g < 4; ++g) {
        u32x2 w; w.x = cvt_pk_bf16(o0[4 * g], o0[4 * g + 1]); w.y = cvt_pk_bf16(o0[4 * g + 2], o0[4 * g + 3]);
        *(u32x2*)(qo + (size_t)ql * 512 + 8 * g + 4 * hi) = w;
        u32x2 w1; w1.x = cvt_pk_bf16(o1[4 * g], o1[4 * g + 1]); w1.y = cvt_pk_bf16(o1[4 * g + 2], o1[4 * g + 3]);
        *(u32x2*)(qo + (size_t)ql * 512 + 32 + 8 * g + 4 * hi) = w1;
    }
}

constexpr int HQ_P = 136, HT_P = 72, HS_P = 72;
constexpr int IMG_KHT = 0, IMG_SC = 128 * HT_P * 2, IMG_DV = IMG_SC + 64 * HS_P * 2, IMG_BYTES = IMG_DV + 512;
constexpr int NPREP = 16 * 65 + 32;
constexpr size_t WS_IMG = WS_XN;
constexpr size_t WS_ORAW = WS_WGU1;
static_assert((size_t)NPREP * IMG_BYTES <= 34603008, "image region");
constexpr int LP_QT = 0, LP_KT = LP_QT + 64 * HQ_P * 2, LP_PART = LP_KT + 64 * HQ_P * 2, LP_END = LP_PART + 8 * 128 * 4;
__device__ __forceinline__ void hgrn_chunk_params(bool prompt, int sidx, int c, int& row0, int& nvalid, int& pos0) {
    if (prompt) { if (c == 0) { row0 = MO; nvalid = 16; pos0 = 0; } else { row0 = sidx * 4096 + 64 * (c - 1); nvalid = 64; pos0 = 16 + 64 * (c - 1); } }
    else { row0 = MP + 32 * sidx; nvalid = 32; pos0 = 0; }
}
template <bool WRITE> __device__ __forceinline__ void hgrn_prep(ArgsP A, LAS unsigned char* lds, int item, int tid) {
    const int lane = tid & 63, w = __builtin_amdgcn_readfirstlane(tid >> 6), l16 = lane & 15, g = lane >> 4;
    const bool prompt = item < 1040; const int bh = prompt ? item / 65 : item - 1040, c = prompt ? item % 65 : 0, sidx = bh >> 2, h = bh & 3;
    int row0, nvalid, pos0; hgrn_chunk_params(prompt, sidx, c, row0, nvalid, pos0);
    LAS bf16* Qt = (LAS bf16*)(lds + LP_QT); LAS bf16* Kt = (LAS bf16*)(lds + LP_KT); LAS float* part = (LAS float*)(lds + LP_PART);
    unsigned char* img = A->ws + WS_IMG + (size_t)item * IMG_BYTES;
    const unsigned short* kkh = (const unsigned short*)(A->ws + WS_KKH); bf16* qh = (bf16*)(A->ws + WS_QH);
    const int kp = lane, tg = w;
    float kk[8][2], qv[8][2], cb[8][2]; float run0 = 0.f, run1 = 0.f;
#pragma unroll
    for (int i = 0; i < 8; ++i) { const int t = 8 * tg + i;
        if (t < nvalid) { const size_t off = (size_t)(row0 + t) * 512 + h * 128 + 2 * kp; const unsigned k2 = *(const unsigned*)(kkh + off), q2 = *(const unsigned*)(qh + off);
            kk[i][0] = (float)__builtin_bit_cast(_Float16, (unsigned short)(k2 & 0xffffu)); kk[i][1] = (float)__builtin_bit_cast(_Float16, (unsigned short)(k2 >> 16));
            qv[i][0] = bf2f((unsigned short)(q2 & 0xffffu)); qv[i][1] = bf2f((unsigned short)(q2 >> 16)); }
        else { kk[i][0] = 0.f; kk[i][1] = 0.f; qv[i][0] = 0.f; qv[i][1] = 0.f; } }
#pragma unroll
    for (int i = 0; i < 8; ++i) { run0 += lg2(1.0f - kk[i][0]); run1 += lg2(1.0f - kk[i][1]); cb[i][0] = run0; cb[i][1] = run1; }
    *(LAS f32x2*)(part + tg * 128 + 2 * kp) = (f32x2){run0, run1};
    __syncthreads();
    float off0 = 0.f, off1 = 0.f, tot0 = 0.f, tot1 = 0.f;
#pragma unroll
    for (int q = 0; q < 8; ++q) { const f32x2 p = *(const LAS f32x2*)(part + q * 128 + 2 * kp); if (q < tg) { off0 += p.x; off1 += p.y; } tot0 += p.x; tot1 += p.y; }
    if (WRITE && tg == 0) *(f32x2*)(img + IMG_DV + 8 * kp) = (f32x2){ex2(tot0), ex2(tot1)};
    float kh0[8], kh1[8];
#pragma unroll
    for (int i = 0; i < 8; ++i) { const int t = 8 * tg + i; const float b0 = off0 + cb[i][0], b1 = off1 + cb[i][1];
        const unsigned qq = cvt_pk_bf16(qv[i][0] * ex2(b0), qv[i][1] * ex2(b1)), kq = cvt_pk_bf16(kk[i][0] * ex2(-b0), kk[i][1] * ex2(-b1));
        *(LAS unsigned*)(Qt + t * HQ_P + 2 * kp) = qq; *(LAS unsigned*)(Kt + t * HQ_P + 2 * kp) = kq;
        if (WRITE && t < nvalid) *(unsigned*)(qh + (size_t)(row0 + t) * 512 + h * 128 + 2 * kp) = qq;
        kh0[i] = kk[i][0] * ex2(tot0 - b0); kh1[i] = kk[i][1] * ex2(tot1 - b1); }
    if (WRITE) { *(bf16x8*)(img + IMG_KHT + ((2 * kp) * HT_P + 8 * tg) * 2) = pack8(kh0);
    *(bf16x8*)(img + IMG_KHT + ((2 * kp + 1) * HT_P + 8 * tg) * 2) = pack8(kh1); }
    else if (kh0[0] + kh1[7] == 12345.678f) part[0] = kh0[1];
    __syncthreads();
    bf16* sci = (bf16*)(img + IMG_SC);
#pragma unroll
    for (int q = 0; q < 2; ++q) { const int id = 2 * w + q, mt = id >> 2, nt = id & 3;
        f32x4 sc = {0.f, 0.f, 0.f, 0.f};
        if (mt >= nt) {
#pragma unroll
            for (int ks = 0; ks < 4; ++ks) { const bf16x8 a = *(const LAS bf16x8*)(Qt + (16 * mt + l16) * HQ_P + 32 * ks + 8 * g), b = *(const LAS bf16x8*)(Kt + (16 * nt + l16) * HQ_P + 32 * ks + 8 * g);
                sc = __builtin_amdgcn_mfma_f32_16x16x32_bf16(a, b, sc, 0, 0, 0); }
        }
#pragma unroll
        for (int j = 0; j < 4; ++j) { const int t = 16 * mt + 4 * g + j, s_ = 16 * nt + l16; const float v = (t >= s_) ? sc[j] : 0.f;
            if (WRITE || v == 12345.678f) sci[t * HS_P + s_] = (bf16)(cvt_pk_bf16(v, 0.f) & 0xffffu); }
    }
    __syncthreads();
}
constexpr int LS_QT = 0, LS_SG = LS_QT + 64 * HQ_P * 2, LS_IMG = LS_SG + 64 * HQ_P * 2, LS_BUF = LS_IMG + IMG_BYTES, LS_SSQ = 2 * LS_BUF, LS_END = LS_SSQ + 2 * 2048;
static_assert(LS_END <= 131072 && (LS_BUF % 16) == 0, "hgrn scan lds");
#define WG_BAR() do { asm volatile("s_waitcnt lgkmcnt(0)" ::: "memory"); __builtin_amdgcn_s_barrier(); asm volatile("" ::: "memory"); } while (0)
template <bool WRITE> __device__ __forceinline__ void hgrn_scan(ArgsP A, LAS unsigned char* lds, int item, int tid) {
    const int lane = tid & 63, w = __builtin_amdgcn_readfirstlane(tid >> 6), l16 = lane & 15, g = lane >> 4;
    const bool prompt = item < 16; const int sidx = prompt ? (item >> 2) : ((item - 16) >> 2), h = item & 3;
    const int nchunk = prompt ? 65 : 1;
    const bf16* qh = (const bf16*)(A->ws + WS_QH); bf16* oraw = (bf16*)(A->ws + WS_ORAW);
    const unsigned char* imgb = A->ws + WS_IMG + (size_t)(prompt ? (sidx * 4 + h) * 65 : 1040 + (sidx * 4 + h)) * IMG_BYTES;
    const int vcol = 16 * w + l16;
    const bf16* ivtb = prompt ? ((const bf16*)(A->ws + WS_IVTP) + ((size_t)((sidx * 4 + h) * 128 + vcol)) * LP) : ((const bf16*)(A->ws + WS_IVTS) + ((size_t)((sidx * 4 + h) * 128 + vcol)) * 64);
    const float gn = A->in[I_HGN][h * 128 + vcol];
    f32x4 S[8];
    if (prompt) {
#pragma unroll
        for (int mt = 0; mt < 8; ++mt) S[mt] = (f32x4){0.f, 0.f, 0.f, 0.f};
    } else {
        const float* st = A->in[I_ST] + (size_t)(sidx * 4 + h) * 16384;
#pragma unroll
        for (int mt = 0; mt < 8; ++mt)
#pragma unroll
            for (int j = 0; j < 4; ++j) S[mt][j] = st[(size_t)(16 * mt + 4 * g + j) * 128 + vcol];
    }
    const int prow = tid >> 4, pseg = tid & 15;
    const unsigned qoff = (unsigned)(prow * (HQ_P * 2) + pseg * 16);
    const u32x4 Z4 = {0u, 0u, 0u, 0u};
    u32x4 X[8], Y[8];
#define HG_ISSUE(SET, cidx) do { int c_ = (cidx); c_ = c_ < nchunk ? c_ : nchunk - 1; int row0_, nv_, pos0_; hgrn_chunk_params(prompt, sidx, c_, row0_, nv_, pos0_); \
        const size_t go_ = (size_t)(row0_ + prow) * 512 + h * 128 + pseg * 8; \
        _Pragma("unroll") for (int i_ = 0; i_ < 2; ++i_) { const unsigned m_ = (prow + 32 * i_ < nv_) ? 0xffffffffu : 0u; SET[i_] = *(const u32x4*)(qh + go_ + (size_t)i_ * 32 * 512) & m_; } \
        const unsigned char* im_ = imgb + (size_t)c_ * IMG_BYTES + tid * 16; \
        _Pragma("unroll") for (int i_ = 0; i_ < 4; ++i_) SET[4 + i_] = *(const u32x4*)(im_ + 8192 * i_); } while (0)
#define HG_BIV(DST, cidx) do { int c_ = (cidx); c_ = c_ < nchunk ? c_ : nchunk - 1; int row0_, nv_, pos0_; hgrn_chunk_params(prompt, sidx, c_, row0_, nv_, pos0_); \
        _Pragma("unroll") for (int s_ = 0; s_ < 2; ++s_) { const unsigned m_ = (32 * s_ + 8 * g < nv_) ? 0xffffffffu : 0u; DST[s_] = *(const u32x4*)(ivtb + pos0_ + 32 * s_ + 8 * g) & m_; } } while (0)
#define HG_COMMIT(SET, boff) do { LAS unsigned char* b_ = lds + (boff); \
        _Pragma("unroll") for (int i_ = 0; i_ < 2; ++i_) { *(LAS u32x4*)(b_ + LS_QT + qoff + i_ * 32 * HQ_P * 2) = SET[i_]; } \
        _Pragma("unroll") for (int i_ = 0; i_ < 4; ++i_) { if (tid + 512 * i_ < IMG_BYTES / 16) *(LAS u32x4*)(b_ + LS_IMG + tid * 16 + 8192 * i_) = SET[4 + i_]; } } while (0)
#define HG_COMPUTE(cidx, boff, bivc) do { const int c_ = (cidx); int row0_, nv_, pos0_; hgrn_chunk_params(prompt, sidx, c_, row0_, nv_, pos0_); const bool wr_ = !(prompt && c_ == 0); \
        LAS unsigned char* b_ = lds + (boff); const LAS bf16* Qt = (const LAS bf16*)(b_ + LS_QT); const LAS bf16* Sg = (const LAS bf16*)(b_ + LS_SG); \
        const LAS bf16* KhT = (const LAS bf16*)(b_ + LS_IMG + IMG_KHT); const LAS bf16* Sc = (const LAS bf16*)(b_ + LS_IMG + IMG_SC); const LAS float* dv = (const LAS float*)(b_ + LS_IMG + IMG_DV); \
        LAS float* ssq = (LAS float*)(lds + LS_SSQ + (c_ & 1) * 2048); \
        bf16x8 bs[4]; \
        _Pragma("unroll") for (int ks = 0; ks < 4; ++ks) { u32x4 t_; t_.x = cvt_pk_bf16(S[2 * ks][0], S[2 * ks][1]); t_.y = cvt_pk_bf16(S[2 * ks][2], S[2 * ks][3]); t_.z = cvt_pk_bf16(S[2 * ks + 1][0], S[2 * ks + 1][1]); t_.w = cvt_pk_bf16(S[2 * ks + 1][2], S[2 * ks + 1][3]); bs[ks] = __builtin_bit_cast(bf16x8, t_); } \
        const bf16x8 biv0 = __builtin_bit_cast(bf16x8, bivc[0]), biv1 = __builtin_bit_cast(bf16x8, bivc[1]); \
        f32x4 o[4]; \
          \
        _Pragma("unroll") for (int gp = 0; gp < 2; ++gp) { bf16x8 fa[12]; \
            _Pragma("unroll") for (int m2 = 0; m2 < 2; ++m2) { const int mt = 2 * gp + m2; \
                fa[6 * m2 + 0] = *(const LAS bf16x8*)(Sc + (16 * mt + l16) * HS_P + 8 * g); fa[6 * m2 + 1] = *(const LAS bf16x8*)(Sc + (16 * mt + l16) * HS_P + 32 + 8 * g); \
                _Pragma("unroll") for (int ks = 0; ks < 4; ++ks) { const u32x2 lo_ = *(const LAS u32x2*)(Qt + (16 * mt + l16) * HQ_P + 32 * ks + 4 * g), hi_ = *(const LAS u32x2*)(Qt + (16 * mt + l16) * HQ_P + 32 * ks + 16 + 4 * g); \
                    u32x4 t_; t_.x = lo_.x; t_.y = lo_.y; t_.z = hi_.x; t_.w = hi_.y; fa[6 * m2 + 2 + ks] = __builtin_bit_cast(bf16x8, t_); } } \
            __builtin_amdgcn_sched_barrier(0); \
            f32x4 a0 = {0.f, 0.f, 0.f, 0.f}, a1 = {0.f, 0.f, 0.f, 0.f}; \
            a0 = __builtin_amdgcn_mfma_f32_16x16x32_bf16(fa[0], biv0, a0, 0, 0, 0); a1 = __builtin_amdgcn_mfma_f32_16x16x32_bf16(fa[6], biv0, a1, 0, 0, 0); \
            a0 = __builtin_amdgcn_mfma_f32_16x16x32_bf16(fa[1], biv1, a0, 0, 0, 0); a1 = __builtin_amdgcn_mfma_f32_16x16x32_bf16(fa[7], biv1, a1, 0, 0, 0); \
            _Pragma("unroll") for (int ks = 0; ks < 4; ++ks) { a0 = __builtin_amdgcn_mfma_f32_16x16x32_bf16(fa[2 + ks], bs[ks], a0, 0, 0, 0); a1 = __builtin_amdgcn_mfma_f32_16x16x32_bf16(fa[8 + ks], bs[ks], a1, 0, 0, 0); } \
            o[2 * gp] = a0; o[2 * gp + 1] = a1; \
            __builtin_amdgcn_sched_barrier(0); } \
        _Pragma("unroll") for (int gp = 0; gp < 2; ++gp) { bf16x8 fk[8]; f32x4 d4[4]; \
            _Pragma("unroll") for (int m4 = 0; m4 < 4; ++m4) { const int mt = 4 * gp + m4; d4[m4] = *(const LAS f32x4*)(dv + 16 * mt + 4 * g); \
                fk[2 * m4] = *(const LAS bf16x8*)(KhT + (16 * mt + l16) * HT_P + 8 * g); fk[2 * m4 + 1] = *(const LAS bf16x8*)(KhT + (16 * mt + l16) * HT_P + 32 + 8 * g); } \
            __builtin_amdgcn_sched_barrier(0); \
            f32x4 a_[4]; \
            _Pragma("unroll") for (int m4 = 0; m4 < 4; ++m4) a_[m4] = S[4 * gp + m4] * d4[m4]; \
            _Pragma("unroll") for (int m4 = 0; m4 < 4; ++m4) a_[m4] = __builtin_amdgcn_mfma_f32_16x16x32_bf16(fk[2 * m4], biv0, a_[m4], 0, 0, 0); \
            _Pragma("unroll") for (int m4 = 0; m4 < 4; ++m4) a_[m4] = __builtin_amdgcn_mfma_f32_16x16x32_bf16(fk[2 * m4 + 1], biv1, a_[m4], 0, 0, 0); \
            _Pragma("unroll") for (int m4 = 0; m4 < 4; ++m4) S[4 * gp + m4] = a_[m4]; \
            __builtin_amdgcn_sched_barrier(0); } \
        if (wr_) { _Pragma("unroll") for (int mt = 0; mt < 4; ++mt) _Pragma("unroll") for (int j = 0; j < 4; ++j) { const int t = 16 * mt + 4 * g + j; \
            if (t < nv_) oraw[(size_t)(row0_ + t) * 512 + h * 128 + vcol] = (bf16)(cvt_pk_bf16(o[mt][j], 0.f) & 0xffffu); } } \
        WG_BAR(); } while (0)
    u32x4 bivA[2], bivB[2];
    HG_ISSUE(X, 0); HG_BIV(bivA, 0); HG_ISSUE(Y, 1); HG_BIV(bivB, 1);
    HG_COMMIT(X, 0);
    HG_ISSUE(X, 2);
    WG_BAR();
    for (int c = 0; c < nchunk; c += 2) {
        if (c + 1 < nchunk) HG_COMMIT(Y, LS_BUF);
        HG_ISSUE(Y, c + 3);
        HG_COMPUTE(c, 0, bivA);
        HG_BIV(bivA, c + 2);
        if (c + 1 < nchunk) {
            if (c + 2 < nchunk) HG_COMMIT(X, 0);
            HG_ISSUE(X, c + 4);
            HG_COMPUTE(c + 1, LS_BUF, bivB);
            HG_BIV(bivB, c + 3);
        }
    }
#undef HG_ISSUE
#undef HG_BIV
#undef HG_COMMIT
#undef HG_COMPUTE
    float* so = A->out + (prompt ? O_PH : O_SH) + (size_t)(sidx * 4 + h) * 16384;
#pragma unroll
    for (int mt = 0; mt < 8; ++mt)
#pragma unroll
        for (int j = 0; j < 4; ++j) so[(size_t)(16 * mt + 4 * g + j) * 128 + vcol] = S[mt][j];
    WG_BAR();
}

__device__ __forceinline__ void hgrn_finalize(ArgsP A, int gw, int ngw, int lane) {
    const bf16* oraw = (const bf16*)(A->ws + WS_ORAW); bf16* sg = (bf16*)(A->ws + WS_SG); const float* gnp = A->in[I_HGN];
    for (int it = gw; it < MO * 4; it += ngw) { const int row = it >> 2, h = it & 3; const size_t off = (size_t)row * 512 + h * 128 + 2 * lane;
        const unsigned ow = *(const unsigned*)(oraw + off), sw = *(const unsigned*)(sg + off);
        const float o0 = bf2f((unsigned short)(ow & 0xffffu)), o1 = bf2f((unsigned short)(ow >> 16));
        const float tot = wave_sum(o0 * o0 + o1 * o1);
        const float rs = rsqrtf(tot * (1.0f / 128.0f) + EPS);
        const f32x2 gn = *(const f32x2*)(gnp + h * 128 + 2 * lane);
        *(unsigned*)(sg + off) = cvt_pk_bf16(o0 * rs * gn.x * bf2f((unsigned short)(sw & 0xffffu)), o1 * rs * gn.y * bf2f((unsigned short)(sw >> 16))); }
}

#define XB_TMO      128
#define XB_XCNT(j)  (256  + 64 * (j))
#define XB_XSUB(j)  (1280 + 64 * (j))
#define XB_XGEN(j)  (2304 + 64 * (j))
#define XB_TOP      3328
#define XB_TOPGEN   3392
#define XCD_BAR_WORDS 3456
#define XB_SPIN_CAP (1u << 18)

__device__ __forceinline__ unsigned xb_ld(unsigned* p)              { return __hip_atomic_load(p, __ATOMIC_RELAXED, __HIP_MEMORY_SCOPE_AGENT); }
__device__ __forceinline__ unsigned xb_add(unsigned* p, unsigned v) { return __hip_atomic_fetch_add(p, v, __ATOMIC_RELAXED, __HIP_MEMORY_SCOPE_AGENT); }
__device__ __forceinline__ unsigned xb_xcc_id() { return (unsigned)__builtin_amdgcn_s_getreg((3 << 11) | 20) & 0xFu; }
#define XB_SPIN(cond, bar) do { unsigned _sp = 0; while (cond) { __builtin_amdgcn_s_sleep(1); \
    if ((++_sp & 255u) == 0u) { if (xb_ld(&(bar)[XB_TMO])) break; if (_sp > XB_SPIN_CAP) { atomicAdd(&(bar)[XB_TMO], 1u); break; } } } } while (0)

struct XcdBarrier {
    unsigned* bar; unsigned x;
    volatile LAS unsigned* st;
};

__device__ __forceinline__ XcdBarrier xcd_barrier_post(unsigned* bar, volatile LAS unsigned* st) {
    XcdBarrier b; b.bar = bar; b.x = xb_xcc_id(); b.st = st;
    if (threadIdx.x == 0) (void)xb_add(&bar[XB_XCNT(b.x)], 1u);
    return b;
}
__device__ __forceinline__ void xcd_barrier_complete(unsigned* bar, unsigned x, unsigned& nloc, unsigned& nx) {
    const unsigned G = gridDim.x * gridDim.y * gridDim.z;
    unsigned sum, cnt, mine, sp = 0u;
    for (;;) {
        sum = 0u; cnt = 0u; mine = 0u;
#pragma unroll
        for (unsigned j = 0; j < 16; ++j) { const unsigned c = xb_ld(&bar[XB_XCNT(j)]); sum += c; cnt += (c > 0u) ? 1u : 0u; mine = (j == x) ? c : mine; }
        if (sum == G) break;
        __builtin_amdgcn_s_sleep(1);
        if ((++sp & 255u) == 0u) { if (xb_ld(&bar[XB_TMO])) break; if (sp > XB_SPIN_CAP) { atomicAdd(&bar[XB_TMO], 1u); break; } }
    }
    nloc = mine > 0u ? mine : 1u; nx = cnt > 0u ? cnt : 1u;
}

__device__ __forceinline__ void xcd_barrier(const XcdBarrier& b) {
    asm volatile("s_waitcnt vmcnt(0)" ::: "memory");
    __syncthreads();
    if (threadIdx.x == 0) {
        unsigned* bar = b.bar;
        __builtin_amdgcn_s_waitcnt(0);
        unsigned nloc = b.st[0], nx = b.st[1];
        if (nloc == 0u) { xcd_barrier_complete(bar, b.x, nloc, nx); b.st[0] = nloc; b.st[1] = nx; }
        const unsigned old = xb_add(&bar[XB_XSUB(b.x)], 1u);
        const unsigned gen = old / nloc;
        if (old + 1u == (gen + 1u) * nloc) {
            __builtin_amdgcn_fence(__ATOMIC_RELEASE, "agent");
            asm volatile("s_waitcnt vmcnt(0)" ::: "memory");
            const unsigned og = xb_add(&bar[XB_TOP], 1u);
            const unsigned tg = og / nx;
            if (og + 1u == (tg + 1u) * nx) xb_add(&bar[XB_TOPGEN], 1u);
            else XB_SPIN(xb_ld(&bar[XB_TOPGEN]) == tg, bar);
            __builtin_amdgcn_fence(__ATOMIC_ACQUIRE, "agent");
            xb_add(&bar[XB_XGEN(b.x)], 1u);
            asm volatile("s_waitcnt vmcnt(0)" ::: "memory");
        } else {
            XB_SPIN(xb_ld(&bar[XB_XGEN(b.x)]) == gen, bar);
            __builtin_amdgcn_fence(__ATOMIC_ACQUIRE, "agent");
            asm volatile("s_waitcnt vmcnt(0)" ::: "memory");
        }
    }
    __syncthreads();
}

__global__ void __launch_bounds__(NTHREADS, 2) mega_fwd(Args Aunused) {
    extern __shared__ __attribute__((aligned(16))) unsigned char lds_raw[];
    LAS unsigned char* lds = (LAS unsigned char*)lds_raw;
    cg::grid_group grid = cg::this_grid();
#define GRID_SYNC_CG() do { asm volatile("s_waitcnt vmcnt(0)" ::: "memory"); grid.sync(); \
        if (threadIdx.x < 64) { __builtin_amdgcn_fence(__ATOMIC_ACQUIRE, "agent"); asm volatile("s_waitcnt vmcnt(0)" ::: "memory"); } __syncthreads(); } while (0)
#define GRID_SYNC() xcd_barrier(xbar)
    if (threadIdx.x < 2) ((volatile LAS unsigned*)(lds + LDS_BARST))[threadIdx.x] = 0u;
    __syncthreads();
    const XcdBarrier xbar = xcd_barrier_post((unsigned*)(argsp()->ws + WS_CTL), (volatile LAS unsigned*)(lds + LDS_BARST));
#define TIDL ({ int t_ = threadIdx.x; asm volatile("" : "+v"(t_)); t_; })
#define LANE (tid & 63)
#define WAVE (__builtin_amdgcn_readfirstlane(tid >> 6))
#define GX ((int)gridDim.x)
#define BX ((int)blockIdx.x)
#define SSP(A, i) ((float*)((A)->ws + WS_SS + (size_t)(i) * SS_BYTES))

#ifndef REP_P0
#define REP_P0 1
#endif
#ifndef REP_P1
#define REP_P1 1
#endif
#ifndef REP_P2
#define REP_P2 1
#endif
#ifndef REP_SYNC
#define REP_SYNC 0
#endif
    for (int rep = 0; rep < REP_P0; ++rep) {
    { const int tid = TIDL; p0_phase(argsp(), lds, WAVE, LANE); }
    if (argsp()->out == nullptr) GRID_SYNC_CG();
    GRID_SYNC();
    }
    for (int rep = 0; rep < REP_SYNC; ++rep) GRID_SYNC();
    for (int rep = 0; rep < REP_P1; ++rep) {
    { ArgsP A = argsp(); unsigned char* ws = A->ws; pg8::Gemm g{(const bf16*)(ws + WS_XN), (const bf16*)(ws + WS_WGU1), MPAD, 2 * FF, D}; pg8::StaticOrder S; S.init(MPAD, 2 * FF, GX, BX); EpiSwiGLU E{(bf16*)(ws + WS_ACT), SSP(A, 0)};
      pg8::gemm_phase<EpiSwiGLU, pg8::StaticOrder, true, true>(lds, g, S, E); }
    GRID_SYNC();
    }
    for (int rep = 0; rep < REP_P2; ++rep) {
    { ArgsP A = argsp(); unsigned char* ws = A->ws; pg8::Gemm g{(const bf16*)(ws + WS_ACT), (const bf16*)(ws + WS_WD1), MPAD, D, FF}; pg8::TailOrder S; S.init(MP, D, GX, BX, 2, 11);
      EpiResid<1, 1, 1> E{A->in[I_XP], A->in[I_XS], A->in[I_META], A->out, (bf16*)(ws + WS_XN), A->in[I_NMIX], SSP(A, 1), (float*)(ws + WS_SLAB), 2, 64};
      pg8::gemm_phase<EpiResid<1, 1, 1>, pg8::TailOrder, true, true>(lds, g, S, E); }
    GRID_SYNC();
    { const int tid = TIDL; ArgsP A = argsp(); unsigned char* ws = A->ws;
      resid_finish<1, 1, 1>(A->in[I_XP], A->in[I_XS], A->in[I_META], A->out, (bf16*)(ws + WS_XN), A->in[I_NMIX], SSP(A, 1), (const float*)(ws + WS_SLAB), 11, 2, 272, BX * NWAVES + WAVE, GX * NWAVES, LANE); }
    GRID_SYNC();
    }
#ifndef REP_P3
#define REP_P3 1
#endif
#ifndef REP_P34
#define REP_P34 1
#endif
    for (int rep34 = 0; rep34 < REP_P34; ++rep34) {
    for (int rep3 = 0; rep3 < REP_P3; ++rep3) {
    { ArgsP A = argsp(); unsigned char* ws = A->ws; pg8::Gemm g{(const bf16*)(ws + WS_XN), (const bf16*)(ws + WS_WIN), MPAD, NIN, D}; pg8::StaticOrder S; S.init(MPAD, NIN, GX, BX); EpiWin E{ws, A->out, A->in[I_LB], A->in[I_BG], SSP(A, 1)};
      pg8::gemm_phase<EpiWin, pg8::StaticOrder, true, true>(lds, g, S, E); }
    GRID_SYNC();
    }
#ifdef REP_PREP
    { const int tid = TIDL; for (int it = BX; it < NPREP; it += GX) hgrn_prep<false>(argsp(), lds, it, tid); }
#endif
    { const int tid = TIDL; for (int it = BX; it < NPREP; it += GX) hgrn_prep<true>(argsp(), lds, it, tid); }
    GRID_SYNC();
    {
        const int G = GX, bx = BX; const int tid = TIDL;
        const int abase = G > 48 ? 48 : 0, na = G - abase;
#ifdef REP_SCAN
        for (int it = bx; it < 48; it += G) hgrn_scan<false>(argsp(), lds, it, tid);
#endif
        for (int it = bx; it < 48; it += G) hgrn_scan<true>(argsp(), lds, it, tid);
#ifdef REP_ATT
        if (bx >= abase) for (int it = (bx - abase) * NWAVES + WAVE; it < 4160; it += na * NWAVES) attn_item<false>(argsp(), it, LANE);
#endif
        if (bx >= abase) { for (int it = (bx - abase) * NWAVES + WAVE; it < 4160; it += na * NWAVES) attn_item<true>(argsp(), it, LANE);
            p0_weights(argsp(), lds, WAVE, LANE, (bx - abase) * NWAVES + WAVE, na * NWAVES, true); }
    }
    GRID_SYNC();
    { const int tid = TIDL; hgrn_finalize(argsp(), BX * NWAVES + WAVE, GX * NWAVES, LANE); }
    GRID_SYNC();
    }
    { ArgsP A = argsp(); unsigned char* ws = A->ws; const long kst8 = 8 * 128;
      pg8::Gemm g{(const bf16*)(ws + WS_QB), (const bf16*)(ws + WS_WA), MO, D, 512, (long)WS_SG - (long)WS_QB - kst8, (long)WS_WB - (long)WS_WA - kst8, 8, 16};
      pg8::StaticOrder S; S.init(MO, D, GX, BX); EpiMergeF E{(const bf16*)(ws + WS_GA), (const bf16*)(ws + WS_GB), (bf16*)(ws + WS_MRG)};
      pg8::gemm_phase<EpiMergeF, pg8::StaticOrder, true, true>(lds, g, S, E); }
    GRID_SYNC();
    { ArgsP A = argsp(); unsigned char* ws = A->ws; pg8::Gemm g{(const bf16*)(ws + WS_MRG), (const bf16*)(ws + WS_WOUT), MO, D, D}; pg8::StaticOrder S; S.init(MO, D, GX, BX);
      EpiResid<0, 0, 1> E{nullptr, nullptr, nullptr, A->out, (bf16*)(ws + WS_XN), A->in[I_N2], SSP(A, 2), nullptr, 0, 0};
      pg8::gemm_phase<EpiResid<0, 0, 1>, pg8::StaticOrder, true, true>(lds, g, S, E); }
    GRID_SYNC();
#ifndef REP_P7
#define REP_P7 1
#endif
    for (int rep = 0; rep < REP_P7; ++rep) {
    { ArgsP A = argsp(); unsigned char* ws = A->ws; pg8::Gemm g{(const bf16*)(ws + WS_XN), (const bf16*)(ws + WS_WGU2), MO, 2 * FF, D}; pg8::StaticOrder S; S.init(MO, 2 * FF, GX, BX); EpiSwiGLU E{(bf16*)(ws + WS_ACT), SSP(A, 2)};
      pg8::gemm_phase<EpiSwiGLU, pg8::StaticOrder, true, true>(lds, g, S, E); }
    GRID_SYNC();
    }
    { ArgsP A = argsp(); unsigned char* ws = A->ws; pg8::Gemm g{(const bf16*)(ws + WS_ACT), (const bf16*)(ws + WS_WD2), MO, D, FF}; pg8::TailOrder S; S.init(MP, D, GX, BX, 1, 11);
      EpiResid<0, 1, 0> E{nullptr, nullptr, nullptr, A->out, nullptr, nullptr, SSP(A, 3), (float*)(ws + WS_SLAB), 1, 64};
      pg8::gemm_phase<EpiResid<0, 1, 0>, pg8::TailOrder, true, true>(lds, g, S, E); }
    GRID_SYNC();
    { const int tid = TIDL; ArgsP A = argsp(); unsigned char* ws = A->ws;
      resid_finish<0, 1, 0>(nullptr, nullptr, nullptr, A->out, nullptr, nullptr, SSP(A, 3), (const float*)(ws + WS_SLAB), 11, 1, 256, BX * NWAVES + WAVE, GX * NWAVES, LANE); }
    GRID_SYNC();
    {
        const int tid = TIDL; ArgsP A = argsp(); float* X = A->out; const float* SS3 = SSP(A, 3);
        const int gw = BX * NWAVES + WAVE, NGW = GX * NWAVES; const f32x4* gf = (const f32x4*)A->in[I_NF] + LANE;
        for (int m = gw; m < MO; m += NGW) { const float rs = rstd_from_ss(SS3, m); f32x4* x4 = (f32x4*)(X + (size_t)m * D) + LANE;
#pragma unroll
            for (int j = 0; j < 4; ++j) { f32x4 v = x4[64 * j]; const f32x4 gg = gf[64 * j]; x4[64 * j] = v * rs * gg; } }
    }
}

extern "C" void kernel_launch(void* const* d_in, const int* in_sizes, int n_in, void* d_out, int out_size, void* d_ws, size_t ws_size, hipStream_t stream) {
    static int grid = 0;
    if (grid == 0) {
        if (n_in != 23 || ws_size < WS_CTL + CTL_BYTES || out_size != 34930688) { fprintf(stderr, "kernel_launch: unexpected problem shape (n_in %d, out %d, ws %zu)\n", n_in, out_size, ws_size); grid = -1; return; }
        int dev = 0, cus = 0, per_cu = 0;
        hipGetDevice(&dev); hipDeviceGetAttribute(&cus, hipDeviceAttributeMultiprocessorCount, dev);
        hipFuncSetAttribute((const void*)mega_fwd, hipFuncAttributeMaxDynamicSharedMemorySize, LDS_BYTES);
        hipOccupancyMaxActiveBlocksPerMultiprocessor(&per_cu, (const void*)mega_fwd, NTHREADS, LDS_BYTES);
        if (per_cu < 1) { fprintf(stderr, "kernel_launch: occupancy query returned %d\n", per_cu); per_cu = 1; }
        (void)hipGetLastError();
        grid = cus * per_cu;
    }
    if (grid < 0) return;
    if (hipMemsetAsync((char*)d_ws + WS_CTL, 0, CTL_BYTES, stream) != hipSuccess) { fprintf(stderr, "kernel_launch: memset of barrier words failed\n"); return; }
    Args a{};
    for (int i = 0; i < 23; ++i) a.in[i] = (const float*)d_in[i];
    a.out = (float*)d_out; a.ws = (unsigned char*)d_ws;
    void* args[] = {&a};
    hipError_t e = hipLaunchCooperativeKernel((const void*)mega_fwd, dim3(grid), dim3(NTHREADS), args, LDS_BYTES, stream);
    if (e != hipSuccess) fprintf(stderr, "cooperative launch failed: %s (grid %d)\n", hipGetErrorString(e), grid);
}
```

```cpp
#include <hip/hip_runtime.h>
#include <hip/hip_cooperative_groups.h>
#include <cstdio>
#include <cstdint>
namespace cg = cooperative_groups;
namespace pg8 {
#define PG8_LAS __attribute__((address_space(3)))
typedef unsigned short bf16_t;
typedef short bf16x8 __attribute__((ext_vector_type(8)));
typedef float f32x4 __attribute__((ext_vector_type(4)));
typedef unsigned u32x4 __attribute__((ext_vector_type(4)));
constexpr int BM = 256, BK = 64, HALF = 128, HTB = HALF * BK * 2  , STAGE_BYTES = 8 * HTB, NXCD = 8, WGM = 8;

__host__ __device__ __forceinline__ int lds_byte(int r, int c) { const int st = (r >> 4) * 2 + (c >> 5), rr = r & 15, cc = c & 31, ob = rr * 64 + cc * 2; return st * 1024 + (ob ^ (((ob >> 9) & 1) << 5)); }
__host__ __device__ __forceinline__ void stage_rc(int b, int& R, int& C) { const int st = b / 1024, sb = b % 1024, swz = sb ^ (((sb >> 9) & 1) << 5); R = (st >> 1) * 16 + swz / 64; C = (st & 1) * 32 + (swz % 64) / 2; }
__host__ __device__ __forceinline__ int perm32(int rho) { const int n = rho >> 4, i = rho & 15; return 8 * (i >> 2) + 4 * n + (i & 3); }

struct Unit { int pm, pn, kc; };
struct Gemm { const bf16_t* A; const bf16_t* Bt; int M, N, K; long adelta, bdelta; int ksplit, ntk; };

struct StaticOrder {
    int nM, nN, nwg, G, c;
    __host__ __device__ void init(int M, int N, int G_, int c_) { nM = M / BM; nN = N / BM; nwg = nM * nN; G = G_; c = c_; }
    __host__ __device__ bool next(int i, Unit& u) const {
        const long L = (long)i * G + c; if (L >= nwg) return false;
        int wgid = (int)L; { const int q = nwg / NXCD, r = nwg % NXCD, xcd = wgid % NXCD, off = wgid / NXCD; wgid = (xcd < r ? xcd * (q + 1) : r * (q + 1) + (xcd - r) * q) + off; }
        const int nig = WGM * nN, gid = wgid / nig, fm = gid * WGM, gsz = (nM - fm) < WGM ? (nM - fm) : WGM;
        u.pm = fm + ((wgid % nig) % gsz); u.pn = (wgid % nig) / gsz; u.kc = -1; return true;
    }
    __device__ __forceinline__ void a_ready(const Unit&) const {}
    __device__ __forceinline__ void done(const Unit&) const {}
};

__device__ __forceinline__ unsigned cvt_pk_bf16(float lo, float hi) { unsigned r; asm volatile("v_cvt_pk_bf16_f32 %0, %1, %2" : "=v"(r) : "v"(lo), "v"(hi)); return r; }
struct TailOrder {
    StaticOrder so; int nmini, nkc, G, c;
    __host__ __device__ void init(int Mmain, int N, int G_, int c_, int nextra, int nkc_) { so.init(Mmain, N, G_, c_); G = G_; c = c_; nkc = nkc_; nmini = nextra * so.nN * nkc_; }
    __host__ __device__ bool next(int i, Unit& u) const {
        const int cm = c < so.nwg ? (so.nwg - c + G - 1) / G : 0; if (i < cm) return so.next(i, u);
        const int j = (i - cm) * G + c; if (j >= nmini) return false;
        u.kc = j % nkc; u.pn = (j / nkc) % so.nN; u.pm = so.nM + j / (nkc * so.nN); return true; }
    __device__ __forceinline__ void a_ready(const Unit&) const {}
    __device__ __forceinline__ void done(const Unit&) const {}
};
template <class Epi, class Sched, bool ALIGN_EPI = false, bool SP2 = false>
__device__ __forceinline__ void gemm_phase(PG8_LAS unsigned char* lds, const Gemm g, const Sched S, const Epi E) {
    int tid_l = threadIdx.x; asm volatile("" : "+v"(tid_l)); const int tid = tid_l, wid = __builtin_amdgcn_readfirstlane(tid >> 6), lane = tid & 63, wr = wid >> 2, wc = wid & 3, fr = lane & 15, fq = lane >> 4;
    const int K = g.K, nt = g.ntk ? g.ntk : K / BK, ks = g.ksplit ? g.ksplit : 0x7fffffff;
    unsigned voffA[2], voffB[2];
#pragma unroll
    for (int i = 0; i < 2; ++i) { int R, C; stage_rc(tid * 16 + i * 8192, R, C); const int Rb = Epi::PERM ? ((R & ~31) + perm32(R & 31)) : R;
        voffA[i] = (unsigned)(R * K + C) * 2u; voffB[i] = (unsigned)(Rb * K + C) * 2u; }
    const size_t kstep = (size_t)(BK * 2);
    const size_t hstep = (size_t)HALF * K * 2;
    const size_t tstep = 2 * hstep;
    const unsigned ldsw = (unsigned)wid * 1024u;
    const int aoff = lds_byte(wr * 64 + fr, fq * 8), boff = lds_byte(wc * 32 + fr, fq * 8);
#define PG8_SA(b, h) (((b) * 2 + (h)) * HTB)
#define PG8_SB(b, h) ((4 + (b) * 2 + (h)) * HTB)
#define PG8_STAGE(bufoff, gbase, voff) do { _Pragma("unroll") for (int _i = 0; _i < 2; ++_i) \
        __builtin_amdgcn_global_load_lds((const unsigned*)((const char*)(gbase) + (voff)[_i]), (PG8_LAS unsigned*)(lds + (bufoff) + ldsw + _i * 8192), 16, 0, 0); } while (0)
#define PG8_LDA(dst, b, h) do { _Pragma("unroll") for (int m = 0; m < 4; ++m) _Pragma("unroll") for (int k = 0; k < 2; ++k) dst[m][k] = *(const PG8_LAS bf16x8*)(lds + PG8_SA(b, h) + aoff + m * 2048 + k * 1024); } while (0)
#define PG8_LDB(dst, b, h) do { _Pragma("unroll") for (int n = 0; n < 2; ++n) _Pragma("unroll") for (int k = 0; k < 2; ++k) dst[n][k] = *(const PG8_LAS bf16x8*)(lds + PG8_SB(b, h) + boff + n * 2048 + k * 1024); } while (0)
#define PG8_MMA(ai, bj, At, Bt) do { __builtin_amdgcn_s_setprio(1); _Pragma("unroll") for (int m = 0; m < 4; ++m) _Pragma("unroll") for (int n = 0; n < 2; ++n) _Pragma("unroll") for (int k = 0; k < 2; ++k) \
        acc[ai][bj][m][n] = __builtin_amdgcn_mfma_f32_16x16x32_bf16(Bt[n][k], At[m][k], acc[ai][bj][m][n], 0, 0, 0); __builtin_amdgcn_s_setprio(0); } while (0)
#define PG8_WAIT_V(n) asm volatile("s_waitcnt vmcnt(" #n ")" ::: "memory")
#define PG8_WAIT_L(n) asm volatile("s_waitcnt lgkmcnt(" #n ")" ::: "memory")
#define PG8_BAR __builtin_amdgcn_s_barrier()
#define PG8_SCHED __builtin_amdgcn_sched_barrier(0)
    Unit cur, nxt; nxt.pm = 0; nxt.pn = 0; nxt.kc = -1; int ui = 0;
    if (!S.next(0, cur)) return;
    f32x4 acc[2][2][4][2];
#pragma unroll
    for (int a = 0; a < 2; ++a)
#pragma unroll
        for (int b = 0; b < 2; ++b)
#pragma unroll
            for (int m = 0; m < 4; ++m)
#pragma unroll
                for (int n = 0; n < 2; ++n) acc[a][b][m][n] = (f32x4){0.f, 0.f, 0.f, 0.f};
    bf16x8 At[4][2], B0[2][2], B1[2][2];
    const char* cA = (const char*)g.A + (size_t)cur.pm * tstep + (cur.kc < 0 ? 0 : cur.kc * 512); const char* cB = (const char*)g.Bt + (size_t)cur.pn * tstep + (cur.kc < 0 ? 0 : cur.kc * 512);
    S.a_ready(cur);
    if constexpr (SP2) {
        PG8_STAGE(PG8_SB(0, 0), cB, voffB); PG8_STAGE(PG8_SB(0, 1), cB + hstep, voffB); PG8_STAGE(PG8_SA(0, 0), cA, voffA); PG8_STAGE(PG8_SA(0, 1), cA + hstep, voffA);
        if (wr == 1) PG8_BAR;
        PG8_WAIT_V(2); PG8_BAR;
        PG8_STAGE(PG8_SB(1, 0), cB + kstep, voffB); PG8_STAGE(PG8_SA(1, 0), cA + kstep, voffA); PG8_STAGE(PG8_SB(1, 1), cB + hstep + kstep, voffB);
        PG8_WAIT_V(6); PG8_BAR;
    } else {
        PG8_STAGE(PG8_SB(0, 0), cB, voffB); PG8_STAGE(PG8_SA(0, 0), cA, voffA); PG8_STAGE(PG8_SB(0, 1), cB + hstep, voffB); PG8_STAGE(PG8_SA(0, 1), cA + hstep, voffA);
        if (wr == 1) PG8_BAR;
        PG8_WAIT_V(4); PG8_BAR;
        PG8_STAGE(PG8_SB(1, 0), cB + kstep, voffB); PG8_STAGE(PG8_SA(1, 0), cA + kstep, voffA); PG8_STAGE(PG8_SB(1, 1), cB + hstep + kstep, voffB);
        PG8_WAIT_V(6); PG8_BAR;
    }
    for (;;) {
        const bool has_next = S.next(ui + 1, nxt);
        const int nk0 = nxt.kc < 0 ? 0 : nxt.kc * 512;
        const char* nA = has_next ? (const char*)g.A + (size_t)nxt.pm * tstep + nk0 : cA; const char* nB = has_next ? (const char*)g.Bt + (size_t)nxt.pn * tstep + nk0 : cB;
        const int unt = cur.kc < 0 ? nt : 4;
        for (int t = 0; t < unt; t += 2) {
            const bool last = (t == unt - 2);
            if constexpr (Epi::HAS_MID) { if (t == ks) E.mid(acc, cur, wr, wc, fr, fq); }
            const char* a1 = cA + (size_t)(t + 1) * kstep + (t + 1 >= ks ? g.adelta : 0);
            const char* a2 = last ? nA : cA + (size_t)(t + 2) * kstep + (t + 2 >= ks ? g.adelta : 0); const char* b2 = last ? nB : cB + (size_t)(t + 2) * kstep + (t + 2 >= ks ? g.bdelta : 0);
            const char* a3 = a2 + kstep; const char* b3 = b2 + kstep;
            if (last && has_next) S.a_ready(nxt);
            if constexpr (SP2) {
            PG8_LDB(B0, 0, 0); PG8_LDB(B1, 0, 1); PG8_SCHED; PG8_LDA(At, 0, 0); PG8_STAGE(PG8_SA(1, 1), a1 + hstep, voffA);
            PG8_WAIT_V(8); PG8_WAIT_L(0); PG8_BAR; PG8_MMA(0, 0, At, B0); PG8_MMA(0, 1, At, B1); PG8_BAR; PG8_SCHED;
            PG8_LDA(At, 0, 1); PG8_STAGE(PG8_SB(0, 0), b2, voffB); PG8_STAGE(PG8_SB(0, 1), b2 + hstep, voffB); PG8_STAGE(PG8_SA(0, 0), a2, voffA);
            PG8_WAIT_V(8); PG8_WAIT_L(0); PG8_BAR; PG8_MMA(1, 0, At, B0); PG8_MMA(1, 1, At, B1); PG8_BAR; PG8_SCHED;
            PG8_LDB(B0, 1, 0); PG8_LDB(B1, 1, 1); PG8_SCHED; PG8_LDA(At, 1, 0); PG8_STAGE(PG8_SA(0, 1), a2 + hstep, voffA);
            PG8_WAIT_V(8); PG8_WAIT_L(0); PG8_BAR; PG8_MMA(0, 0, At, B0); PG8_MMA(0, 1, At, B1); PG8_BAR; PG8_SCHED;
            PG8_LDA(At, 1, 1); PG8_STAGE(PG8_SB(1, 0), b3, voffB); PG8_STAGE(PG8_SB(1, 1), b3 + hstep, voffB); PG8_STAGE(PG8_SA(1, 0), a3, voffA);
            PG8_WAIT_V(8); PG8_WAIT_L(0); PG8_BAR; PG8_MMA(1, 0, At, B0); PG8_MMA(1, 1, At, B1); PG8_BAR; PG8_SCHED;
            } else {
            PG8_LDB(B0, 0, 0); PG8_SCHED; PG8_LDA(At, 0, 0); PG8_STAGE(PG8_SA(1, 1), a1 + hstep, voffA);
            PG8_WAIT_L(8); PG8_BAR; PG8_WAIT_L(0); PG8_MMA(0, 0, At, B0); PG8_BAR; PG8_SCHED;
            PG8_LDB(B1, 0, 1); PG8_STAGE(PG8_SB(0, 0), b2, voffB);
            PG8_BAR; PG8_WAIT_L(0); PG8_MMA(0, 1, At, B1); PG8_BAR;
            PG8_LDA(At, 0, 1); PG8_STAGE(PG8_SA(0, 0), a2, voffA);
            PG8_BAR; PG8_WAIT_L(0); PG8_MMA(1, 0, At, B0); PG8_BAR; PG8_SCHED;
            PG8_STAGE(PG8_SB(0, 1), b2 + hstep, voffB);
            PG8_WAIT_V(6); PG8_BAR; PG8_MMA(1, 1, At, B1); PG8_BAR;
            PG8_LDB(B0, 1, 0); PG8_SCHED; PG8_LDA(At, 1, 0); PG8_STAGE(PG8_SA(0, 1), a2 + hstep, voffA);
            PG8_WAIT_L(8); PG8_BAR; PG8_WAIT_L(0); PG8_MMA(0, 0, At, B0); PG8_BAR; PG8_SCHED;
            PG8_LDB(B1, 1, 1); PG8_STAGE(PG8_SB(1, 0), b3, voffB);
            PG8_BAR; PG8_WAIT_L(0); PG8_MMA(0, 1, At, B1); PG8_BAR;
            PG8_LDA(At, 1, 1); PG8_STAGE(PG8_SA(1, 0), a3, voffA);
            PG8_BAR; PG8_WAIT_L(0); PG8_MMA(1, 0, At, B0); PG8_BAR; PG8_SCHED;
            PG8_STAGE(PG8_SB(1, 1), b3 + hstep, voffB);
            PG8_WAIT_V(6); PG8_BAR; PG8_MMA(1, 1, At, B1); PG8_BAR;
            }
        }
        if constexpr (ALIGN_EPI) { if (wr == 0) PG8_BAR; }
        if constexpr (!Epi::AFTER_DRAIN) { E(acc, cur, wr, wc, fr, fq); S.done(cur); }
        if (!has_next) break;
#pragma unroll
        for (int a = 0; a < 2; ++a)
#pragma unroll
            for (int b = 0; b < 2; ++b)
#pragma unroll
                for (int m = 0; m < 4; ++m)
#pragma unroll
                    for (int n = 0; n < 2; ++n) acc[a][b][m][n] = (f32x4){0.f, 0.f, 0.f, 0.f};
        cur = nxt; cA = nA; cB = nB; ++ui;
        if constexpr (ALIGN_EPI) { if (wr == 1) PG8_BAR; }
    }
    PG8_WAIT_V(0);
    if constexpr (!ALIGN_EPI) { if (wr == 0) PG8_BAR; }
    PG8_BAR;
    if constexpr (Epi::AFTER_DRAIN) { E.fused(acc, cur, wr, wc, fr, fq, lds, wid, lane); S.done(cur); }
#undef PG8_SA
#undef PG8_SB
#undef PG8_STAGE
#undef PG8_LDA
#undef PG8_LDB
#undef PG8_MMA
#undef PG8_WAIT_V
#undef PG8_WAIT_L
#undef PG8_BAR
#undef PG8_SCHED
}
}

#define LAS __attribute__((address_space(3)))
typedef unsigned short bf16;
typedef float f32x4 __attribute__((ext_vector_type(4)));
typedef float f32x16 __attribute__((ext_vector_type(16)));
typedef short bf16x8 __attribute__((ext_vector_type(8)));
typedef unsigned u32x4 __attribute__((ext_vector_type(4)));
typedef unsigned u32x2 __attribute__((ext_vector_type(2)));
typedef float f32x2 __attribute__((ext_vector_type(2)));
using pg8::cvt_pk_bf16;

constexpr int NWAVES = 8, NTHREADS = 512;
constexpr int D = 1024, FF = 2816, NIN = 5632;
constexpr int MP = 16384;
constexpr int MS = 256;
constexpr int MO = MP + MS;
constexpr int MX = MO + 16;
constexpr int MPAD = 16896;
constexpr int LP = 4112;
constexpr int LC = 2064;
constexpr float EPS = 1e-6f;
constexpr float LOG2E = 1.4426950408889634f;
constexpr float QSCALE = 0.125f * LOG2E;
constexpr float SB_EXIT = 152.0f;

constexpr size_t O_YP = 0, O_YS = 16777216, O_PK = 17039360, O_PV = 25460736, O_PH = 33882112, O_SK = 34144256, O_SV = 34275328, O_SH = 34406400;
constexpr size_t WS_WGU1 = 0, WS_WD1 = 11534336, WS_WIN = 17301504, WS_WA = 28835840, WS_WB = 29884416, WS_WOUT = 30932992, WS_WGU2 = 33030144, WS_WD2 = 44564480;
constexpr size_t WS_SS = 50331648, SS_BYTES = (size_t)MPAD * 16 * 4;
constexpr size_t WS_XN = 54657024, WS_ACT = 89260032;
constexpr size_t WS_KKH = 184418304, WS_QB = 201719808, WS_QH = 219021312, WS_IVTP = 236322816, WS_IVTS = 253165568, WS_END = 253689856;
constexpr size_t WS_GA = WS_ACT, WS_GB = WS_ACT + 34603008, WS_SG = WS_ACT + 69206016;
constexpr int LDS_BYTES = 147456;
constexpr size_t WS_MRG = 219021312;
constexpr size_t WS_SLAB = 219021312;
constexpr size_t WS_CTL = 253689856, CTL_BYTES = 16384;
constexpr int LDS_BARST = 131072 + 64;

struct Args { const float* in[23]; float* out; unsigned char* ws; };
typedef const Args __attribute__((address_space(4)))* ArgsP;
__device__ __forceinline__ ArgsP argsp() { ArgsP p = (ArgsP)__builtin_amdgcn_kernarg_segment_ptr(); asm volatile("" : "+s"(p)); return p; }
enum { I_XP = 0, I_XS, I_CK, I_CV, I_ST, I_META, I_N1, I_WG1, I_WU1, I_WD1, I_NMIX, I_WIN, I_BG, I_LB, I_HGN, I_WA, I_WB, I_WOUT, I_N2, I_WG2, I_WU2, I_WD2, I_NF };

__device__ __forceinline__ float wave_sum(float v) {
#pragma unroll
    for (int o = 1; o < 64; o <<= 1) v += __shfl_xor(v, o);
    return v;
}
__device__ __forceinline__ float ex2(float x) { return __builtin_amdgcn_exp2f(x); }
__device__ __forceinline__ float lg2(float x) { return __builtin_amdgcn_logf(x); }
__device__ __forceinline__ float sigmoidf_(float x) { return 1.0f / (1.0f + ex2(-x * LOG2E)); }
__device__ __forceinline__ float rstd_from_ss(const float* ss, int r) {
    const f32x4* p = (const f32x4*)(ss + (size_t)r * 16);
    f32x4 a = p[0], b = p[1], c = p[2], d = p[3];
    float s = ((a.x + a.y) + (a.z + a.w)) + ((b.x + b.y) + (b.z + b.w)) + ((c.x + c.y) + (c.z + c.w)) + ((d.x + d.y) + (d.z + d.w));
    return rsqrtf(s * (1.0f / 1024.0f) + EPS);
}
__device__ __forceinline__ const float* xin_row(ArgsP A, int r) {
    if (r < MP) return A->in[I_XP] + (size_t)r * D;
    if (r < MO) return A->in[I_XS] + (size_t)(r - MP) * D;
    if (r < MX) return A->in[I_META] + (size_t)(r - MO) * D;
    return nullptr;
}

__device__ __forceinline__ void p0_transpose_item(const float* W, int K, int N, bf16* WT, int il, LAS float* scr, int item, int lane) {
    const int nblk = N / 32, kb = item / nblk, nb = item % nblk, k0 = 64 * kb, n0 = 32 * nb;
#pragma unroll 8
    for (int i = 0; i < 32; ++i) { const int kk = 2 * i + (lane >> 5); scr[kk * 33 + (lane & 31)] = W[(size_t)(k0 + kk) * N + n0 + (lane & 31)]; }
    asm volatile("s_waitcnt lgkmcnt(0)" ::: "memory");
    const int rbase = il == 0 ? n0 : ((n0 >> 7) * 256 + (n0 & 127) + (il == 2 ? 128 : 0));
    const int c = lane & 7;
#pragma unroll
    for (int j = 0; j < 4; ++j) { const int n = (lane >> 3) + 8 * j; const LAS float* s = scr + (8 * c) * 33 + n;
        u32x4 o; o.x = cvt_pk_bf16(s[0 * 33], s[1 * 33]); o.y = cvt_pk_bf16(s[2 * 33], s[3 * 33]); o.z = cvt_pk_bf16(s[4 * 33], s[5 * 33]); o.w = cvt_pk_bf16(s[6 * 33], s[7 * 33]);
        *(u32x4*)(WT + (size_t)(rbase + n) * K + k0 + 8 * c) = o; }
    asm volatile("s_waitcnt lgkmcnt(0)" ::: "memory");
}
__device__ __forceinline__ void p0_weights(ArgsP A, LAS unsigned char* lds, int wave, int lane, int gw, int NGW, bool late) {
    LAS float* scr = (LAS float*)(lds + wave * 16384);
    unsigned char* ws = A->ws;
    constexpr int I_GU = (D / 64) * (FF / 32), I_DN = (FF / 64) * (D / 32), I_IN = (D / 64) * (NIN / 32), I_BR = (512 / 64) * (D / 32), I_OU = (D / 64) * (D / 32);
    constexpr int N_EARLY = 2 * I_GU + I_DN + I_IN, N_LATE = 2 * I_BR + I_OU + 2 * I_GU + I_DN;
    if (!late) {
        for (int it = gw; it < N_EARLY; it += NGW) {
            int r = it;
            if (r < I_GU) { p0_transpose_item(A->in[I_WG1], D, FF, (bf16*)(ws + WS_WGU1), 1, scr, r, lane); continue; } r -= I_GU;
            if (r < I_GU) { p0_transpose_item(A->in[I_WU1], D, FF, (bf16*)(ws + WS_WGU1), 2, scr, r, lane); continue; } r -= I_GU;
            if (r < I_DN) { p0_transpose_item(A->in[I_WD1], FF, D, (bf16*)(ws + WS_WD1), 0, scr, r, lane); continue; } r -= I_DN;
            p0_transpose_item(A->in[I_WIN], D, NIN, (bf16*)(ws + WS_WIN), 0, scr, r, lane);
        }
    } else {
        for (int it = gw; it < N_LATE; it += NGW) {
            int r = it;
            if (r < I_BR) { p0_transpose_item(A->in[I_WA], 512, D, (bf16*)(ws + WS_WA), 0, scr, r, lane); continue; } r -= I_BR;
            if (r < I_BR) { p0_transpose_item(A->in[I_WB], 512, D, (bf16*)(ws + WS_WB), 0, scr, r, lane); continue; } r -= I_BR;
            if (r < I_OU) { p0_transpose_item(A->in[I_WOUT], D, D, (bf16*)(ws + WS_WOUT), 0, scr, r, lane); continue; } r -= I_OU;
            if (r < I_GU) { p0_transpose_item(A->in[I_WG2], D, FF, (bf16*)(ws + WS_WGU2), 1, scr, r, lane); continue; } r -= I_GU;
            if (r < I_GU) { p0_transpose_item(A->in[I_WU2], D, FF, (bf16*)(ws + WS_WGU2), 2, scr, r, lane); continue; } r -= I_GU;
            p0_transpose_item(A->in[I_WD2], FF, D, (bf16*)(ws + WS_WD2), 0, scr, r, lane);
        }
    }
}
__device__ __forceinline__ void p0_phase(ArgsP A, LAS unsigned char* lds, int wave, int lane) {
    const int G = gridDim.x, gw = blockIdx.x * NWAVES + wave, NGW = G * NWAVES;
    unsigned char* ws = A->ws;
    p0_weights(A, lds, wave, lane, gw, NGW, false);
    bf16* XN = (bf16*)(ws + WS_XN); float* SS0 = (float*)(ws + WS_SS);
    const f32x4* g1 = (const f32x4*)A->in[I_N1] + lane;
    for (int m = gw; m < MPAD; m += NGW) {
        const float* xr = xin_row(A, m);
        unsigned long long* o8 = (unsigned long long*)(XN + (size_t)m * D) + lane;
        float s = 0.f;
        if (xr) {
            const f32x4* x4 = (const f32x4*)xr + lane;
#pragma unroll
            for (int j = 0; j < 4; ++j) { f32x4 v = x4[64 * j]; const f32x4 g = g1[64 * j]; s += (v.x * v.x + v.y * v.y) + (v.z * v.z + v.w * v.w);
                o8[64 * j] = (unsigned long long)cvt_pk_bf16(v.x * g.x, v.y * g.y) | ((unsigned long long)cvt_pk_bf16(v.z * g.z, v.w * g.w) << 32); }
        } else {
#pragma unroll
            for (int j = 0; j < 4; ++j) o8[64 * j] = 0ull;
        }
        s = wave_sum(s);
        if (lane < 16) SS0[(size_t)m * 16 + lane] = lane == 0 ? s : 0.f;
    }
}

struct EpiSwiGLU {
    static constexpr bool PERM = true, AFTER_DRAIN = false, HAS_MID = false;
    bf16* act; const float* ss;
    __device__ __forceinline__ void operator()(const f32x4 (&acc)[2][2][4][2], const pg8::Unit& u, int wr, int wc, int fr, int fq) const {
        const int col0 = u.pn * 128 + wc * 32 + 8 * fq;
#pragma unroll
        for (int ai = 0; ai < 2; ++ai)
#pragma unroll
            for (int m = 0; m < 4; ++m) {
                const int r = u.pm * 256 + ai * 128 + wr * 64 + m * 16 + fr;
                const float rs = rstd_from_ss(ss, r);
                float o[8];
#pragma unroll
                for (int n = 0; n < 2; ++n)
#pragma unroll
                    for (int e = 0; e < 4; ++e) { const float g = acc[ai][0][m][n][e] * rs, up = acc[ai][1][m][n][e] * rs; o[4 * n + e] = g * up / (1.0f + ex2(-g * LOG2E)); }
                u32x4 w; w.x = cvt_pk_bf16(o[0], o[1]); w.y = cvt_pk_bf16(o[2], o[3]); w.z = cvt_pk_bf16(o[4], o[5]); w.w = cvt_pk_bf16(o[6], o[7]);
                *(u32x4*)(act + (size_t)r * FF + col0) = w;
            }
    }
};
template <int SRC_INPUTS, int HALF_SCALE, int HAS_XN> struct EpiResid {
    static constexpr bool PERM = false, AFTER_DRAIN = false, HAS_MID = false;
    const float* xp; const float* xs; const float* xm; float* X; bf16* XN; const float* gnext; float* ss; float* slab; int ntile, pm0;
    __device__ __forceinline__ void operator()(const f32x4 (&acc)[2][2][4][2], const pg8::Unit& u, int wr, int wc, int fr, int fq) const {
        const int col0 = u.pn * 256 + wc * 32 + 4 * fq;
        if (u.kc >= 0) {
            float* sl = slab + ((size_t)(u.kc * ntile + (u.pm - pm0)) * 256) * 1024;
#pragma unroll
            for (int ai = 0; ai < 2; ++ai)
#pragma unroll
                for (int m = 0; m < 4; ++m)
#pragma unroll
                    for (int bj = 0; bj < 2; ++bj)
#pragma unroll
                        for (int n = 0; n < 2; ++n) *(f32x4*)(sl + (size_t)(ai * 128 + wr * 64 + m * 16 + fr) * 1024 + col0 + bj * 128 + n * 16) = acc[ai][bj][m][n];
            return;
        }
#pragma unroll
        for (int ai = 0; ai < 2; ++ai)
#pragma unroll
            for (int m = 0; m < 4; ++m) {
                const int r = u.pm * 256 + ai * 128 + wr * 64 + m * 16 + fr;
                const float* srow = SRC_INPUTS ? (r < MP ? xp + (size_t)r * D : (r < MO ? xs + (size_t)(r - MP) * D : (r < MX ? xm + (size_t)(r - MO) * D : nullptr))) : (X + (size_t)r * D);
                float s = 0.f;
#pragma unroll
                for (int bj = 0; bj < 2; ++bj)
#pragma unroll
                    for (int n = 0; n < 2; ++n) {
                        const int c = col0 + bj * 128 + n * 16;
                        f32x4 v = acc[ai][bj][m][n] * (HALF_SCALE ? 0.5f : 1.0f);
                        if (srow) v += *(const f32x4*)(srow + c);
                        s += (v.x * v.x + v.y * v.y) + (v.z * v.z + v.w * v.w);
                        if (r < MO) *(f32x4*)(X + (size_t)r * D + c) = v;
                        if (HAS_XN) { const f32x4 g = *(const f32x4*)(gnext + c); u32x2 w; w.x = cvt_pk_bf16(v.x * g.x, v.y * g.y); w.y = cvt_pk_bf16(v.z * g.z, v.w * g.w); *(u32x2*)(XN + (size_t)r * D + c) = w; }
                    }
                s += __shfl_xor(s, 16); s += __shfl_xor(s, 32);
                if (fq == 0) ss[(size_t)r * 16 + u.pn * 4 + wc] = s;
            }
    }
};
template <int SRC_INPUTS, int HALF_SCALE, int HAS_XN> __device__ __forceinline__ void resid_finish(const float* xp, const float* xs, const float* xm, float* X, bf16* XN, const float* gnext, float* ss,
                                                                                                   const float* slab, int nkc, int ntile, int nrows, int gw, int ngw, int lane) {
    for (int rr = gw; rr < nrows; rr += ngw) { const int r = MP + rr;
        const float* srow = SRC_INPUTS ? (r < MO ? xs + (size_t)(r - MP) * D : xm + (size_t)(r - MO) * D) : (X + (size_t)r * D);
        float s = 0.f;
#pragma unroll
        for (int j = 0; j < 4; ++j) { const int c = 4 * lane + 256 * j; f32x4 a = {0.f, 0.f, 0.f, 0.f};
            for (int kc = 0; kc < nkc; ++kc) a += *(const f32x4*)(slab + ((size_t)kc * ntile * 256 + rr) * 1024 + c);
            f32x4 v = a * (HALF_SCALE ? 0.5f : 1.0f) + *(const f32x4*)(srow + c);
            s += (v.x * v.x + v.y * v.y) + (v.z * v.z + v.w * v.w);
            if (r < MO) *(f32x4*)(X + (size_t)r * D + c) = v;
            if (HAS_XN) { const f32x4 g = *(const f32x4*)(gnext + c); u32x2 w; w.x = cvt_pk_bf16(v.x * g.x, v.y * g.y); w.y = cvt_pk_bf16(v.z * g.z, v.w * g.w); *(u32x2*)(XN + (size_t)r * D + c) = w; } }
        s = wave_sum(s);
        if (lane < 16) ss[(size_t)r * 16 + lane] = lane == 0 ? s : 0.f; }
}
struct EpiWin {
    static constexpr bool PERM = false, AFTER_DRAIN = false, HAS_MID = false;
    unsigned char* ws; float* out; const float* lbp; const float* bgp; const float* ss;
    template <int TYPE> __device__ __forceinline__ void run(const f32x4 (&acc)[2][2][4][2], const pg8::Unit& u, int wr, int wc, int fr, int fq, int cbase) const {
        const int col0 = u.pn * 256 + wc * 32 + 4 * fq - cbase;
#pragma unroll
        for (int ai = 0; ai < 2; ++ai)
#pragma unroll
            for (int m = 0; m < 4; ++m) {
                const int r = u.pm * 256 + ai * 128 + wr * 64 + m * 16 + fr;
                const int rlim = (TYPE == 0 || TYPE >= 6) ? MO : MX;
                if (r < rlim) {
                const float rs = rstd_from_ss(ss, r);
#pragma unroll
                for (int bj = 0; bj < 2; ++bj)
#pragma unroll
                    for (int n = 0; n < 2; ++n) {
                        const int cc = col0 + bj * 128 + n * 16;
                        const f32x4 v = acc[ai][bj][m][n] * rs;
                        if (TYPE == 0) {
                            u32x2 w; w.x = cvt_pk_bf16(v.x * QSCALE, v.y * QSCALE); w.y = cvt_pk_bf16(v.z * QSCALE, v.w * QSCALE); *(u32x2*)((bf16*)(ws + WS_QB) + (size_t)r * 512 + cc) = w;
                        } else if (TYPE == 1 || TYPE == 2) {
                            const size_t ob = TYPE == 2 ? O_PV : O_PK, os = TYPE == 2 ? O_SV : O_SK;
                            if (r < MP) { const int b = r >> 12, t = r & 4095; *(f32x4*)(out + ob + ((size_t)(b * LP + 16 + t)) * 512 + cc) = v; }
                            else if (r < MO) { *(f32x4*)(out + os + (size_t)(r - MP) * 512 + cc) = v; }
                            else { const int mm = r - MO;
#pragma unroll
                                for (int b = 0; b < 4; ++b) *(f32x4*)(out + ob + ((size_t)(b * LP + mm)) * 512 + cc) = v; }
                        } else if (TYPE == 3) {
                            const f32x4 l0 = *(const f32x4*)(lbp + cc), l1 = *(const f32x4*)(lbp + 512 + cc);
                            _Float16 h[4];
#pragma unroll
                            for (int e = 0; e < 4; ++e) { const float oml = 1.0f / (1.0f + ex2((l1[e] - l0[e]) * LOG2E));
                                h[e] = (_Float16)(oml / (1.0f + ex2(v[e] * LOG2E))); }
                            u32x2 w; w.x = (unsigned)__builtin_bit_cast(unsigned short, h[0]) | ((unsigned)__builtin_bit_cast(unsigned short, h[1]) << 16);
                            w.y = (unsigned)__builtin_bit_cast(unsigned short, h[2]) | ((unsigned)__builtin_bit_cast(unsigned short, h[3]) << 16);
                            *(u32x2*)((unsigned short*)(ws + WS_KKH) + (size_t)r * 512 + cc) = w;
                        } else if (TYPE == 4) {
                            const int h = cc >> 7, vv = cc & 127;
                            const unsigned w01 = cvt_pk_bf16(v.x, v.y), w23 = cvt_pk_bf16(v.z, v.w);
                            const bf16 e0 = (bf16)(w01 & 0xffffu), e1 = (bf16)(w01 >> 16), e2 = (bf16)(w23 & 0xffffu), e3 = (bf16)(w23 >> 16);
                            if (r < MP) { const int b = r >> 12, t = r & 4095; bf16* p = (bf16*)(ws + WS_IVTP) + ((size_t)((b * 4 + h) * 128 + vv)) * LP + 16 + t; p[0] = e0; p[LP] = e1; p[2 * LP] = e2; p[3 * LP] = e3; }
                            else if (r < MO) { const int s = (r - MP) >> 5, t = (r - MP) & 31; bf16* p = (bf16*)(ws + WS_IVTS) + ((size_t)((s * 4 + h) * 128 + vv)) * 64 + t; p[0] = e0; p[64] = e1; p[128] = e2; p[192] = e3; }
                            else { const int mm = r - MO;
#pragma unroll
                                for (int b = 0; b < 4; ++b) { bf16* p = (bf16*)(ws + WS_IVTP) + ((size_t)((b * 4 + h) * 128 + vv)) * LP + mm; p[0] = e0; p[LP] = e1; p[2 * LP] = e2; p[3 * LP] = e3; } }
                        } else if (TYPE == 5) {
                            u32x2 w; w.x = cvt_pk_bf16(v.x, v.y); w.y = cvt_pk_bf16(v.z, v.w); *(u32x2*)((bf16*)(ws + WS_QH) + (size_t)r * 512 + cc) = w;
                        } else if (TYPE == 6) {
                            float o[4];
#pragma unroll
                            for (int e = 0; e < 4; ++e) o[e] = v[e] / (1.0f + ex2(-v[e] * LOG2E));
                            u32x2 w; w.x = cvt_pk_bf16(o[0], o[1]); w.y = cvt_pk_bf16(o[2], o[3]); *(u32x2*)((bf16*)(ws + WS_SG) + (size_t)r * 512 + cc) = w;
                        } else {
                            const f32x4 bg = *(const f32x4*)(bgp + (TYPE == 8 ? 1024 : 0) + cc); float o[4];
#pragma unroll
                            for (int e = 0; e < 4; ++e) o[e] = 1.0f / (1.0f + ex2(-(v[e] + bg[e]) * LOG2E));
                            u32x2 w; w.x = cvt_pk_bf16(o[0], o[1]); w.y = cvt_pk_bf16(o[2], o[3]); *(u32x2*)((bf16*)(ws + (TYPE == 8 ? WS_GB : WS_GA)) + (size_t)r * D + cc) = w;
                        }
                    }
                }
            }
    }
    __device__ __forceinline__ void operator()(const f32x4 (&acc)[2][2][4][2], const pg8::Unit& u, int wr, int wc, int fr, int fq) const {
        const int pn = u.pn;
        if (pn < 2) run<0>(acc, u, wr, wc, fr, fq, 0);
        else if (pn < 4) run<1>(acc, u, wr, wc, fr, fq, 512);
        else if (pn < 6) run<2>(acc, u, wr, wc, fr, fq, 1024);
        else if (pn < 8) run<3>(acc, u, wr, wc, fr, fq, 1536);
        else if (pn < 10) run<4>(acc, u, wr, wc, fr, fq, 2048);
        else if (pn < 12) run<5>(acc, u, wr, wc, fr, fq, 2560);
        else if (pn < 14) run<6>(acc, u, wr, wc, fr, fq, 3072);
        else if (pn < 18) run<7>(acc, u, wr, wc, fr, fq, 3584);
        else run<8>(acc, u, wr, wc, fr, fq, 4608);
    }
};
__device__ __forceinline__ float bf2f(unsigned short h) { return __builtin_bit_cast(float, (unsigned)h << 16); }
__device__ __forceinline__ float bf2f(unsigned h) { return __builtin_bit_cast(float, h << 16); }
struct EpiMergeF {
    static constexpr bool PERM = false, AFTER_DRAIN = false, HAS_MID = true;
    const bf16* ga; const bf16* gb; bf16* merged;
    __device__ __forceinline__ void mid(f32x4 (&acc)[2][2][4][2], const pg8::Unit& u, int wr, int wc, int fr_in, int fq_in) const {
        int fr = fr_in, fq = fq_in; asm volatile("" : "+v"(fr), "+v"(fq));
        const int col0 = u.pn * 256 + wc * 32 + 4 * fq;
#pragma unroll
        for (int ai = 0; ai < 2; ++ai)
#pragma unroll
            for (int m = 0; m < 4; ++m) {
                const size_t ro = (size_t)(u.pm * 256 + ai * 128 + wr * 64 + m * 16 + fr) * D + col0;
#pragma unroll
                for (int bj = 0; bj < 2; ++bj) { u32x2 wa[2], wb[2];
#pragma unroll
                    for (int n = 0; n < 2; ++n) { wa[n] = *(const u32x2*)(ga + ro + bj * 128 + n * 16); wb[n] = *(const u32x2*)(gb + ro + bj * 128 + n * 16); }
#pragma unroll
                    for (int n = 0; n < 2; ++n) { f32x4& v = acc[ai][bj][m][n]; const u32x2 a = wa[n], b = wb[n];
                        v.x *= bf2f(a.x & 0xffffu) * __builtin_amdgcn_rcpf(bf2f(b.x & 0xffffu)); v.y *= bf2f(a.x >> 16) * __builtin_amdgcn_rcpf(bf2f(b.x >> 16));
                        v.z *= bf2f(a.y & 0xffffu) * __builtin_amdgcn_rcpf(bf2f(b.y & 0xffffu)); v.w *= bf2f(a.y >> 16) * __builtin_amdgcn_rcpf(bf2f(b.y >> 16)); } }
            }
    }
    __device__ __forceinline__ void operator()(const f32x4 (&acc)[2][2][4][2], const pg8::Unit& u, int wr, int wc, int fr, int fq) const {
        const int col0 = u.pn * 256 + wc * 32 + 4 * fq;
#pragma unroll
        for (int ai = 0; ai < 2; ++ai)
#pragma unroll
            for (int m = 0; m < 4; ++m) {
                const size_t ro = (size_t)(u.pm * 256 + ai * 128 + wr * 64 + m * 16 + fr) * D + col0;
                u32x2 wb[2][2];
#pragma unroll
                for (int bj = 0; bj < 2; ++bj)
#pragma unroll
                    for (int n = 0; n < 2; ++n) wb[bj][n] = *(const u32x2*)(gb + ro + bj * 128 + n * 16);
#pragma unroll
                for (int bj = 0; bj < 2; ++bj)
#pragma unroll
                    for (int n = 0; n < 2; ++n) { const f32x4 v = acc[ai][bj][m][n]; const u32x2 b = wb[bj][n];
                        u32x2 w; w.x = cvt_pk_bf16(v.x * bf2f(b.x & 0xffffu), v.y * bf2f(b.x >> 16)); w.y = cvt_pk_bf16(v.z * bf2f(b.y & 0xffffu), v.w * bf2f(b.y >> 16));
                        *(u32x2*)(merged + ro + bj * 128 + n * 16) = w; }
            }
    }
};

__device__ __forceinline__ bf16x8 pack8(const float* f) { u32x4 w; w.x = cvt_pk_bf16(f[0], f[1]); w.y = cvt_pk_bf16(f[2], f[3]); w.z = cvt_pk_bf16(f[4], f[5]); w.w = cvt_pk_bf16(f[6], f[7]); return __builtin_bit_cast(bf16x8, w); }
template <bool WRITE> __device__ __forceinline__ void attn_item(ArgsP A, int item, int lane) {
    const float* kdiag; const float* vdiag; const float* klow; const float* vlow; int qrow0, posq0, nblk, h;
    if (item < 4096) { const int b = item >> 10; h = (item >> 7) & 7; const int qt = item & 127;
        qrow0 = b * 4096 + 32 * qt; posq0 = 16 + 32 * qt; nblk = qt + 2;
        klow = A->out + O_PK + (size_t)b * LP * 512 + h * 64; vlow = A->out + O_PV + (size_t)b * LP * 512 + h * 64;
        kdiag = klow + (size_t)posq0 * 512; vdiag = vlow + (size_t)posq0 * 512;
    } else { const int id = item - 4096, s = id >> 3; h = id & 7;
        qrow0 = MP + 32 * s; posq0 = LC; nblk = 66;
        klow = A->in[I_CK] + (size_t)s * LC * 512 + h * 64; vlow = A->in[I_CV] + (size_t)s * LC * 512 + h * 64;
        kdiag = A->out + O_SK + (size_t)s * 32 * 512 + h * 64; vdiag = A->out + O_SV + (size_t)s * 32 * 512 + h * 64;
    }
    bf16* qo = (bf16*)(A->ws + WS_QB) + (size_t)qrow0 * 512 + h * 64;
    const int ql = lane & 31, hi = lane >> 5;
    bf16x8 qf[4];
#pragma unroll
    for (int s = 0; s < 4; ++s) qf[s] = *(const bf16x8*)(qo + (size_t)ql * 512 + 16 * s + 8 * hi);
    const int rA = (ql & 3) + 4 * (ql >> 3), hA = (ql >> 2) & 1, kappaA = 8 * hA + rA + (rA >= 8 ? 8 : 0);
    f32x16 o0, o1;
#pragma unroll
    for (int r = 0; r < 16; ++r) { o0[r] = 0.f; o1[r] = 0.f; }
    float R = 0.f;
    for (int j = 0; j < nblk; ++j) {
        const int pos0 = posq0 - 32 * j;
        const float* kb = j == 0 ? kdiag : klow; const float* vb = j == 0 ? vdiag : vlow;
        const int rb = j == 0 ? 0 : pos0;
        int rowA = rb + kappaA; rowA = rowA < 0 ? 0 : rowA;
        const float* kp = kb + (size_t)rowA * 512 + 8 * hi;
        f32x16 sacc;
#pragma unroll
        for (int r = 0; r < 16; ++r) sacc[r] = 0.f;
        f32x4 kv[8];
#pragma unroll
        for (int s = 0; s < 4; ++s) { kv[2 * s] = *(const f32x4*)(kp + 16 * s); kv[2 * s + 1] = *(const f32x4*)(kp + 16 * s + 4); }
        float vv[2][2][8];
#pragma unroll
        for (int st = 0; st < 2; ++st)
#pragma unroll
            for (int i = 0; i < 8; ++i) { int row = rb + 16 * st + 8 * hi + i; row = row < 0 ? 0 : row; const float* vp = vb + (size_t)row * 512 + ql; vv[st][0][i] = vp[0]; vv[st][1][i] = vp[32]; }
#pragma unroll
        for (int s = 0; s < 4; ++s) { float kk[8] = {kv[2 * s].x, kv[2 * s].y, kv[2 * s].z, kv[2 * s].w, kv[2 * s + 1].x, kv[2 * s + 1].y, kv[2 * s + 1].z, kv[2 * s + 1].w};
            sacc = __builtin_amdgcn_mfma_f32_32x32x16_bf16(pack8(kk), qf[s], sacc, 0, 0, 0); }
        float sp[16];
#pragma unroll
        for (int r = 0; r < 16; ++r) { const int kappa = 8 * hi + r + (r >= 8 ? 8 : 0);
            const bool valid = (pos0 + kappa >= 0) && (j > 0 || kappa < ql);
            const float z = sacc[r];
            const float s_ = fmaxf(z, 0.f) + lg2(1.0f + ex2(-fabsf(z)));
            sp[r] = valid ? s_ : 0.f; sacc[r] = valid ? z : -1e30f; }
        float glo = 0.f, ghi = 0.f;
#pragma unroll
        for (int r = 0; r < 8; ++r) { glo += sp[r]; ghi += sp[8 + r]; }
        const float pglo = __shfl_xor(glo, 32), pghi = __shfl_xor(ghi, 32);
        const float base_hi = R + (hi == 0 ? pghi : 0.f);
        const float base_lo = R + ghi + pghi + (hi == 0 ? pglo : 0.f);
        float pa[16];
        { float c = base_hi;
#pragma unroll
          for (int r = 15; r >= 8; --r) { c += sp[r]; pa[r] = ex2(sacc[r] - c); }
          c = base_lo;
#pragma unroll
          for (int r = 7; r >= 0; --r) { c += sp[r]; pa[r] = ex2(sacc[r] - c); } }
        R += (glo + ghi) + (pglo + pghi);
        const bf16x8 p0 = pack8(pa), p1 = pack8(pa + 8);
        o0 = __builtin_amdgcn_mfma_f32_32x32x16_bf16(pack8(vv[0][0]), p0, o0, 0, 0, 0);
        o1 = __builtin_amdgcn_mfma_f32_32x32x16_bf16(pack8(vv[0][1]), p0, o1, 0, 0, 0);
        o0 = __builtin_amdgcn_mfma_f32_32x32x16_bf16(pack8(vv[1][0]), p1, o0, 0, 0, 0);
        o1 = __builtin_amdgcn_mfma_f32_32x32x16_bf16(pack8(vv[1][1]), p1, o1, 0, 0, 0);
        if (__all(R > SB_EXIT)) break;
    }
    if (!WRITE) { if (o0[0] + o1[5] != 12345.678f) return; }
#pragma unroll
    for (int g = 0; g < 4; ++g) {
        u32x2 w; w.x = cvt_pk_bf16(o0[4 * g], o0[4 * g + 1]); w.y = cvt_pk_bf16(o0[4 * g + 2], o0[4 * g + 3]);
        *(u32x2*)(qo + (size_t)ql * 512 + 8 * g + 4 * hi) = w;
        u32x2 w1; w1.x = cvt_pk_bf16(o1[4 * g], o1[4 * g + 1]); w1.y = cvt_pk_bf16(o1[4 * g + 2], o1[4 * g + 3]);
        *(u32x2*)(qo + (size_t)ql * 512 + 32 + 8 * g + 4 * hi) = w1;
    }
}

constexpr int HQ_P = 136, HT_P = 72, HS_P = 72;
constexpr int IMG_KHT = 0, IMG_SC = 128 * HT_P * 2, IMG_DV = IMG_SC + 64 * HS_P * 2, IMG_BYTES = IMG_DV + 512;
constexpr int NPREP = 16 * 65 + 32;
constexpr size_t WS_IMG = WS_XN;
constexpr size_t WS_ORAW = WS_WGU1;
static_assert((size_t)NPREP * IMG_BYTES <= 34603008, "image region");
constexpr int LP_QT = 0, LP_KT = LP_QT + 64 * HQ_P * 2, LP_PART = LP_KT + 64 * HQ_P * 2, LP_END = LP_PART + 8 * 128 * 4;
__device__ __forceinline__ void hgrn_chunk_params(bool prompt, int sidx, int c, int& row0, int& nvalid, int& pos0) {
    if (prompt) { if (c == 0) { row0 = MO; nvalid = 16; pos0 = 0; } else { row0 = sidx * 4096 + 64 * (c - 1); nvalid = 64; pos0 = 16 + 64 * (c - 1); } }
    else { row0 = MP + 32 * sidx; nvalid = 32; pos0 = 0; }
}
template <bool WRITE> __device__ __forceinline__ void hgrn_prep(ArgsP A, LAS unsigned char* lds, int item, int tid) {
    const int lane = tid & 63, w = __builtin_amdgcn_readfirstlane(tid >> 6), l16 = lane & 15, g = lane >> 4;
    const bool prompt = item < 1040; const int bh = prompt ? item / 65 : item - 1040, c = prompt ? item % 65 : 0, sidx = bh >> 2, h = bh & 3;
    int row0, nvalid, pos0; hgrn_chunk_params(prompt, sidx, c, row0, nvalid, pos0);
    LAS bf16* Qt = (LAS bf16*)(lds + LP_QT); LAS bf16* Kt = (LAS bf16*)(lds + LP_KT); LAS float* part = (LAS float*)(lds + LP_PART);
    unsigned char* img = A->ws + WS_IMG + (size_t)item * IMG_BYTES;
    const unsigned short* kkh = (const unsigned short*)(A->ws + WS_KKH); bf16* qh = (bf16*)(A->ws + WS_QH);
    const int kp = lane, tg = w;
    float kk[8][2], qv[8][2], cb[8][2]; float run0 = 0.f, run1 = 0.f;
#pragma unroll
    for (int i = 0; i < 8; ++i) { const int t = 8 * tg + i; const unsigned m_ = t < nvalid ? 0xffffffffu : 0u;
        const size_t off = (size_t)(row0 + t) * 512 + h * 128 + 2 * kp; const unsigned k2 = *(const unsigned*)(kkh + off) & m_, q2 = *(const unsigned*)(qh + off) & m_;
        kk[i][0] = (float)__builtin_bit_cast(_Float16, (unsigned short)(k2 & 0xffffu)); kk[i][1] = (float)__builtin_bit_cast(_Float16, (unsigned short)(k2 >> 16));
        qv[i][0] = bf2f((unsigned short)(q2 & 0xffffu)); qv[i][1] = bf2f((unsigned short)(q2 >> 16)); }
#pragma unroll
    for (int i = 0; i < 8; ++i) { run0 += lg2(1.0f - kk[i][0]); run1 += lg2(1.0f - kk[i][1]); cb[i][0] = run0; cb[i][1] = run1; }
    *(LAS f32x2*)(part + tg * 128 + 2 * kp) = (f32x2){run0, run1};
    __syncthreads();
    float off0 = 0.f, off1 = 0.f, tot0 = 0.f, tot1 = 0.f;
#pragma unroll
    for (int q = 0; q < 8; ++q) { const f32x2 p = *(const LAS f32x2*)(part + q * 128 + 2 * kp); if (q < tg) { off0 += p.x; off1 += p.y; } tot0 += p.x; tot1 += p.y; }
    if (WRITE && tg == 0) *(f32x2*)(img + IMG_DV + 8 * kp) = (f32x2){ex2(tot0), ex2(tot1)};
    float kh0[8], kh1[8];
#pragma unroll
    for (int i = 0; i < 8; ++i) { const int t = 8 * tg + i; const float b0 = off0 + cb[i][0], b1 = off1 + cb[i][1];
        const unsigned qq = cvt_pk_bf16(qv[i][0] * ex2(b0), qv[i][1] * ex2(b1)), kq = cvt_pk_bf16(kk[i][0] * ex2(-b0), kk[i][1] * ex2(-b1));
        *(LAS unsigned*)(Qt + t * HQ_P + 2 * kp) = qq; *(LAS unsigned*)(Kt + t * HQ_P + 2 * kp) = kq;
        if (WRITE && t < nvalid) *(unsigned*)(qh + (size_t)(row0 + t) * 512 + h * 128 + 2 * kp) = qq;
        kh0[i] = kk[i][0] * ex2(tot0 - b0); kh1[i] = kk[i][1] * ex2(tot1 - b1); }
    if (WRITE) { *(bf16x8*)(img + IMG_KHT + ((2 * kp) * HT_P + 8 * tg) * 2) = pack8(kh0);
    *(bf16x8*)(img + IMG_KHT + ((2 * kp + 1) * HT_P + 8 * tg) * 2) = pack8(kh1); }
    else if (kh0[0] + kh1[7] == 12345.678f) part[0] = kh0[1];
    __syncthreads();
    bf16* sci = (bf16*)(img + IMG_SC);
#pragma unroll
    for (int q = 0; q < 2; ++q) { const int id = 2 * w + q, mt = id >> 2, nt = id & 3;
        f32x4 sc = {0.f, 0.f, 0.f, 0.f};
        if (mt >= nt) {
#pragma unroll
            for (int ks = 0; ks < 4; ++ks) { const bf16x8 a = *(const LAS bf16x8*)(Qt + (16 * mt + l16) * HQ_P + 32 * ks + 8 * g), b = *(const LAS bf16x8*)(Kt + (16 * nt + l16) * HQ_P + 32 * ks + 8 * g);
                sc = __builtin_amdgcn_mfma_f32_16x16x32_bf16(a, b, sc, 0, 0, 0); }
        }
#pragma unroll
        for (int j = 0; j < 4; ++j) { const int t = 16 * mt + 4 * g + j, s_ = 16 * nt + l16; const float v = (t >= s_) ? sc[j] : 0.f;
            if (WRITE || v == 12345.678f) sci[t * HS_P + s_] = (bf16)(cvt_pk_bf16(v, 0.f) & 0xffffu); }
    }
    __syncthreads();
}
constexpr int LS_QT = 0, LS_SG = LS_QT + 64 * HQ_P * 2, LS_IMG = LS_SG + 64 * HQ_P * 2, LS_BUF = LS_IMG + IMG_BYTES, LS_SSQ = 2 * LS_BUF, LS_END = LS_SSQ + 2 * 2048;
static_assert(LS_END <= 131072 && (LS_BUF % 16) == 0, "hgrn scan lds");
#define WG_BAR() do { asm volatile("s_waitcnt lgkmcnt(0)" ::: "memory"); __builtin_amdgcn_s_barrier(); asm volatile("" ::: "memory"); } while (0)
template <bool WRITE> __device__ __forceinline__ void hgrn_scan(ArgsP A, LAS unsigned char* lds, int item, int tid) {
    const int lane = tid & 63, w = __builtin_amdgcn_readfirstlane(tid >> 6), l16 = lane & 15, g = lane >> 4;
    const bool prompt = item < 16; const int sidx = prompt ? (item >> 2) : ((item - 16) >> 2), h = item & 3;
    const int nchunk = prompt ? 65 : 1;
    const bf16* qh = (const bf16*)(A->ws + WS_QH); bf16* oraw = (bf16*)(A->ws + WS_ORAW);
    const unsigned char* imgb = A->ws + WS_IMG + (size_t)(prompt ? (sidx * 4 + h) * 65 : 1040 + (sidx * 4 + h)) * IMG_BYTES;
    const int vcol = 16 * w + l16;
    const bf16* ivtb = prompt ? ((const bf16*)(A->ws + WS_IVTP) + ((size_t)((sidx * 4 + h) * 128 + vcol)) * LP) : ((const bf16*)(A->ws + WS_IVTS) + ((size_t)((sidx * 4 + h) * 128 + vcol)) * 64);
    const float gn = A->in[I_HGN][h * 128 + vcol];
    f32x4 S[8];
    if (prompt) {
#pragma unroll
        for (int mt = 0; mt < 8; ++mt) S[mt] = (f32x4){0.f, 0.f, 0.f, 0.f};
    } else {
        const float* st = A->in[I_ST] + (size_t)(sidx * 4 + h) * 16384;
#pragma unroll
        for (int mt = 0; mt < 8; ++mt)
#pragma unroll
            for (int j = 0; j < 4; ++j) S[mt][j] = st[(size_t)(16 * mt + 4 * g + j) * 128 + vcol];
    }
    const int prow = tid >> 4, pseg = tid & 15;
    const unsigned qoff = (unsigned)(prow * (HQ_P * 2) + pseg * 16);
    const u32x4 Z4 = {0u, 0u, 0u, 0u};
    u32x4 X[8], Y[8];
#define HG_ISSUE(SET, cidx) do { int c_ = (cidx); c_ = c_ < nchunk ? c_ : nchunk - 1; int row0_, nv_, pos0_; hgrn_chunk_params(prompt, sidx, c_, row0_, nv_, pos0_); \
        const size_t go_ = (size_t)(row0_ + prow) * 512 + h * 128 + pseg * 8; \
        _Pragma("unroll") for (int i_ = 0; i_ < 2; ++i_) { const unsigned m_ = (prow + 32 * i_ < nv_) ? 0xffffffffu : 0u; SET[i_] = *(const u32x4*)(qh + go_ + (size_t)i_ * 32 * 512) & m_; } \
        const unsigned char* im_ = imgb + (size_t)c_ * IMG_BYTES + tid * 16; \
        _Pragma("unroll") for (int i_ = 0; i_ < 4; ++i_) SET[4 + i_] = *(const u32x4*)(im_ + 8192 * i_); } while (0)
#define HG_BIV(DST, cidx) do { int c_ = (cidx); c_ = c_ < nchunk ? c_ : nchunk - 1; int row0_, nv_, pos0_; hgrn_chunk_params(prompt, sidx, c_, row0_, nv_, pos0_); \
        _Pragma("unroll") for (int s_ = 0; s_ < 2; ++s_) { const unsigned m_ = (32 * s_ + 8 * g < nv_) ? 0xffffffffu : 0u; DST[s_] = *(const u32x4*)(ivtb + pos0_ + 32 * s_ + 8 * g) & m_; } } while (0)
#define HG_COMMIT(SET, boff) do { LAS unsigned char* b_ = lds + (boff); \
        _Pragma("unroll") for (int i_ = 0; i_ < 2; ++i_) { *(LAS u32x4*)(b_ + LS_QT + qoff + i_ * 32 * HQ_P * 2) = SET[i_]; } \
        _Pragma("unroll") for (int i_ = 0; i_ < 4; ++i_) { if (tid + 512 * i_ < IMG_BYTES / 16) *(LAS u32x4*)(b_ + LS_IMG + tid * 16 + 8192 * i_) = SET[4 + i_]; } } while (0)
#define HG_COMPUTE(cidx, boff, bivc) do { const int c_ = (cidx); int row0_, nv_, pos0_; hgrn_chunk_params(prompt, sidx, c_, row0_, nv_, pos0_); const bool wr_ = !(prompt && c_ == 0); \
        LAS unsigned char* b_ = lds + (boff); const LAS bf16* Qt = (const LAS bf16*)(b_ + LS_QT); const LAS bf16* Sg = (const LAS bf16*)(b_ + LS_SG); \
        const LAS bf16* KhT = (const LAS bf16*)(b_ + LS_IMG + IMG_KHT); const LAS bf16* Sc = (const LAS bf16*)(b_ + LS_IMG + IMG_SC); const LAS float* dv = (const LAS float*)(b_ + LS_IMG + IMG_DV); \
        LAS float* ssq = (LAS float*)(lds + LS_SSQ + (c_ & 1) * 2048); \
        bf16x8 bs[4]; \
        _Pragma("unroll") for (int ks = 0; ks < 4; ++ks) { u32x4 t_; t_.x = cvt_pk_bf16(S[2 * ks][0], S[2 * ks][1]); t_.y = cvt_pk_bf16(S[2 * ks][2], S[2 * ks][3]); t_.z = cvt_pk_bf16(S[2 * ks + 1][0], S[2 * ks + 1][1]); t_.w = cvt_pk_bf16(S[2 * ks + 1][2], S[2 * ks + 1][3]); bs[ks] = __builtin_bit_cast(bf16x8, t_); } \
        const bf16x8 biv0 = __builtin_bit_cast(bf16x8, bivc[0]), biv1 = __builtin_bit_cast(bf16x8, bivc[1]); \
        f32x4 o[4]; \
          \
        _Pragma("unroll") for (int gp = 0; gp < 2; ++gp) { bf16x8 fa[12]; \
            _Pragma("unroll") for (int m2 = 0; m2 < 2; ++m2) { const int mt = 2 * gp + m2; \
                fa[6 * m2 + 0] = *(const LAS bf16x8*)(Sc + (16 * mt + l16) * HS_P + 8 * g); fa[6 * m2 + 1] = *(const LAS bf16x8*)(Sc + (16 * mt + l16) * HS_P + 32 + 8 * g); \
                _Pragma("unroll") for (int ks = 0; ks < 4; ++ks) { const u32x2 lo_ = *(const LAS u32x2*)(Qt + (16 * mt + l16) * HQ_P + 32 * ks + 4 * g), hi_ = *(const LAS u32x2*)(Qt + (16 * mt + l16) * HQ_P + 32 * ks + 16 + 4 * g); \
                    u32x4 t_; t_.x = lo_.x; t_.y = lo_.y; t_.z = hi_.x; t_.w = hi_.y; fa[6 * m2 + 2 + ks] = __builtin_bit_cast(bf16x8, t_); } } \
            __builtin_amdgcn_sched_barrier(0); \
            f32x4 a0 = {0.f, 0.f, 0.f, 0.f}, a1 = {0.f, 0.f, 0.f, 0.f}; \
            a0 = __builtin_amdgcn_mfma_f32_16x16x32_bf16(fa[0], biv0, a0, 0, 0, 0); a1 = __builtin_amdgcn_mfma_f32_16x16x32_bf16(fa[6], biv0, a1, 0, 0, 0); \
            a0 = __builtin_amdgcn_mfma_f32_16x16x32_bf16(fa[1], biv1, a0, 0, 0, 0); a1 = __builtin_amdgcn_mfma_f32_16x16x32_bf16(fa[7], biv1, a1, 0, 0, 0); \
            _Pragma("unroll") for (int ks = 0; ks < 4; ++ks) { a0 = __builtin_amdgcn_mfma_f32_16x16x32_bf16(fa[2 + ks], bs[ks], a0, 0, 0, 0); a1 = __builtin_amdgcn_mfma_f32_16x16x32_bf16(fa[8 + ks], bs[ks], a1, 0, 0, 0); } \
            o[2 * gp] = a0; o[2 * gp + 1] = a1; \
            __builtin_amdgcn_sched_barrier(0); } \
        _Pragma("unroll") for (int gp = 0; gp < 2; ++gp) { bf16x8 fk[8]; f32x4 d4[4]; \
            _Pragma("unroll") for (int m4 = 0; m4 < 4; ++m4) { const int mt = 4 * gp + m4; d4[m4] = *(const LAS f32x4*)(dv + 16 * mt + 4 * g); \
                fk[2 * m4] = *(const LAS bf16x8*)(KhT + (16 * mt + l16) * HT_P + 8 * g); fk[2 * m4 + 1] = *(const LAS bf16x8*)(KhT + (16 * mt + l16) * HT_P + 32 + 8 * g); } \
            __builtin_amdgcn_sched_barrier(0); \
            f32x4 a_[4]; \
            _Pragma("unroll") for (int m4 = 0; m4 < 4; ++m4) a_[m4] = S[4 * gp + m4] * d4[m4]; \
            _Pragma("unroll") for (int m4 = 0; m4 < 4; ++m4) a_[m4] = __builtin_amdgcn_mfma_f32_16x16x32_bf16(fk[2 * m4], biv0, a_[m4], 0, 0, 0); \
            _Pragma("unroll") for (int m4 = 0; m4 < 4; ++m4) a_[m4] = __builtin_amdgcn_mfma_f32_16x16x32_bf16(fk[2 * m4 + 1], biv1, a_[m4], 0, 0, 0); \
            _Pragma("unroll") for (int m4 = 0; m4 < 4; ++m4) S[4 * gp + m4] = a_[m4]; \
            __builtin_amdgcn_sched_barrier(0); } \
        if (wr_) { _Pragma("unroll") for (int mt = 0; mt < 4; ++mt) _Pragma("unroll") for (int j = 0; j < 4; ++j) { const int t = 16 * mt + 4 * g + j; \
            if (t < nv_) oraw[(size_t)(row0_ + t) * 512 + h * 128 + vcol] = (bf16)(cvt_pk_bf16(o[mt][j], 0.f) & 0xffffu); } } \
        WG_BAR(); } while (0)
    u32x4 bivA[2], bivB[2];
    HG_ISSUE(X, 0); HG_BIV(bivA, 0); HG_ISSUE(Y, 1); HG_BIV(bivB, 1);
    HG_COMMIT(X, 0);
    HG_ISSUE(X, 2);
    WG_BAR();
    for (int c = 0; c < nchunk; c += 2) {
        if (c + 1 < nchunk) HG_COMMIT(Y, LS_BUF);
        HG_ISSUE(Y, c + 3);
        HG_COMPUTE(c, 0, bivA);
        HG_BIV(bivA, c + 2);
        if (c + 1 < nchunk) {
            if (c + 2 < nchunk) HG_COMMIT(X, 0);
            HG_ISSUE(X, c + 4);
            HG_COMPUTE(c + 1, LS_BUF, bivB);
            HG_BIV(bivB, c + 3);
        }
    }
#undef HG_ISSUE
#undef HG_BIV
#undef HG_COMMIT
#undef HG_COMPUTE
    float* so = A->out + (prompt ? O_PH : O_SH) + (size_t)(sidx * 4 + h) * 16384;
#pragma unroll
    for (int mt = 0; mt < 8; ++mt)
#pragma unroll
        for (int j = 0; j < 4; ++j) so[(size_t)(16 * mt + 4 * g + j) * 128 + vcol] = S[mt][j];
    WG_BAR();
}

__device__ __forceinline__ void hgrn_finalize(ArgsP A, int gw, int ngw, int lane) {
    const bf16* oraw = (const bf16*)(A->ws + WS_ORAW); bf16* sg = (bf16*)(A->ws + WS_SG); const float* gnp = A->in[I_HGN];
    for (int it = gw; it < MO * 4; it += ngw) { const int row = it >> 2, h = it & 3; const size_t off = (size_t)row * 512 + h * 128 + 2 * lane;
        const unsigned ow = *(const unsigned*)(oraw + off), sw = *(const unsigned*)(sg + off);
        const float o0 = bf2f((unsigned short)(ow & 0xffffu)), o1 = bf2f((unsigned short)(ow >> 16));
        const float tot = wave_sum(o0 * o0 + o1 * o1);
        const float rs = rsqrtf(tot * (1.0f / 128.0f) + EPS);
        const f32x2 gn = *(const f32x2*)(gnp + h * 128 + 2 * lane);
        *(unsigned*)(sg + off) = cvt_pk_bf16(o0 * rs * gn.x * bf2f((unsigned short)(sw & 0xffffu)), o1 * rs * gn.y * bf2f((unsigned short)(sw >> 16))); }
}

#define XB_TMO      128
#define XB_XCNT(j)  (256  + 64 * (j))
#define XB_XSUB(j)  (1280 + 64 * (j))
#define XB_XGEN(j)  (2304 + 64 * (j))
#define XB_TOP      3328
#define XB_TOPGEN   3392
#define XCD_BAR_WORDS 3456
#define XB_SPIN_CAP (1u << 18)

__device__ __forceinline__ unsigned xb_ld(unsigned* p)              { return __hip_atomic_load(p, __ATOMIC_RELAXED, __HIP_MEMORY_SCOPE_AGENT); }
__device__ __forceinline__ unsigned xb_add(unsigned* p, unsigned v) { return __hip_atomic_fetch_add(p, v, __ATOMIC_RELAXED, __HIP_MEMORY_SCOPE_AGENT); }
__device__ __forceinline__ unsigned xb_xcc_id() { return (unsigned)__builtin_amdgcn_s_getreg((3 << 11) | 20) & 0xFu; }
#define XB_SPIN(cond, bar) do { unsigned _sp = 0; while (cond) { __builtin_amdgcn_s_sleep(1); \
    if ((++_sp & 255u) == 0u) { if (xb_ld(&(bar)[XB_TMO])) break; if (_sp > XB_SPIN_CAP) { atomicAdd(&(bar)[XB_TMO], 1u); break; } } } } while (0)

struct XcdBarrier {
    unsigned* bar; unsigned x;
    volatile LAS unsigned* st;
};

__device__ __forceinline__ XcdBarrier xcd_barrier_post(unsigned* bar, volatile LAS unsigned* st) {
    XcdBarrier b; b.bar = bar; b.x = xb_xcc_id(); b.st = st;
    if (threadIdx.x == 0) (void)xb_add(&bar[XB_XCNT(b.x)], 1u);
    return b;
}
__device__ __forceinline__ void xcd_barrier_complete(unsigned* bar, unsigned x, unsigned& nloc, unsigned& nx) {
    const unsigned G = gridDim.x * gridDim.y * gridDim.z;
    unsigned sum, cnt, mine, sp = 0u;
    for (;;) {
        sum = 0u; cnt = 0u; mine = 0u;
#pragma unroll
        for (unsigned j = 0; j < 16; ++j) { const unsigned c = xb_ld(&bar[XB_XCNT(j)]); sum += c; cnt += (c > 0u) ? 1u : 0u; mine = (j == x) ? c : mine; }
        if (sum == G) break;
        __builtin_amdgcn_s_sleep(1);
        if ((++sp & 255u) == 0u) { if (xb_ld(&bar[XB_TMO])) break; if (sp > XB_SPIN_CAP) { atomicAdd(&bar[XB_TMO], 1u); break; } }
    }
    nloc = mine > 0u ? mine : 1u; nx = cnt > 0u ? cnt : 1u;
}

__device__ __forceinline__ void xcd_barrier(const XcdBarrier& b) {
    asm volatile("s_waitcnt vmcnt(0)" ::: "memory");
    __syncthreads();
    if (threadIdx.x == 0) {
        unsigned* bar = b.bar;
        __builtin_amdgcn_s_waitcnt(0);
        unsigned nloc = b.st[0], nx = b.st[1];
        if (nloc == 0u) { xcd_barrier_complete(bar, b.x, nloc, nx); b.st[0] = nloc; b.st[1] = nx; }
        const unsigned old = xb_add(&bar[XB_XSUB(b.x)], 1u);
        const unsigned gen = old / nloc;
        if (old + 1u == (gen + 1u) * nloc) {
            __builtin_amdgcn_fence(__ATOMIC_RELEASE, "agent");
            asm volatile("s_waitcnt vmcnt(0)" ::: "memory");
            const unsigned og = xb_add(&bar[XB_TOP], 1u);
            const unsigned tg = og / nx;
            if (og + 1u == (tg + 1u) * nx) xb_add(&bar[XB_TOPGEN], 1u);
            else XB_SPIN(xb_ld(&bar[XB_TOPGEN]) == tg, bar);
            __builtin_amdgcn_fence(__ATOMIC_ACQUIRE, "agent");
            xb_add(&bar[XB_XGEN(b.x)], 1u);
            asm volatile("s_waitcnt vmcnt(0)" ::: "memory");
        } else {
            XB_SPIN(xb_ld(&bar[XB_XGEN(b.x)]) == gen, bar);
            __builtin_amdgcn_fence(__ATOMIC_ACQUIRE, "agent");
            asm volatile("s_waitcnt vmcnt(0)" ::: "memory");
        }
    }
    __syncthreads();
}

__global__ void __launch_bounds__(NTHREADS, 2) mega_fwd(Args Aunused) {
    extern __shared__ __attribute__((aligned(16))) unsigned char lds_raw[];
    LAS unsigned char* lds = (LAS unsigned char*)lds_raw;
    cg::grid_group grid = cg::this_grid();
#define GRID_SYNC_CG() do { asm volatile("s_waitcnt vmcnt(0)" ::: "memory"); grid.sync(); \
        if (threadIdx.x < 64) { __builtin_amdgcn_fence(__ATOMIC_ACQUIRE, "agent"); asm volatile("s_waitcnt vmcnt(0)" ::: "memory"); } __syncthreads(); } while (0)
#define GRID_SYNC() xcd_barrier(xbar)
    if (threadIdx.x < 2) ((volatile LAS unsigned*)(lds + LDS_BARST))[threadIdx.x] = 0u;
    __syncthreads();
    const XcdBarrier xbar = xcd_barrier_post((unsigned*)(argsp()->ws + WS_CTL), (volatile LAS unsigned*)(lds + LDS_BARST));
#define TIDL ({ int t_ = threadIdx.x; asm volatile("" : "+v"(t_)); t_; })
#define LANE (tid & 63)
#define WAVE (__builtin_amdgcn_readfirstlane(tid >> 6))
#define GX ((int)gridDim.x)
#define BX ((int)blockIdx.x)
#define SSP(A, i) ((float*)((A)->ws + WS_SS + (size_t)(i) * SS_BYTES))

#ifndef REP_P0
#define REP_P0 1
#endif
#ifndef REP_P1
#define REP_P1 1
#endif
#ifndef REP_P2
#define REP_P2 1
#endif
#ifndef REP_SYNC
#define REP_SYNC 0
#endif
    for (int rep = 0; rep < REP_P0; ++rep) {
    { const int tid = TIDL; p0_phase(argsp(), lds, WAVE, LANE); }
    if (argsp()->out == nullptr) GRID_SYNC_CG();
    GRID_SYNC();
    }
    for (int rep = 0; rep < REP_SYNC; ++rep) GRID_SYNC();
    for (int rep = 0; rep < REP_P1; ++rep) {
    { ArgsP A = argsp(); unsigned char* ws = A->ws; pg8::Gemm g{(const bf16*)(ws + WS_XN), (const bf16*)(ws + WS_WGU1), MPAD, 2 * FF, D}; pg8::StaticOrder S; S.init(MPAD, 2 * FF, GX, BX); EpiSwiGLU E{(bf16*)(ws + WS_ACT), SSP(A, 0)};
      pg8::gemm_phase<EpiSwiGLU, pg8::StaticOrder, true, true>(lds, g, S, E); }
    GRID_SYNC();
    }
    for (int rep = 0; rep < REP_P2; ++rep) {
    { ArgsP A = argsp(); unsigned char* ws = A->ws; pg8::Gemm g{(const bf16*)(ws + WS_ACT), (const bf16*)(ws + WS_WD1), MPAD, D, FF}; pg8::TailOrder S; S.init(MP, D, GX, BX, 2, 11);
      EpiResid<1, 1, 1> E{A->in[I_XP], A->in[I_XS], A->in[I_META], A->out, (bf16*)(ws + WS_XN), A->in[I_NMIX], SSP(A, 1), (float*)(ws + WS_SLAB), 2, 64};
      pg8::gemm_phase<EpiResid<1, 1, 1>, pg8::TailOrder, true, true>(lds, g, S, E); }
    GRID_SYNC();
    { const int tid = TIDL; ArgsP A = argsp(); unsigned char* ws = A->ws;
      resid_finish<1, 1, 1>(A->in[I_XP], A->in[I_XS], A->in[I_META], A->out, (bf16*)(ws + WS_XN), A->in[I_NMIX], SSP(A, 1), (const float*)(ws + WS_SLAB), 11, 2, 272, BX * NWAVES + WAVE, GX * NWAVES, LANE); }
    GRID_SYNC();
    }
#ifndef REP_P3
#define REP_P3 1
#endif
#ifndef REP_P34
#define REP_P34 1
#endif
    for (int rep34 = 0; rep34 < REP_P34; ++rep34) {
    for (int rep3 = 0; rep3 < REP_P3; ++rep3) {
    { ArgsP A = argsp(); unsigned char* ws = A->ws; pg8::Gemm g{(const bf16*)(ws + WS_XN), (const bf16*)(ws + WS_WIN), MPAD, NIN, D}; pg8::StaticOrder S; S.init(MPAD, NIN, GX, BX); EpiWin E{ws, A->out, A->in[I_LB], A->in[I_BG], SSP(A, 1)};
      pg8::gemm_phase<EpiWin, pg8::StaticOrder, true, true>(lds, g, S, E); }
    GRID_SYNC();
    }
#ifdef REP_PREP
    { const int tid = TIDL; for (int it = BX; it < NPREP; it += GX) hgrn_prep<false>(argsp(), lds, it, tid); }
#endif
    { const int tid = TIDL; for (int it = BX; it < NPREP; it += GX) hgrn_prep<true>(argsp(), lds, it, tid); }
    GRID_SYNC();
    {
        const int G = GX, bx = BX; const int tid = TIDL;
        const int abase = G > 48 ? 48 : 0, na = G - abase;
#ifdef REP_SCAN
        for (int it = bx; it < 48; it += G) hgrn_scan<false>(argsp(), lds, it, tid);
#endif
        for (int it = bx; it < 48; it += G) hgrn_scan<true>(argsp(), lds, it, tid);
#ifdef REP_ATT
        if (bx >= abase) for (int it = (bx - abase) * NWAVES + WAVE; it < 4160; it += na * NWAVES) attn_item<false>(argsp(), it, LANE);
#endif
        if (bx >= abase) { for (int it = (bx - abase) * NWAVES + WAVE; it < 4160; it += na * NWAVES) attn_item<true>(argsp(), it, LANE);
            p0_weights(argsp(), lds, WAVE, LANE, (bx - abase) * NWAVES + WAVE, na * NWAVES, true); }
    }
    GRID_SYNC();
    { const int tid = TIDL; hgrn_finalize(argsp(), BX * NWAVES + WAVE, GX * NWAVES, LANE); }
    GRID_SYNC();
    }
    { ArgsP A = argsp(); unsigned char* ws = A->ws; const long kst8 = 8 * 128;
      pg8::Gemm g{(const bf16*)(ws + WS_QB), (const bf16*)(ws + WS_WA), MO, D, 512, (long)WS_SG - (long)WS_QB - kst8, (long)WS_WB - (long)WS_WA - kst8, 8, 16};
      pg8::StaticOrder S; S.init(MO, D, GX, BX); EpiMergeF E{(const bf16*)(ws + WS_GA), (const bf16*)(ws + WS_GB), (bf16*)(ws + WS_MRG)};
      pg8::gemm_phase<EpiMergeF, pg8::StaticOrder, true, true>(lds, g, S, E); }
    GRID_SYNC();
    { ArgsP A = argsp(); unsigned char* ws = A->ws; pg8::Gemm g{(const bf16*)(ws + WS_MRG), (const bf16*)(ws + WS_WOUT), MO, D, D}; pg8::TailOrder S; S.init(MP, D, GX, BX, 1, 4);
      EpiResid<0, 0, 1> E{nullptr, nullptr, nullptr, A->out, (bf16*)(ws + WS_XN), A->in[I_N2], SSP(A, 2), (float*)(ws + WS_KKH), 1, 64};
      pg8::gemm_phase<EpiResid<0, 0, 1>, pg8::TailOrder, true, true>(lds, g, S, E); }
    GRID_SYNC();
    { const int tid = TIDL; ArgsP A = argsp(); unsigned char* ws = A->ws;
      resid_finish<0, 0, 1>(nullptr, nullptr, nullptr, A->out, (bf16*)(ws + WS_XN), A->in[I_N2], SSP(A, 2), (const float*)(ws + WS_KKH), 4, 1, 256, BX * NWAVES + WAVE, GX * NWAVES, LANE); }
    GRID_SYNC();
#ifndef REP_P7
#define REP_P7 1
#endif
    for (int rep = 0; rep < REP_P7; ++rep) {
    { ArgsP A = argsp(); unsigned char* ws = A->ws; pg8::Gemm g{(const bf16*)(ws + WS_XN), (const bf16*)(ws + WS_WGU2), MO, 2 * FF, D}; pg8::StaticOrder S; S.init(MO, 2 * FF, GX, BX); EpiSwiGLU E{(bf16*)(ws + WS_ACT), SSP(A, 2)};
      pg8::gemm_phase<EpiSwiGLU, pg8::StaticOrder, true, true>(lds, g, S, E); }
    GRID_SYNC();
    }
    { ArgsP A = argsp(); unsigned char* ws = A->ws; pg8::Gemm g{(const bf16*)(ws + WS_ACT), (const bf16*)(ws + WS_WD2), MO, D, FF}; pg8::TailOrder S; S.init(MP, D, GX, BX, 1, 11);
      EpiResid<0, 1, 0> E{nullptr, nullptr, nullptr, A->out, nullptr, nullptr, SSP(A, 3), (float*)(ws + WS_SLAB), 1, 64};
      pg8::gemm_phase<EpiResid<0, 1, 0>, pg8::TailOrder, true, true>(lds, g, S, E); }
    GRID_SYNC();
    { const int tid = TIDL; ArgsP A = argsp(); unsigned char* ws = A->ws;
      resid_finish<0, 1, 0>(nullptr, nullptr, nullptr, A->out, nullptr, nullptr, SSP(A, 3), (const float*)(ws + WS_SLAB), 11, 1, 256, BX * NWAVES + WAVE, GX * NWAVES, LANE); }
    GRID_SYNC();
    {
        const int tid = TIDL; ArgsP A = argsp(); float* X = A->out; const float* SS3 = SSP(A, 3);
        const int gw = BX * NWAVES + WAVE, NGW = GX * NWAVES; const f32x4* gf = (const f32x4*)A->in[I_NF] + LANE;
        for (int m = gw; m < MO; m += NGW) { const float rs = rstd_from_ss(SS3, m); f32x4* x4 = (f32x4*)(X + (size_t)m * D) + LANE;
#pragma unroll
            for (int j = 0; j < 4; ++j) { f32x4 v = x4[64 * j]; const f32x4 gg = gf[64 * j]; x4[64 * j] = v * rs * gg; } }
    }
}

extern "C" void kernel_launch(void* const* d_in, const int* in_sizes, int n_in, void* d_out, int out_size, void* d_ws, size_t ws_size, hipStream_t stream) {
    static int grid = 0;
    if (grid == 0) {
        if (n_in != 23 || ws_size < WS_CTL + CTL_BYTES || out_size != 34930688) { fprintf(stderr, "kernel_launch: unexpected problem shape (n_in %d, out %d, ws %zu)\n", n_in, out_size, ws_size); grid = -1; return; }
        int dev = 0, cus = 0, per_cu = 0;
        hipGetDevice(&dev); hipDeviceGetAttribute(&cus, hipDeviceAttributeMultiprocessorCount, dev);
        hipFuncSetAttribute((const void*)mega_fwd, hipFuncAttributeMaxDynamicSharedMemorySize, LDS_BYTES);
        hipOccupancyMaxActiveBlocksPerMultiprocessor(&per_cu, (const void*)mega_fwd, NTHREADS, LDS_BYTES);
        if (per_cu < 1) { fprintf(stderr, "kernel_launch: occupancy query returned %d\n", per_cu); per_cu = 1; }
        (void)hipGetLastError();
        grid = cus * per_cu;
    }
    if (grid < 0) return;
    if (hipMemsetAsync((char*)d_ws + WS_CTL, 0, CTL_BYTES, stream) != hipSuccess) { fprintf(stderr, "kernel_launch: memset of barrier words failed\n"); return; }
    Args a{};
    for (int i = 0; i < 23; ++i) a.in[i] = (const float*)d_in[i];
    a.out = (float*)d_out; a.ws = (unsigned char*)d_ws;
    void* args[] = {&a};
    hipError_t e = hipLaunchCooperativeKernel((const void*)mega_fwd, dim3(grid), dim3(NTHREADS), args, LDS_BYTES, stream);
    if (e != hipSuccess) fprintf(stderr, "cooperative launch failed: %s (grid %d)\n", hipGetErrorString(e), grid);
}
```
